# Optimizing an MI355X kernel written in HIP

```python
import math
import jax, jax.numpy as jnp
from jax import lax
import numpy as np

D_MODEL = 1024
BATCH = 8
SEQ = 8192
DEPTH = 1

CHUNK = 64
MIX_WIDTH = D_MODEL
POOL_WIDTH = MIX_WIDTH // 2
ATTN_WIDTH = MIX_WIDTH - POOL_WIDTH
POOL_WINDOWS = (2, 4, 8, 16)
N_POOL_GROUPS = len(POOL_WINDOWS)
POOL_GROUP_DIM = POOL_WIDTH // N_POOL_GROUPS
HEAD_DIM = 64
N_HEADS = ATTN_WIDTH // HEAD_DIM
LEFT_CHUNKS = 8
BAND = (LEFT_CHUNKS + 1) * CHUNK
MAX_REL = 64
N_REL = 2 * MAX_REL + 1
IN_PROJ_WIDTH = 2 * POOL_WIDTH + 4 * ATTN_WIDTH
EPS = 1e-6
MASK_VALUE = -1e30

kernel_name = "hybrid_pool_chunkattn_block"


def rms_norm(x, g):
    xf = x.astype(jnp.float32)
    y = xf * lax.rsqrt(jnp.mean(xf * xf, axis=-1, keepdims=True) + EPS)
    return (y * g.astype(jnp.float32)).astype(x.dtype)


def multiscale_pool(v, pool_w, pool_scale):
    S = v.shape[1]
    vf = v.astype(jnp.float32)
    cs = jnp.pad(jnp.cumsum(vf, axis=1), ((0, 0), (1, 0), (0, 0)))
    t = jnp.arange(S)
    diffs = []
    for gi, w in enumerate(POOL_WINDOWS):
        sl = slice(gi * POOL_GROUP_DIM, (gi + 1) * POOL_GROUP_DIM)
        cs_g = cs[..., sl]
        lo = jnp.maximum(t + 1 - w, 0)
        win_sum = cs_g[:, 1:] - jnp.take(cs_g, lo, axis=1)
        count = (t + 1 - lo).astype(jnp.float32)[None, :, None]
        diffs.append(win_sum / count - vf[..., sl])
    d = jnp.stack(diffs, axis=2)
    y = jnp.einsum('bsgc,gcd->bsgd', d, pool_w.astype(jnp.float32))
    y = y.reshape(y.shape[0], S, POOL_WIDTH) * pool_scale.astype(jnp.float32)
    return y.astype(v.dtype)


def chunked_rel_attention(q, k, v, rel_bias):
    B, S, H, Dh = q.shape
    n_chunks = S // CHUNK
    pad = LEFT_CHUNKS * CHUNK
    kp = jnp.pad(k, ((0, 0), (pad, 0), (0, 0), (0, 0)))
    vp = jnp.pad(v, ((0, 0), (pad, 0), (0, 0), (0, 0)))
    qc = jnp.moveaxis(q.reshape(B, n_chunks, CHUNK, H, Dh), 1, 0)
    i = jnp.arange(CHUNK)
    j = jnp.arange(BAND)
    rel = j[None, :] - pad - i[:, None]
    rel_idx = jnp.clip(rel, -MAX_REL, MAX_REL) + MAX_REL
    bias = rel_bias.astype(jnp.float32)[:, rel_idx]
    scale = 1.0 / math.sqrt(Dh)

    def one_chunk(args):
        c, qb = args
        start = c * CHUNK
        kb = lax.dynamic_slice_in_dim(kp, start, BAND, axis=1)
        vb = lax.dynamic_slice_in_dim(vp, start, BAND, axis=1)
        s = jnp.einsum('bqhd,bkhd->bhqk', qb, kb).astype(jnp.float32) * scale + bias[None]
        valid = (start + j - pad) >= 0
        s = jnp.where(valid[None, None, None, :], s, MASK_VALUE)
        p = jax.nn.softmax(s, axis=-1)
        return jnp.einsum('bhqk,bkhd->bqhd', p.astype(vb.dtype), vb)

    out = lax.map(one_chunk, (jnp.arange(n_chunks), qc))
    return jnp.moveaxis(out, 0, 1).reshape(B, S, H * Dh)


def setup_inputs(seed: int = 0) -> dict:
    key = jax.random.key(seed)
    ks = jax.random.split(key, 9)
    x = jax.random.normal(ks[0], (BATCH, SEQ, D_MODEL), jnp.float32)
    norm_gain = 1.0 + 0.02 * jax.random.normal(ks[1], (DEPTH, D_MODEL), jnp.float32)
    w_in = jax.random.normal(ks[2], (DEPTH, D_MODEL, IN_PROJ_WIDTH), jnp.float32) * D_MODEL ** -0.5
    pool_w = jax.random.normal(ks[3], (DEPTH, N_POOL_GROUPS, POOL_GROUP_DIM, POOL_GROUP_DIM), jnp.float32) * POOL_GROUP_DIM ** -0.5
    pool_scale = 1.0 + 0.02 * jax.random.normal(ks[4], (DEPTH, POOL_WIDTH), jnp.float32)
    rel_bias = 0.5 * jax.random.normal(ks[5], (DEPTH, N_HEADS, N_REL), jnp.float32)
    w_out = jax.random.normal(ks[6], (DEPTH, MIX_WIDTH, D_MODEL), jnp.float32) * MIX_WIDTH ** -0.5
    final_norm_gain = 1.0 + 0.02 * jax.random.normal(ks[7], (D_MODEL,), jnp.float32)
    return {"x": x, "norm_gain": norm_gain, "w_in": w_in, "pool_w": pool_w,
            "pool_scale": pool_scale, "rel_bias": rel_bias, "w_out": w_out,
            "final_norm_gain": final_norm_gain}


def reference(x, norm_gain, w_in, pool_w, pool_scale, rel_bias, w_out, final_norm_gain):
    B, S, _ = x.shape
    for layer in range(DEPTH):
        h = rms_norm(x, norm_gain[layer])
        proj = jnp.einsum('bsd,de->bse', h, w_in[layer])
        o = 0
        pool_v = proj[..., o:o + POOL_WIDTH]; o += POOL_WIDTH
        pool_g = proj[..., o:o + POOL_WIDTH]; o += POOL_WIDTH
        q = proj[..., o:o + ATTN_WIDTH]; o += ATTN_WIDTH
        k = proj[..., o:o + ATTN_WIDTH]; o += ATTN_WIDTH
        v = proj[..., o:o + ATTN_WIDTH]; o += ATTN_WIDTH
        attn_g = proj[..., o:o + ATTN_WIDTH]
        y_pool = multiscale_pool(pool_v, pool_w[layer], pool_scale[layer]) * jax.nn.silu(pool_g)
        qh = q.reshape(B, S, N_HEADS, HEAD_DIM)
        kh = k.reshape(B, S, N_HEADS, HEAD_DIM)
        vh = v.reshape(B, S, N_HEADS, HEAD_DIM)
        y_attn = chunked_rel_attention(qh, kh, vh, rel_bias[layer]) * jax.nn.silu(attn_g)
        y = jnp.concatenate([y_pool, y_attn], axis=-1)
        x = x + jnp.einsum('bse,ed->bsd', y, w_out[layer])
    return rms_norm(x, final_norm_gain)
```

```cpp
#include <hip/hip_runtime.h>
#include <hip/hip_cooperative_groups.h>
#include <cstdio>
#include <cstdint>
namespace pg8 {
#define PG8_LAS __attribute__((address_space(3)))
typedef unsigned short bf16_t;
typedef short bf16x8 __attribute__((ext_vector_type(8)));
typedef float f32x4 __attribute__((ext_vector_type(4)));
typedef unsigned u32x4 __attribute__((ext_vector_type(4)));
constexpr int BM = 256, BK = 64, HALF = 128, HTB = HALF * BK * 2  , STAGE_BYTES = 8 * HTB, NXCD = 8, WGM = 8;

__host__ __device__ __forceinline__ int lds_byte(int r, int c) { const int st = (r >> 4) * 2 + (c >> 5), rr = r & 15, cc = c & 31, ob = rr * 64 + cc * 2; return st * 1024 + (ob ^ (((ob >> 9) & 1) << 5)); }
__host__ __device__ __forceinline__ void stage_rc(int b, int& R, int& C) { const int st = b / 1024, sb = b % 1024, swz = sb ^ (((sb >> 9) & 1) << 5); R = (st >> 1) * 16 + swz / 64; C = (st & 1) * 32 + (swz % 64) / 2; }
__host__ __device__ __forceinline__ int perm32(int rho) { const int n = rho >> 4, i = rho & 15; return 8 * (i >> 2) + 4 * n + (i & 3); }

struct Unit { int pm, pn; };
struct Gemm { const bf16_t* A; const bf16_t* Bt; int M, N, K; };

struct StaticOrder {
    int nM, nN, nwg, G, c;
    __host__ __device__ void init(int M, int N, int G_, int c_) { nM = M / BM; nN = N / BM; nwg = nM * nN; G = G_; c = c_; }
    __host__ __device__ bool next(int i, Unit& u) const {
        const long L = (long)i * G + c; if (L >= nwg) return false;
        int wgid = (int)L; { const int q = nwg / NXCD, r = nwg % NXCD, xcd = wgid % NXCD, off = wgid / NXCD; wgid = (xcd < r ? xcd * (q + 1) : r * (q + 1) + (xcd - r) * q) + off; }
        const int nig = WGM * nN, gid = wgid / nig, fm = gid * WGM, gsz = (nM - fm) < WGM ? (nM - fm) : WGM;
        u.pm = fm + ((wgid % nig) % gsz); u.pn = (wgid % nig) / gsz; return true;
    }
    __device__ __forceinline__ void a_ready(const Unit&) const {}
    __device__ __forceinline__ void done(const Unit&) const {}
};

__device__ __forceinline__ unsigned cvt_pk_bf16(float lo, float hi) { unsigned r; asm volatile("v_cvt_pk_bf16_f32 %0, %1, %2" : "=v"(r) : "v"(lo), "v"(hi)); return r; }
__device__ __forceinline__ unsigned short bf16_1(float v) { return (unsigned short)(cvt_pk_bf16(v, v) & 0xffffu); }
struct EpiProj {
    static constexpr bool PERM = true, AFTER_DRAIN = false;
    bf16_t* P; bf16_t* VT;
    __device__ __forceinline__ void operator()(const f32x4 (&acc)[2][2][4][2], const Unit& u, int wr, int wc, int fr, int fq) const {
        const int row0 = u.pm * BM + wr * 64 + fr, col0 = u.pn * BM + wc * 32 + 8 * fq;
        if (u.pn == 8 || u.pn == 9) {
            const int b = row0 >> 13, s0 = row0 & 8191;
            bf16_t* base = VT + (size_t)(b * 512 + (col0 - 2048)) * 8192 + s0;
#pragma unroll
            for (int ai = 0; ai < 2; ++ai)
#pragma unroll
                for (int m = 0; m < 4; ++m) { const int ds = ai * HALF + m * 16;
#pragma unroll
                    for (int bj = 0; bj < 2; ++bj)
#pragma unroll
                        for (int n = 0; n < 2; ++n)
#pragma unroll
                            for (int e = 0; e < 4; ++e) base[(size_t)(bj * HALF + 4 * n + e) * 8192 + ds] = bf16_1(acc[ai][bj][m][n][e]); }
        } else {
#pragma unroll
            for (int ai = 0; ai < 2; ++ai)
#pragma unroll
                for (int m = 0; m < 4; ++m) { bf16_t* rowp = P + (size_t)(row0 + ai * HALF + m * 16) * 3072 + col0;
#pragma unroll
                    for (int bj = 0; bj < 2; ++bj) { const f32x4 v0 = acc[ai][bj][m][0], v1 = acc[ai][bj][m][1];
                        u32x4 w; w.x = cvt_pk_bf16(v0[0], v0[1]); w.y = cvt_pk_bf16(v0[2], v0[3]); w.z = cvt_pk_bf16(v1[0], v1[1]); w.w = cvt_pk_bf16(v1[2], v1[3]);
                        *(u32x4*)(rowp + bj * HALF) = w; } }
        }
    }
};
struct EpiOut {
    static constexpr bool PERM = false, AFTER_DRAIN = false;
    const float* X; float* O; float* part;
    __device__ __forceinline__ void operator()(const f32x4 (&acc)[2][2][4][2], const Unit& u, int wr, int wc, int fr, int fq) const {
        const int row0 = u.pm * BM + wr * 64 + fr, col0 = u.pn * BM + wc * 32 + 4 * fq;
#pragma unroll
        for (int ai = 0; ai < 2; ++ai)
#pragma unroll
            for (int m = 0; m < 4; ++m) { const int row = row0 + ai * HALF + m * 16; const size_t off = (size_t)row * 1024 + col0; float ss = 0.f;
#pragma unroll
                for (int bj = 0; bj < 2; ++bj)
#pragma unroll
                    for (int n = 0; n < 2; ++n) { const f32x4 xv = *(const f32x4*)(X + off + bj * HALF + n * 16); const f32x4 o = xv + acc[ai][bj][m][n];
                        *(f32x4*)(O + off + bj * HALF + n * 16) = o; ss += (o[0] * o[0] + o[1] * o[1]) + (o[2] * o[2] + o[3] * o[3]); }
                ss += __shfl_xor(ss, 16); ss += __shfl_xor(ss, 32);
                if (fq == 0) part[(size_t)row * 16 + u.pn * 4 + wc] = ss; }
    }
};
template <class Epi, class Sched, bool ALIGN_EPI = false, bool SP2 = false>
__device__ __forceinline__ void gemm_phase(PG8_LAS unsigned char* lds, const Gemm g, const Sched& S, const Epi& E) {
    const int tid = threadIdx.x, wid = __builtin_amdgcn_readfirstlane(tid >> 6), lane = tid & 63, wr = wid >> 2, wc = wid & 3, fr = lane & 15, fq = lane >> 4;
    const int K = g.K, nt = K / BK;
    unsigned voffA[2], voffB[2];
#pragma unroll
    for (int i = 0; i < 2; ++i) { int R, C; stage_rc(tid * 16 + i * 8192, R, C); const int Rb = Epi::PERM ? ((R & ~31) + perm32(R & 31)) : R;
        voffA[i] = (unsigned)(R * K + C) * 2u; voffB[i] = (unsigned)(Rb * K + C) * 2u; }
    const size_t kstep = (size_t)(BK * 2);
    const size_t hstep = (size_t)HALF * K * 2;
    const size_t tstep = 2 * hstep;
    const unsigned ldsw = (unsigned)wid * 1024u;
    const int aoff = lds_byte(wr * 64 + fr, fq * 8), boff = lds_byte(wc * 32 + fr, fq * 8);
#define PG8_SA(b, h) (((b) * 2 + (h)) * HTB)
#define PG8_SB(b, h) ((4 + (b) * 2 + (h)) * HTB)
#define PG8_STAGE(bufoff, gbase, voff) do { _Pragma("unroll") for (int _i = 0; _i < 2; ++_i) \
        __builtin_amdgcn_global_load_lds((const unsigned*)((const char*)(gbase) + (voff)[_i]), (PG8_LAS unsigned*)(lds + (bufoff) + ldsw + _i * 8192), 16, 0, 0); } while (0)
#define PG8_LDA(dst, b, h) do { _Pragma("unroll") for (int m = 0; m < 4; ++m) _Pragma("unroll") for (int k = 0; k < 2; ++k) dst[m][k] = *(const PG8_LAS bf16x8*)(lds + PG8_SA(b, h) + aoff + m * 2048 + k * 1024); } while (0)
#define PG8_LDB(dst, b, h) do { _Pragma("unroll") for (int n = 0; n < 2; ++n) _Pragma("unroll") for (int k = 0; k < 2; ++k) dst[n][k] = *(const PG8_LAS bf16x8*)(lds + PG8_SB(b, h) + boff + n * 2048 + k * 1024); } while (0)
#define PG8_MMA(ai, bj, At, Bt) do { __builtin_amdgcn_s_setprio(1); _Pragma("unroll") for (int m = 0; m < 4; ++m) _Pragma("unroll") for (int n = 0; n < 2; ++n) _Pragma("unroll") for (int k = 0; k < 2; ++k) \
        acc[ai][bj][m][n] = __builtin_amdgcn_mfma_f32_16x16x32_bf16(Bt[n][k], At[m][k], acc[ai][bj][m][n], 0, 0, 0); __builtin_amdgcn_s_setprio(0); } while (0)
#define PG8_WAIT_V(n) asm volatile("s_waitcnt vmcnt(" #n ")" ::: "memory")
#define PG8_WAIT_L(n) asm volatile("s_waitcnt lgkmcnt(" #n ")" ::: "memory")
#define PG8_BAR __builtin_amdgcn_s_barrier()
#define PG8_SCHED __builtin_amdgcn_sched_barrier(0)
    Unit cur, nxt; int ui = 0;
    if (!S.next(0, cur)) return;
    f32x4 acc[2][2][4][2];
#pragma unroll
    for (int a = 0; a < 2; ++a)
#pragma unroll
        for (int b = 0; b < 2; ++b)
#pragma unroll
            for (int m = 0; m < 4; ++m)
#pragma unroll
                for (int n = 0; n < 2; ++n) acc[a][b][m][n] = (f32x4){0.f, 0.f, 0.f, 0.f};
    bf16x8 At[4][2], B0[2][2], B1[2][2];
    const char* cA = (const char*)g.A + (size_t)cur.pm * tstep; const char* cB = (const char*)g.Bt + (size_t)cur.pn * tstep;
    S.a_ready(cur);
    if constexpr (SP2) {
        PG8_STAGE(PG8_SB(0, 0), cB, voffB); PG8_STAGE(PG8_SB(0, 1), cB + hstep, voffB); PG8_STAGE(PG8_SA(0, 0), cA, voffA); PG8_STAGE(PG8_SA(0, 1), cA + hstep, voffA);
        if (wr == 1) PG8_BAR;
        PG8_WAIT_V(2); PG8_BAR;
        PG8_STAGE(PG8_SB(1, 0), cB + kstep, voffB); PG8_STAGE(PG8_SA(1, 0), cA + kstep, voffA); PG8_STAGE(PG8_SB(1, 1), cB + hstep + kstep, voffB);
        PG8_WAIT_V(6); PG8_BAR;
    } else {
        PG8_STAGE(PG8_SB(0, 0), cB, voffB); PG8_STAGE(PG8_SA(0, 0), cA, voffA); PG8_STAGE(PG8_SB(0, 1), cB + hstep, voffB); PG8_STAGE(PG8_SA(0, 1), cA + hstep, voffA);
        if (wr == 1) PG8_BAR;
        PG8_WAIT_V(4); PG8_BAR;
        PG8_STAGE(PG8_SB(1, 0), cB + kstep, voffB); PG8_STAGE(PG8_SA(1, 0), cA + kstep, voffA); PG8_STAGE(PG8_SB(1, 1), cB + hstep + kstep, voffB);
        PG8_WAIT_V(6); PG8_BAR;
    }
    for (;;) {
        const bool has_next = S.next(ui + 1, nxt);
        const char* nA = has_next ? (const char*)g.A + (size_t)nxt.pm * tstep : cA; const char* nB = has_next ? (const char*)g.Bt + (size_t)nxt.pn * tstep : cB;
        for (int t = 0; t < nt; t += 2) {
            const bool last = (t == nt - 2);
            const char* a1 = cA + (size_t)(t + 1) * kstep;
            const char* a2 = last ? nA : cA + (size_t)(t + 2) * kstep; const char* b2 = last ? nB : cB + (size_t)(t + 2) * kstep;
            const char* a3 = a2 + kstep; const char* b3 = b2 + kstep;
            if (last && has_next) S.a_ready(nxt);
            if constexpr (SP2) {
            PG8_LDB(B0, 0, 0); PG8_LDB(B1, 0, 1); PG8_SCHED; PG8_LDA(At, 0, 0); PG8_STAGE(PG8_SA(1, 1), a1 + hstep, voffA);
            PG8_WAIT_V(8); PG8_WAIT_L(0); PG8_BAR; PG8_MMA(0, 0, At, B0); PG8_MMA(0, 1, At, B1); PG8_BAR; PG8_SCHED;
            PG8_LDA(At, 0, 1); PG8_STAGE(PG8_SB(0, 0), b2, voffB); PG8_STAGE(PG8_SB(0, 1), b2 + hstep, voffB); PG8_STAGE(PG8_SA(0, 0), a2, voffA);
            PG8_WAIT_V(8); PG8_WAIT_L(0); PG8_BAR; PG8_MMA(1, 0, At, B0); PG8_MMA(1, 1, At, B1); PG8_BAR; PG8_SCHED;
            PG8_LDB(B0, 1, 0); PG8_LDB(B1, 1, 1); PG8_SCHED; PG8_LDA(At, 1, 0); PG8_STAGE(PG8_SA(0, 1), a2 + hstep, voffA);
            PG8_WAIT_V(8); PG8_WAIT_L(0); PG8_BAR; PG8_MMA(0, 0, At, B0); PG8_MMA(0, 1, At, B1); PG8_BAR; PG8_SCHED;
            PG8_LDA(At, 1, 1); PG8_STAGE(PG8_SB(1, 0), b3, voffB); PG8_STAGE(PG8_SB(1, 1), b3 + hstep, voffB); PG8_STAGE(PG8_SA(1, 0), a3, voffA);
            PG8_WAIT_V(8); PG8_WAIT_L(0); PG8_BAR; PG8_MMA(1, 0, At, B0); PG8_MMA(1, 1, At, B1); PG8_BAR; PG8_SCHED;
            } else {
            PG8_LDB(B0, 0, 0); PG8_SCHED; PG8_LDA(At, 0, 0); PG8_STAGE(PG8_SA(1, 1), a1 + hstep, voffA);
            PG8_WAIT_L(8); PG8_BAR; PG8_WAIT_L(0); PG8_MMA(0, 0, At, B0); PG8_BAR; PG8_SCHED;
            PG8_LDB(B1, 0, 1); PG8_STAGE(PG8_SB(0, 0), b2, voffB);
            PG8_BAR; PG8_WAIT_L(0); PG8_MMA(0, 1, At, B1); PG8_BAR;
            PG8_LDA(At, 0, 1); PG8_STAGE(PG8_SA(0, 0), a2, voffA);
            PG8_BAR; PG8_WAIT_L(0); PG8_MMA(1, 0, At, B0); PG8_BAR; PG8_SCHED;
            PG8_STAGE(PG8_SB(0, 1), b2 + hstep, voffB);
            PG8_WAIT_V(6); PG8_BAR; PG8_MMA(1, 1, At, B1); PG8_BAR;
            PG8_LDB(B0, 1, 0); PG8_SCHED; PG8_LDA(At, 1, 0); PG8_STAGE(PG8_SA(0, 1), a2 + hstep, voffA);
            PG8_WAIT_L(8); PG8_BAR; PG8_WAIT_L(0); PG8_MMA(0, 0, At, B0); PG8_BAR; PG8_SCHED;
            PG8_LDB(B1, 1, 1); PG8_STAGE(PG8_SB(1, 0), b3, voffB);
            PG8_BAR; PG8_WAIT_L(0); PG8_MMA(0, 1, At, B1); PG8_BAR;
            PG8_LDA(At, 1, 1); PG8_STAGE(PG8_SA(1, 0), a3, voffA);
            PG8_BAR; PG8_WAIT_L(0); PG8_MMA(1, 0, At, B0); PG8_BAR; PG8_SCHED;
            PG8_STAGE(PG8_SB(1, 1), b3 + hstep, voffB);
            PG8_WAIT_V(6); PG8_BAR; PG8_MMA(1, 1, At, B1); PG8_BAR;
            }
        }
        if constexpr (ALIGN_EPI) { if (wr == 0) PG8_BAR; }
        if constexpr (!Epi::AFTER_DRAIN) { E(acc, cur, wr, wc, fr, fq); S.done(cur); }
        if (!has_next) break;
#pragma unroll
        for (int a = 0; a < 2; ++a)
#pragma unroll
            for (int b = 0; b < 2; ++b)
#pragma unroll
                for (int m = 0; m < 4; ++m)
#pragma unroll
                    for (int n = 0; n < 2; ++n) acc[a][b][m][n] = (f32x4){0.f, 0.f, 0.f, 0.f};
        cur = nxt; cA = nA; cB = nB; ++ui;
        if constexpr (ALIGN_EPI) { if (wr == 1) PG8_BAR; }
    }
    PG8_WAIT_V(0);
    if constexpr (!ALIGN_EPI) { if (wr == 0) PG8_BAR; }
    PG8_BAR;
    if constexpr (Epi::AFTER_DRAIN) { E.fused(acc, cur, wr, wc, fr, fq, lds, wid, lane); S.done(cur); }
#undef PG8_SA
#undef PG8_SB
#undef PG8_STAGE
#undef PG8_LDA
#undef PG8_LDB
#undef PG8_MMA
#undef PG8_WAIT_V
#undef PG8_WAIT_L
#undef PG8_BAR
#undef PG8_SCHED
}
}
#ifndef PG8_SP2
#define PG8_SP2 true
#endif
#ifndef PG8_ALIGN
#define PG8_ALIGN true
#endif
namespace cg = cooperative_groups;
#define LAS __attribute__((address_space(3)))
typedef unsigned short bf16;
typedef float f32x4 __attribute__((ext_vector_type(4)));
typedef float f32x16 __attribute__((ext_vector_type(16)));
typedef short bf16x8 __attribute__((ext_vector_type(8)));
typedef unsigned u32x4 __attribute__((ext_vector_type(4)));
typedef unsigned u32x2 __attribute__((ext_vector_type(2)));

constexpr int NWAVES = 8;
constexpr int BATCH = 8, SEQ = 8192, DM = 1024, M = BATCH * SEQ, NPROJ = 3072, CHUNK = 64, NCHUNK = SEQ / CHUNK;
constexpr float EPS = 1e-6f, LOG2E = 1.4426950408889634f, SCL = 0.125f * 1.4426950408889634f;
constexpr size_t MiB = 1u << 20;
constexpr size_t WS_WINT = 1 * MiB, WS_WOUTT = 8 * MiB, WS_POOLWT = 10 * MiB, WS_PART = 12 * MiB, WS_XN = 16 * MiB, WS_PROJ = 144 * MiB, WS_VT = 528 * MiB, WS_Y = 592 * MiB, WS_END = 720 * MiB;
constexpr int LDS_BYTES = 147456;

__device__ __forceinline__ unsigned f2bf(float f) { unsigned u = __builtin_bit_cast(unsigned, f); return (u + 0x7fffu + ((u >> 16) & 1u)) >> 16; }
__device__ __forceinline__ unsigned pk2(float lo, float hi) { return f2bf(lo) | (f2bf(hi) << 16); }
typedef float f32x2_t __attribute__((ext_vector_type(2))); typedef __bf16 bf16x2_t __attribute__((ext_vector_type(2)));
__device__ __forceinline__ unsigned pkbf(float lo, float hi) { f32x2_t v = {lo, hi}; bf16x2_t b = __builtin_convertvector(v, bf16x2_t); return __builtin_bit_cast(unsigned, b); }
__device__ __forceinline__ float bf_lo(unsigned w) { return __builtin_bit_cast(float, w << 16); }
__device__ __forceinline__ float bf_hi(unsigned w) { return __builtin_bit_cast(float, w & 0xffff0000u); }
__device__ __forceinline__ float silu_f(float x) { return x * __builtin_amdgcn_rcpf(1.f + __builtin_amdgcn_exp2f(-x * LOG2E)); }
__device__ __forceinline__ float wave_sum(float v) {
#pragma unroll
    for (int o = 1; o < 64; o <<= 1) v += __shfl_xor(v, o);
    return v;
}

__device__ __forceinline__ void p0_transpose_item(const float* W, int K, int N, bf16* WT, LAS float* scr, int item, int lane) {
    const int nblk = N / 32, kb = item / nblk, nb = item % nblk, k0 = 64 * kb, n0 = 32 * nb;
#pragma unroll 8
    for (int i = 0; i < 32; ++i) { const int kk = 2 * i + (lane >> 5); scr[kk * 33 + (lane & 31)] = W[(size_t)(k0 + kk) * N + n0 + (lane & 31)]; }
    asm volatile("s_waitcnt lgkmcnt(0)" ::: "memory");
    const int c = lane & 7;
#pragma unroll
    for (int j = 0; j < 4; ++j) { const int n = (lane >> 3) + 8 * j; const LAS float* s = scr + (8 * c) * 33 + n;
        u32x4 o; o.x = pk2(s[0 * 33], s[1 * 33]); o.y = pk2(s[2 * 33], s[3 * 33]); o.z = pk2(s[4 * 33], s[5 * 33]); o.w = pk2(s[6 * 33], s[7 * 33]);
        *(u32x4*)(WT + (size_t)(n0 + n) * K + k0 + 8 * c) = o; }
    asm volatile("s_waitcnt lgkmcnt(0)" ::: "memory");
}

struct Args { const float* x; const float* norm_gain; const float* w_in; const float* pool_w; const float* pool_scale; const float* rel_bias; const float* w_out; const float* fgain; float* out; unsigned char* ws; };

template <int W> __device__ __forceinline__ bf16x8 pool_dfrag(const bf16* pv, int s) {
    float sum[8], own[8];
#pragma unroll
    for (int e = 0; e < 8; ++e) { sum[e] = 0.f; own[e] = 0.f; }
#pragma unroll
    for (int i = 0; i < W; ++i) {
        u32x4 w = (u32x4){0u, 0u, 0u, 0u};
        if (s - i >= 0) w = *(const u32x4*)(pv - (size_t)i * NPROJ);
        const float f[8] = {bf_lo(w.x), bf_hi(w.x), bf_lo(w.y), bf_hi(w.y), bf_lo(w.z), bf_hi(w.z), bf_lo(w.w), bf_hi(w.w)};
#pragma unroll
        for (int e = 0; e < 8; ++e) { sum[e] += f[e]; if (i == 0) own[e] = f[e]; }
    }
    const int cnt = (s + 1 < W) ? (s + 1) : W; const float inv = 1.f / (float)cnt;
    u32x4 o; o.x = pkbf(sum[0] * inv - own[0], sum[1] * inv - own[1]); o.y = pkbf(sum[2] * inv - own[2], sum[3] * inv - own[3]);
    o.z = pkbf(sum[4] * inv - own[4], sum[5] * inv - own[5]); o.w = pkbf(sum[6] * inv - own[6], sum[7] * inv - own[7]);
    return __builtin_bit_cast(bf16x8, o);
}
template <int W> __device__ __forceinline__ void pool_unit(const bf16* proj, const bf16* poolwt, const float* pool_scale, bf16* Y, int b, int c, int g, int th, int lane) {
    const int r32 = lane & 31, hi = lane >> 5;
    const int s = c * CHUNK + th * 32 + r32; const size_t row = (size_t)b * SEQ + s;
    const bf16* pv = proj + row * NPROJ + g * 128 + 8 * hi;
    const bf16* wt = poolwt + (size_t)(g * 128 + r32) * 128 + 8 * hi;
    f32x16 acc[4];
#pragma unroll
    for (int db = 0; db < 4; ++db)
#pragma unroll
        for (int i = 0; i < 16; ++i) acc[db][i] = 0.f;
#pragma unroll 1
    for (int ks = 0; ks < 8; ++ks) {
        const bf16x8 df = pool_dfrag<W>(pv + 16 * ks, s);
#pragma unroll
        for (int db = 0; db < 4; ++db) { const bf16x8 wf = *(const bf16x8*)(wt + db * 32 * 128 + 16 * ks); acc[db] = __builtin_amdgcn_mfma_f32_32x32x16_bf16(wf, df, acc[db], 0, 0, 0); }
    }
#pragma unroll
    for (int db = 0; db < 4; ++db)
#pragma unroll
        for (int i4 = 0; i4 < 4; ++i4) { const int dd = g * 128 + 32 * db + 8 * i4 + 4 * hi;
            const u32x2 gw = *(const u32x2*)(proj + row * NPROJ + 512 + dd); const f32x4 sc = *(const f32x4*)(pool_scale + dd);
            const float o0 = acc[db][4 * i4 + 0] * sc[0] * silu_f(bf_lo(gw.x)), o1 = acc[db][4 * i4 + 1] * sc[1] * silu_f(bf_hi(gw.x));
            const float o2 = acc[db][4 * i4 + 2] * sc[2] * silu_f(bf_lo(gw.y)), o3 = acc[db][4 * i4 + 3] * sc[3] * silu_f(bf_hi(gw.y));
            u32x2 ow; ow.x = pkbf(o0, o1); ow.y = pkbf(o2, o3); *(u32x2*)(Y + row * DM + dd) = ow; }
}
__device__ __forceinline__ void attn_unit(const bf16* proj, const bf16* VT, bf16* Y, const LAS float* tab, int b, int c, int h, int lane) {
    const int r32 = lane & 31, hi = lane >> 5;
    const int jstart = (c < 8) ? (8 - c) : 0;
    for (int qh = 0; qh < 2; ++qh) {
        const size_t rowq = (size_t)b * SEQ + c * CHUNK + qh * 32 + r32;
        bf16x8 qf[4];
#pragma unroll
        for (int ds = 0; ds < 4; ++ds) qf[ds] = *(const bf16x8*)(proj + rowq * NPROJ + 1024 + h * 64 + 16 * ds + 8 * hi);
        float m = -1e30f, l = 0.f; f32x16 o[2];
#pragma unroll
        for (int db = 0; db < 2; ++db)
#pragma unroll
            for (int i = 0; i < 16; ++i) o[db][i] = 0.f;
        const int qq = qh * 32 + r32;
        for (int j = jstart; j <= 8; ++j) {
            const int kc = c - 8 + j; const size_t krow0 = (size_t)b * SEQ + (size_t)kc * CHUNK;
            f32x16 sc[2];
#pragma unroll
            for (int kb = 0; kb < 2; ++kb) {
#pragma unroll
                for (int i = 0; i < 16; ++i) sc[kb][i] = 0.f;
#pragma unroll
                for (int ds = 0; ds < 4; ++ds) { const bf16x8 kf = *(const bf16x8*)(proj + (krow0 + 32 * kb + r32) * NPROJ + 1536 + h * 64 + 16 * ds + 8 * hi);
                    sc[kb] = __builtin_amdgcn_mfma_f32_32x32x16_bf16(kf, qf[ds], sc[kb], 0, 0, 0); }
            }
            if (j <= 6) { const float b0 = tab[0];
#pragma unroll
                for (int kb = 0; kb < 2; ++kb)
#pragma unroll
                    for (int i = 0; i < 16; ++i) sc[kb][i] = sc[kb][i] * SCL + b0;
            } else {
#pragma unroll
                for (int kb = 0; kb < 2; ++kb)
#pragma unroll
                    for (int i = 0; i < 16; ++i) { const int kk = 32 * kb + (i & 3) + 8 * (i >> 2) + 4 * hi; int idx = kk - qq; idx = (j == 8) ? (idx + 64) : (idx > 0 ? idx : 0);
                        sc[kb][i] = sc[kb][i] * SCL + tab[idx]; }
            }
            float mt = sc[0][0];
#pragma unroll
            for (int kb = 0; kb < 2; ++kb)
#pragma unroll
                for (int i = 0; i < 16; ++i) mt = fmaxf(mt, sc[kb][i]);
            mt = fmaxf(mt, __shfl_xor(mt, 32));
            const float mn = fmaxf(m, mt); const float alpha = __builtin_amdgcn_exp2f(m - mn); m = mn;
            float ls = 0.f;
#pragma unroll
            for (int kb = 0; kb < 2; ++kb)
#pragma unroll
                for (int i = 0; i < 16; ++i) { const float p = __builtin_amdgcn_exp2f(sc[kb][i] - mn); sc[kb][i] = p; ls += p; }
            l = l * alpha + ls;
#pragma unroll
            for (int db = 0; db < 2; ++db)
#pragma unroll
                for (int i = 0; i < 16; ++i) o[db][i] *= alpha;
#pragma unroll
            for (int kb = 0; kb < 2; ++kb)
#pragma unroll
                for (int s2 = 0; s2 < 2; ++s2) {
                    u32x4 pw; pw.x = pkbf(sc[kb][8 * s2 + 0], sc[kb][8 * s2 + 1]); pw.y = pkbf(sc[kb][8 * s2 + 2], sc[kb][8 * s2 + 3]);
                    pw.z = pkbf(sc[kb][8 * s2 + 4], sc[kb][8 * s2 + 5]); pw.w = pkbf(sc[kb][8 * s2 + 6], sc[kb][8 * s2 + 7]);
                    const bf16x8 pf = __builtin_bit_cast(bf16x8, pw);
#pragma unroll
                    for (int db = 0; db < 2; ++db) {
                        const bf16* vp = VT + (size_t)(b * 512 + h * 64 + 32 * db + r32) * SEQ + (size_t)kc * CHUNK + 32 * kb + 16 * s2 + 4 * hi;
                        const u32x2 v0 = *(const u32x2*)vp, v1 = *(const u32x2*)(vp + 8);
                        u32x4 vw; vw.x = v0.x; vw.y = v0.y; vw.z = v1.x; vw.w = v1.y;
                        o[db] = __builtin_amdgcn_mfma_f32_32x32x16_bf16(__builtin_bit_cast(bf16x8, vw), pf, o[db], 0, 0, 0);
                    }
                }
        }
        l += __shfl_xor(l, 32); const float inv = 1.f / l;
#pragma unroll
        for (int db = 0; db < 2; ++db)
#pragma unroll
            for (int i4 = 0; i4 < 4; ++i4) { const int d = h * 64 + 32 * db + 8 * i4 + 4 * hi;
                const u32x2 gw = *(const u32x2*)(proj + rowq * NPROJ + 2560 + d);
                const float o0 = o[db][4 * i4 + 0] * inv * silu_f(bf_lo(gw.x)), o1 = o[db][4 * i4 + 1] * inv * silu_f(bf_hi(gw.x));
                const float o2 = o[db][4 * i4 + 2] * inv * silu_f(bf_lo(gw.y)), o3 = o[db][4 * i4 + 3] * inv * silu_f(bf_hi(gw.y));
                u32x2 ow; ow.x = pkbf(o0, o1); ow.y = pkbf(o2, o3); *(u32x2*)(Y + rowq * DM + 512 + d) = ow; }
    }
}

__global__ void __launch_bounds__(NWAVES * 64, 2) fwd_mega(Args a) {
    extern __shared__ __attribute__((aligned(16))) unsigned char lds[];
    cg::grid_group grid = cg::this_grid();
    const int tid = threadIdx.x, lane = tid & 63, wave = __builtin_amdgcn_readfirstlane(tid >> 6);
    const int G = gridDim.x, bx = blockIdx.x; const int vcu = (G % 8 == 0) ? (bx % 8) * (G / 8) + bx / 8 : bx;
    unsigned char* ws = a.ws;
    bf16* WinT = (bf16*)(ws + WS_WINT); bf16* WoutT = (bf16*)(ws + WS_WOUTT); bf16* PoolWT = (bf16*)(ws + WS_POOLWT);
    float* part = (float*)(ws + WS_PART); bf16* XN = (bf16*)(ws + WS_XN); bf16* PROJ = (bf16*)(ws + WS_PROJ); bf16* VT = (bf16*)(ws + WS_VT); bf16* Y = (bf16*)(ws + WS_Y);
    const int gw = vcu * NWAVES + wave, NGW = G * NWAVES;

    {
        LAS float* scr = (LAS float*)((LAS unsigned char*)lds + wave * 16384);
        constexpr int I_IN = (DM / 64) * (NPROJ / 32), I_OUT = (DM / 64) * (DM / 32), I_PW = (128 / 64) * (128 / 32);
        constexpr int NITEMS = I_IN + I_OUT + 4 * I_PW;
        for (int it = gw; it < NITEMS; it += NGW) {
            int r = it;
            if (r < I_IN) { p0_transpose_item(a.w_in, DM, NPROJ, WinT, scr, r, lane); continue; } r -= I_IN;
            if (r < I_OUT) { p0_transpose_item(a.w_out, DM, DM, WoutT, scr, r, lane); continue; } r -= I_OUT;
            const int g = r / I_PW; r -= g * I_PW;
            p0_transpose_item(a.pool_w + (size_t)g * 128 * 128, 128, 128, PoolWT + (size_t)g * 128 * 128, scr, r, lane);
        }
        f32x4 gv[4];
#pragma unroll
        for (int j = 0; j < 4; ++j) gv[j] = ((const f32x4*)a.norm_gain)[lane + 64 * j];
        for (int m = gw; m < M; m += NGW) {
            const f32x4* xr = (const f32x4*)(a.x + (size_t)m * DM) + lane;
            f32x4 v[4]; float ss = 0.f;
#pragma unroll
            for (int j = 0; j < 4; ++j) { v[j] = xr[64 * j]; ss += (v[j][0] * v[j][0] + v[j][1] * v[j][1]) + (v[j][2] * v[j][2] + v[j][3] * v[j][3]); }
            const float rstd = 1.0f / sqrtf(wave_sum(ss) * (1.f / DM) + EPS);
            unsigned long long* o8 = (unsigned long long*)(XN + (size_t)m * DM) + lane;
#pragma unroll
            for (int j = 0; j < 4; ++j) { const f32x4 t = v[j] * rstd * gv[j]; o8[64 * j] = (unsigned long long)pkbf(t[0], t[1]) | ((unsigned long long)pkbf(t[2], t[3]) << 32); }
        }
    }
    grid.sync();

    {
        pg8::Gemm g{XN, WinT, M, NPROJ, DM}; pg8::StaticOrder S; S.init(M, NPROJ, G, bx);
        pg8::EpiProj E{PROJ, VT};
        pg8::gemm_phase<pg8::EpiProj, pg8::StaticOrder, PG8_ALIGN, PG8_SP2>((PG8_LAS unsigned char*)lds, g, S, E);
    }
    grid.sync();

    {
        LAS float* tab = (LAS float*)lds;
        for (int i = tid; i < 8 * 129; i += NWAVES * 64) tab[i] = a.rel_bias[i] * LOG2E;
        __syncthreads();
        for (int unit = vcu; unit < BATCH * NCHUNK; unit += G) {
            const int b = unit / NCHUNK, c = unit % NCHUNK;
            const int g = wave >> 1, th = wave & 1;
            switch (g) {
                case 0: pool_unit<2>(PROJ, PoolWT, a.pool_scale, Y, b, c, 0, th, lane); break;
                case 1: pool_unit<4>(PROJ, PoolWT, a.pool_scale, Y, b, c, 1, th, lane); break;
                case 2: pool_unit<8>(PROJ, PoolWT, a.pool_scale, Y, b, c, 2, th, lane); break;
                default: pool_unit<16>(PROJ, PoolWT, a.pool_scale, Y, b, c, 3, th, lane); break;
            }
            attn_unit(PROJ, VT, Y, tab + wave * 129, b, c, wave, lane);
        }
    }
    grid.sync();

    {
        pg8::Gemm g{Y, WoutT, M, DM, DM}; pg8::StaticOrder S; S.init(M, DM, G, bx);
        pg8::EpiOut E{a.x, a.out, part};
        pg8::gemm_phase<pg8::EpiOut, pg8::StaticOrder, PG8_ALIGN, PG8_SP2>((PG8_LAS unsigned char*)lds, g, S, E);
    }
    grid.sync();

    {
        f32x4 gv[4];
#pragma unroll
        for (int j = 0; j < 4; ++j) gv[j] = ((const f32x4*)a.fgain)[lane + 64 * j];
        for (int m = gw; m < M; m += NGW) {
            float ps = (lane < 16) ? part[(size_t)m * 16 + lane] : 0.f;
            const float rstd = 1.0f / sqrtf(wave_sum(ps) * (1.f / DM) + EPS);
            f32x4* xr = (f32x4*)(a.out + (size_t)m * DM) + lane;
#pragma unroll
            for (int j = 0; j < 4; ++j) { const f32x4 v = xr[64 * j]; xr[64 * j] = v * rstd * gv[j]; }
        }
    }
}

extern "C" void kernel_launch(void* const* d_in, const int* in_sizes, int n_in, void* d_out, int out_size, void* d_ws, size_t ws_size, hipStream_t stream) {
    static int grid = 0;
    if (grid == 0) {
        if (n_in != 8 || in_sizes[0] != M * DM || out_size != M * DM || ws_size < WS_END) { fprintf(stderr, "kernel_launch: unexpected shapes (n_in %d, in0 %d, out %d, ws %zu); nothing launched\n", n_in, n_in > 0 ? in_sizes[0] : -1, out_size, ws_size); grid = -1; return; }
        int dev = 0, cus = 0, per_cu = 0;
        if (hipGetDevice(&dev) != hipSuccess || hipDeviceGetAttribute(&cus, hipDeviceAttributeMultiprocessorCount, dev) != hipSuccess) { fprintf(stderr, "kernel_launch: device query failed\n"); grid = -1; return; }
        if (hipFuncSetAttribute((const void*)fwd_mega, hipFuncAttributeMaxDynamicSharedMemorySize, LDS_BYTES) != hipSuccess) { fprintf(stderr, "kernel_launch: hipFuncSetAttribute failed\n"); grid = -1; return; }
        if (hipOccupancyMaxActiveBlocksPerMultiprocessor(&per_cu, (const void*)fwd_mega, NWAVES * 64, LDS_BYTES) != hipSuccess || per_cu < 1) { fprintf(stderr, "kernel_launch: occupancy query gave %d blocks per CU\n", per_cu); (void)hipGetLastError(); grid = -1; return; }
        grid = cus * per_cu;
    }
    if (grid < 0) return;
    Args a{};
    a.x = (const float*)d_in[0]; a.norm_gain = (const float*)d_in[1]; a.w_in = (const float*)d_in[2]; a.pool_w = (const float*)d_in[3]; a.pool_scale = (const float*)d_in[4];
    a.rel_bias = (const float*)d_in[5]; a.w_out = (const float*)d_in[6]; a.fgain = (const float*)d_in[7]; a.out = (float*)d_out; a.ws = (unsigned char*)d_ws;
    void* args[] = {&a};
    hipError_t e = hipLaunchCooperativeKernel((const void*)fwd_mega, dim3(grid), dim3(NWAVES * 64), args, LDS_BYTES, stream);
    if (e != hipSuccess) fprintf(stderr, "kernel_launch: cooperative launch failed: %s (grid %d)\n", hipGetErrorString(e), grid);
}
```

```cpp
#include <hip/hip_runtime.h>
#include <hip/hip_cooperative_groups.h>
#include <cstdio>
#include <cstdint>
namespace pg8 {
#define PG8_LAS __attribute__((address_space(3)))
typedef unsigned short bf16_t;
typedef short bf16x8 __attribute__((ext_vector_type(8)));
typedef float f32x4 __attribute__((ext_vector_type(4)));
typedef unsigned u32x4 __attribute__((ext_vector_type(4)));
constexpr int BM = 256, BK = 64, HALF = 128, HTB = HALF * BK * 2  , STAGE_BYTES = 8 * HTB, NXCD = 8, WGM = 8;

__host__ __device__ __forceinline__ int lds_byte(int r, int c) { const int st = (r >> 4) * 2 + (c >> 5), rr = r & 15, cc = c & 31, ob = rr * 64 + cc * 2; return st * 1024 + (ob ^ (((ob >> 9) & 1) << 5)); }
__host__ __device__ __forceinline__ void stage_rc(int b, int& R, int& C) { const int st = b / 1024, sb = b % 1024, swz = sb ^ (((sb >> 9) & 1) << 5); R = (st >> 1) * 16 + swz / 64; C = (st & 1) * 32 + (swz % 64) / 2; }
__host__ __device__ __forceinline__ int perm32(int rho) { const int n = rho >> 4, i = rho & 15; return 8 * (i >> 2) + 4 * n + (i & 3); }

struct Unit { int pm, pn; };
struct Gemm { const bf16_t* A; const bf16_t* Bt; int M, N, K; };

struct StaticOrder {
    int nM, nN, nwg, G, c;
    __host__ __device__ void init(int M, int N, int G_, int c_) { nM = M / BM; nN = N / BM; nwg = nM * nN; G = G_; c = c_; }
    __host__ __device__ bool next(int i, Unit& u) const {
        const long L = (long)i * G + c; if (L >= nwg) return false;
        int wgid = (int)L; { const int q = nwg / NXCD, r = nwg % NXCD, xcd = wgid % NXCD, off = wgid / NXCD; wgid = (xcd < r ? xcd * (q + 1) : r * (q + 1) + (xcd - r) * q) + off; }
        const int nig = WGM * nN, gid = wgid / nig, fm = gid * WGM, gsz = (nM - fm) < WGM ? (nM - fm) : WGM;
        u.pm = fm + ((wgid % nig) % gsz); u.pn = (wgid % nig) / gsz; return true;
    }
    __device__ __forceinline__ void a_ready(const Unit&) const {}
    __device__ __forceinline__ void done(const Unit&) const {}
};

__device__ __forceinline__ unsigned cvt_pk_bf16(float lo, float hi) { unsigned r; asm volatile("v_cvt_pk_bf16_f32 %0, %1, %2" : "=v"(r) : "v"(lo), "v"(hi)); return r; }
__device__ __forceinline__ unsigned short bf16_1(float v) { return (unsigned short)(cvt_pk_bf16(v, v) & 0xffffu); }
struct EpiProj {
    static constexpr bool PERM = true, AFTER_DRAIN = false;
    bf16_t* P; bf16_t* KF; bf16_t* VF;
    __device__ __forceinline__ void operator()(const f32x4 (&acc)[2][2][4][2], const Unit& u, int wr, int wc, int fr, int fq) const {
        const int row0 = u.pm * BM + wr * 64 + fr, col0 = u.pn * BM + wc * 32 + 8 * fq;
        if (u.pn == 6 || u.pn == 7) {
            const int b = row0 >> 13, s0 = row0 & 8191;
#pragma unroll
            for (int ai = 0; ai < 2; ++ai)
#pragma unroll
                for (int m = 0; m < 4; ++m) { const int s = s0 + ai * HALF + m * 16;
#pragma unroll
                    for (int bj = 0; bj < 2; ++bj) { const int ck = col0 - 1536 + bj * HALF, h = ck >> 6, d0 = ck & 63;
                        const size_t idx = ((((((size_t)(b * 8 + h) * 256 + (s >> 5)) * 4 + (d0 >> 4)) * 2 + ((d0 >> 3) & 1)) * 32 + (s & 31))) * 8;
                        const f32x4 v0 = acc[ai][bj][m][0], v1 = acc[ai][bj][m][1];
                        u32x4 w; w.x = cvt_pk_bf16(v0[0], v0[1]); w.y = cvt_pk_bf16(v0[2], v0[3]); w.z = cvt_pk_bf16(v1[0], v1[1]); w.w = cvt_pk_bf16(v1[2], v1[3]);
                        *(u32x4*)(KF + idx) = w; } }
        } else if (u.pn == 8 || u.pn == 9) {
            const int b = row0 >> 13, s0 = row0 & 8191;
#pragma unroll
            for (int ai = 0; ai < 2; ++ai)
#pragma unroll
                for (int m = 0; m < 4; ++m) { const int s = s0 + ai * HALF + m * 16;
                    const int sj = ((s >> 3) & 1) * 4 + (s & 3), shi = (s >> 2) & 1, ss2 = (s >> 4) & 1, sblk = s >> 5;
#pragma unroll
                    for (int bj = 0; bj < 2; ++bj) { const int cv = col0 - 2048 + bj * HALF, h = cv >> 6, d0 = cv & 63;
                        bf16_t* base = VF + (((((((size_t)(b * 8 + h) * 256 + sblk) * 2 + ss2) * 2 + (d0 >> 5)) * 2 + shi) * 32 + (d0 & 31))) * 8 + sj;
#pragma unroll
                        for (int n = 0; n < 2; ++n)
#pragma unroll
                            for (int e = 0; e < 4; ++e) base[(4 * n + e) * 8] = bf16_1(acc[ai][bj][m][n][e]); } }
        } else {
#pragma unroll
            for (int ai = 0; ai < 2; ++ai)
#pragma unroll
                for (int m = 0; m < 4; ++m) { bf16_t* rowp = P + (size_t)(row0 + ai * HALF + m * 16) * 3072 + col0;
#pragma unroll
                    for (int bj = 0; bj < 2; ++bj) { const f32x4 v0 = acc[ai][bj][m][0], v1 = acc[ai][bj][m][1];
                        u32x4 w; w.x = cvt_pk_bf16(v0[0], v0[1]); w.y = cvt_pk_bf16(v0[2], v0[3]); w.z = cvt_pk_bf16(v1[0], v1[1]); w.w = cvt_pk_bf16(v1[2], v1[3]);
                        *(u32x4*)(rowp + bj * HALF) = w; } }
        }
    }
};
struct EpiOut {
    static constexpr bool PERM = false, AFTER_DRAIN = false;
    const float* X; float* O; float* part;
    __device__ __forceinline__ void operator()(const f32x4 (&acc)[2][2][4][2], const Unit& u, int wr, int wc, int fr, int fq) const {
        const int row0 = u.pm * BM + wr * 64 + fr, col0 = u.pn * BM + wc * 32 + 4 * fq;
#pragma unroll
        for (int ai = 0; ai < 2; ++ai)
#pragma unroll
            for (int m = 0; m < 4; ++m) { const int row = row0 + ai * HALF + m * 16; const size_t off = (size_t)row * 1024 + col0; float ss = 0.f;
#pragma unroll
                for (int bj = 0; bj < 2; ++bj)
#pragma unroll
                    for (int n = 0; n < 2; ++n) { const f32x4 xv = *(const f32x4*)(X + off + bj * HALF + n * 16); const f32x4 o = xv + acc[ai][bj][m][n];
                        *(f32x4*)(O + off + bj * HALF + n * 16) = o; ss += (o[0] * o[0] + o[1] * o[1]) + (o[2] * o[2] + o[3] * o[3]); }
                ss += __shfl_xor(ss, 16); ss += __shfl_xor(ss, 32);
                if (fq == 0) part[(size_t)row * 16 + u.pn * 4 + wc] = ss; }
    }
};
template <class Epi, class Sched, bool ALIGN_EPI = false, bool SP2 = false>
__device__ __forceinline__ void gemm_phase(PG8_LAS unsigned char* lds, const Gemm g, const Sched& S, const Epi& E) {
    const int tid = threadIdx.x, wid = __builtin_amdgcn_readfirstlane(tid >> 6), lane = tid & 63, wr = wid >> 2, wc = wid & 3, fr = lane & 15, fq = lane >> 4;
    const int K = g.K, nt = K / BK;
    unsigned voffA[2], voffB[2];
#pragma unroll
    for (int i = 0; i < 2; ++i) { int R, C; stage_rc(tid * 16 + i * 8192, R, C); const int Rb = Epi::PERM ? ((R & ~31) + perm32(R & 31)) : R;
        voffA[i] = (unsigned)(R * K + C) * 2u; voffB[i] = (unsigned)(Rb * K + C) * 2u; }
    const size_t kstep = (size_t)(BK * 2);
    const size_t hstep = (size_t)HALF * K * 2;
    const size_t tstep = 2 * hstep;
    const unsigned ldsw = (unsigned)wid * 1024u;
    const int aoff = lds_byte(wr * 64 + fr, fq * 8), boff = lds_byte(wc * 32 + fr, fq * 8);
#define PG8_SA(b, h) (((b) * 2 + (h)) * HTB)
#define PG8_SB(b, h) ((4 + (b) * 2 + (h)) * HTB)
#define PG8_STAGE(bufoff, gbase, voff) do { _Pragma("unroll") for (int _i = 0; _i < 2; ++_i) \
        __builtin_amdgcn_global_load_lds((const unsigned*)((const char*)(gbase) + (voff)[_i]), (PG8_LAS unsigned*)(lds + (bufoff) + ldsw + _i * 8192), 16, 0, 0); } while (0)
#define PG8_LDA(dst, b, h) do { _Pragma("unroll") for (int m = 0; m < 4; ++m) _Pragma("unroll") for (int k = 0; k < 2; ++k) dst[m][k] = *(const PG8_LAS bf16x8*)(lds + PG8_SA(b, h) + aoff + m * 2048 + k * 1024); } while (0)
#define PG8_LDB(dst, b, h) do { _Pragma("unroll") for (int n = 0; n < 2; ++n) _Pragma("unroll") for (int k = 0; k < 2; ++k) dst[n][k] = *(const PG8_LAS bf16x8*)(lds + PG8_SB(b, h) + boff + n * 2048 + k * 1024); } while (0)
#define PG8_MMA(ai, bj, At, Bt) do { __builtin_amdgcn_s_setprio(1); _Pragma("unroll") for (int m = 0; m < 4; ++m) _Pragma("unroll") for (int n = 0; n < 2; ++n) _Pragma("unroll") for (int k = 0; k < 2; ++k) \
        acc[ai][bj][m][n] = __builtin_amdgcn_mfma_f32_16x16x32_bf16(Bt[n][k], At[m][k], acc[ai][bj][m][n], 0, 0, 0); __builtin_amdgcn_s_setprio(0); } while (0)
#define PG8_WAIT_V(n) asm volatile("s_waitcnt vmcnt(" #n ")" ::: "memory")
#define PG8_WAIT_L(n) asm volatile("s_waitcnt lgkmcnt(" #n ")" ::: "memory")
#define PG8_BAR __builtin_amdgcn_s_barrier()
#define PG8_SCHED __builtin_amdgcn_sched_barrier(0)
    Unit cur, nxt; int ui = 0;
    if (!S.next(0, cur)) return;
    f32x4 acc[2][2][4][2];
#pragma unroll
    for (int a = 0; a < 2; ++a)
#pragma unroll
        for (int b = 0; b < 2; ++b)
#pragma unroll
            for (int m = 0; m < 4; ++m)
#pragma unroll
                for (int n = 0; n < 2; ++n) acc[a][b][m][n] = (f32x4){0.f, 0.f, 0.f, 0.f};
    bf16x8 At[4][2], B0[2][2], B1[2][2];
    const char* cA = (const char*)g.A + (size_t)cur.pm * tstep; const char* cB = (const char*)g.Bt + (size_t)cur.pn * tstep;
    S.a_ready(cur);
    if constexpr (SP2) {
        PG8_STAGE(PG8_SB(0, 0), cB, voffB); PG8_STAGE(PG8_SB(0, 1), cB + hstep, voffB); PG8_STAGE(PG8_SA(0, 0), cA, voffA); PG8_STAGE(PG8_SA(0, 1), cA + hstep, voffA);
        if (wr == 1) PG8_BAR;
        PG8_WAIT_V(2); PG8_BAR;
        PG8_STAGE(PG8_SB(1, 0), cB + kstep, voffB); PG8_STAGE(PG8_SA(1, 0), cA + kstep, voffA); PG8_STAGE(PG8_SB(1, 1), cB + hstep + kstep, voffB);
        PG8_WAIT_V(6); PG8_BAR;
    } else {
        PG8_STAGE(PG8_SB(0, 0), cB, voffB); PG8_STAGE(PG8_SA(0, 0), cA, voffA); PG8_STAGE(PG8_SB(0, 1), cB + hstep, voffB); PG8_STAGE(PG8_SA(0, 1), cA + hstep, voffA);
        if (wr == 1) PG8_BAR;
        PG8_WAIT_V(4); PG8_BAR;
        PG8_STAGE(PG8_SB(1, 0), cB + kstep, voffB); PG8_STAGE(PG8_SA(1, 0), cA + kstep, voffA); PG8_STAGE(PG8_SB(1, 1), cB + hstep + kstep, voffB);
        PG8_WAIT_V(6); PG8_BAR;
    }
    for (;;) {
        const bool has_next = S.next(ui + 1, nxt);
        const char* nA = has_next ? (const char*)g.A + (size_t)nxt.pm * tstep : cA; const char* nB = has_next ? (const char*)g.Bt + (size_t)nxt.pn * tstep : cB;
        for (int t = 0; t < nt; t += 2) {
            const bool last = (t == nt - 2);
            const char* a1 = cA + (size_t)(t + 1) * kstep;
            const char* a2 = last ? nA : cA + (size_t)(t + 2) * kstep; const char* b2 = last ? nB : cB + (size_t)(t + 2) * kstep;
            const char* a3 = a2 + kstep; const char* b3 = b2 + kstep;
            if (last && has_next) S.a_ready(nxt);
            if constexpr (SP2) {
            PG8_LDB(B0, 0, 0); PG8_LDB(B1, 0, 1); PG8_SCHED; PG8_LDA(At, 0, 0); PG8_STAGE(PG8_SA(1, 1), a1 + hstep, voffA);
            PG8_WAIT_V(8); PG8_WAIT_L(0); PG8_BAR; PG8_MMA(0, 0, At, B0); PG8_MMA(0, 1, At, B1); PG8_BAR; PG8_SCHED;
            PG8_LDA(At, 0, 1); PG8_STAGE(PG8_SB(0, 0), b2, voffB); PG8_STAGE(PG8_SB(0, 1), b2 + hstep, voffB); PG8_STAGE(PG8_SA(0, 0), a2, voffA);
            PG8_WAIT_V(8); PG8_WAIT_L(0); PG8_BAR; PG8_MMA(1, 0, At, B0); PG8_MMA(1, 1, At, B1); PG8_BAR; PG8_SCHED;
            PG8_LDB(B0, 1, 0); PG8_LDB(B1, 1, 1); PG8_SCHED; PG8_LDA(At, 1, 0); PG8_STAGE(PG8_SA(0, 1), a2 + hstep, voffA);
            PG8_WAIT_V(8); PG8_WAIT_L(0); PG8_BAR; PG8_MMA(0, 0, At, B0); PG8_MMA(0, 1, At, B1); PG8_BAR; PG8_SCHED;
            PG8_LDA(At, 1, 1); PG8_STAGE(PG8_SB(1, 0), b3, voffB); PG8_STAGE(PG8_SB(1, 1), b3 + hstep, voffB); PG8_STAGE(PG8_SA(1, 0), a3, voffA);
            PG8_WAIT_V(8); PG8_WAIT_L(0); PG8_BAR; PG8_MMA(1, 0, At, B0); PG8_MMA(1, 1, At, B1); PG8_BAR; PG8_SCHED;
            } else {
            PG8_LDB(B0, 0, 0); PG8_SCHED; PG8_LDA(At, 0, 0); PG8_STAGE(PG8_SA(1, 1), a1 + hstep, voffA);
            PG8_WAIT_L(8); PG8_BAR; PG8_WAIT_L(0); PG8_MMA(0, 0, At, B0); PG8_BAR; PG8_SCHED;
            PG8_LDB(B1, 0, 1); PG8_STAGE(PG8_SB(0, 0), b2, voffB);
            PG8_BAR; PG8_WAIT_L(0); PG8_MMA(0, 1, At, B1); PG8_BAR;
            PG8_LDA(At, 0, 1); PG8_STAGE(PG8_SA(0, 0), a2, voffA);
            PG8_BAR; PG8_WAIT_L(0); PG8_MMA(1, 0, At, B0); PG8_BAR; PG8_SCHED;
            PG8_STAGE(PG8_SB(0, 1), b2 + hstep, voffB);
            PG8_WAIT_V(6); PG8_BAR; PG8_MMA(1, 1, At, B1); PG8_BAR;
            PG8_LDB(B0, 1, 0); PG8_SCHED; PG8_LDA(At, 1, 0); PG8_STAGE(PG8_SA(0, 1), a2 + hstep, voffA);
            PG8_WAIT_L(8); PG8_BAR; PG8_WAIT_L(0); PG8_MMA(0, 0, At, B0); PG8_BAR; PG8_SCHED;
            PG8_LDB(B1, 1, 1); PG8_STAGE(PG8_SB(1, 0), b3, voffB);
            PG8_BAR; PG8_WAIT_L(0); PG8_MMA(0, 1, At, B1); PG8_BAR;
            PG8_LDA(At, 1, 1); PG8_STAGE(PG8_SA(1, 0), a3, voffA);
            PG8_BAR; PG8_WAIT_L(0); PG8_MMA(1, 0, At, B0); PG8_BAR; PG8_SCHED;
            PG8_STAGE(PG8_SB(1, 1), b3 + hstep, voffB);
            PG8_WAIT_V(6); PG8_BAR; PG8_MMA(1, 1, At, B1); PG8_BAR;
            }
        }
        if constexpr (ALIGN_EPI) { if (wr == 0) PG8_BAR; }
        if constexpr (!Epi::AFTER_DRAIN) { E(acc, cur, wr, wc, fr, fq); S.done(cur); }
        if (!has_next) break;
#pragma unroll
        for (int a = 0; a < 2; ++a)
#pragma unroll
            for (int b = 0; b < 2; ++b)
#pragma unroll
                for (int m = 0; m < 4; ++m)
#pragma unroll
                    for (int n = 0; n < 2; ++n) acc[a][b][m][n] = (f32x4){0.f, 0.f, 0.f, 0.f};
        cur = nxt; cA = nA; cB = nB; ++ui;
        if constexpr (ALIGN_EPI) { if (wr == 1) PG8_BAR; }
    }
    PG8_WAIT_V(0);
    if constexpr (!ALIGN_EPI) { if (wr == 0) PG8_BAR; }
    PG8_BAR;
    if constexpr (Epi::AFTER_DRAIN) { E.fused(acc, cur, wr, wc, fr, fq, lds, wid, lane); S.done(cur); }
#undef PG8_SA
#undef PG8_SB
#undef PG8_STAGE
#undef PG8_LDA
#undef PG8_LDB
#undef PG8_MMA
#undef PG8_WAIT_V
#undef PG8_WAIT_L
#undef PG8_BAR
#undef PG8_SCHED
}
}
#ifndef PG8_SP2
#define PG8_SP2 true
#endif
#ifndef PG8_ALIGN
#define PG8_ALIGN true
#endif
namespace cg = cooperative_groups;
#define LAS __attribute__((address_space(3)))
typedef unsigned short bf16;
typedef float f32x4 __attribute__((ext_vector_type(4)));
typedef float f32x16 __attribute__((ext_vector_type(16)));
typedef short bf16x8 __attribute__((ext_vector_type(8)));
typedef unsigned u32x4 __attribute__((ext_vector_type(4)));
typedef unsigned u32x2 __attribute__((ext_vector_type(2)));

constexpr int NWAVES = 8;
constexpr int BATCH = 8, SEQ = 8192, DM = 1024, M = BATCH * SEQ, NPROJ = 3072, CHUNK = 64, NCHUNK = SEQ / CHUNK;
constexpr float EPS = 1e-6f, LOG2E = 1.4426950408889634f, SCL = 0.125f * 1.4426950408889634f;
constexpr size_t MiB = 1u << 20;
constexpr size_t WS_WINT = 1 * MiB, WS_WOUTT = 8 * MiB, WS_POOLWT = 10 * MiB, WS_PART = 12 * MiB, WS_XN = 16 * MiB, WS_PROJ = 144 * MiB, WS_VT = 528 * MiB, WS_Y = 592 * MiB, WS_KF = 720 * MiB, WS_END = 784 * MiB;
constexpr int LDS_BYTES = 147456;

__device__ __forceinline__ unsigned f2bf(float f) { unsigned u = __builtin_bit_cast(unsigned, f); return (u + 0x7fffu + ((u >> 16) & 1u)) >> 16; }
__device__ __forceinline__ unsigned pk2(float lo, float hi) { return f2bf(lo) | (f2bf(hi) << 16); }
typedef float f32x2_t __attribute__((ext_vector_type(2))); typedef __bf16 bf16x2_t __attribute__((ext_vector_type(2)));
__device__ __forceinline__ unsigned pkbf(float lo, float hi) { f32x2_t v = {lo, hi}; bf16x2_t b = __builtin_convertvector(v, bf16x2_t); return __builtin_bit_cast(unsigned, b); }
__device__ __forceinline__ float bf_lo(unsigned w) { return __builtin_bit_cast(float, w << 16); }
__device__ __forceinline__ float bf_hi(unsigned w) { return __builtin_bit_cast(float, w & 0xffff0000u); }
__device__ __forceinline__ float silu_f(float x) { return x * __builtin_amdgcn_rcpf(1.f + __builtin_amdgcn_exp2f(-x * LOG2E)); }
__device__ __forceinline__ float wave_sum(float v) {
#pragma unroll
    for (int o = 1; o < 64; o <<= 1) v += __shfl_xor(v, o);
    return v;
}

template <bool POOLF> __device__ __forceinline__ void p0_transpose_item(const float* W, int K, int N, bf16* WT, LAS float* scr, int item, int lane) {
    const int nblk = N / 32, kb = item / nblk, nb = item % nblk, k0 = 64 * kb, n0 = 32 * nb;
#pragma unroll 8
    for (int i = 0; i < 32; ++i) { const int kk = 2 * i + (lane >> 5); scr[kk * 33 + (lane & 31)] = W[(size_t)(k0 + kk) * N + n0 + (lane & 31)]; }
    asm volatile("s_waitcnt lgkmcnt(0)" ::: "memory");
    const int c = lane & 7;
#pragma unroll
    for (int j = 0; j < 4; ++j) { const int n = (lane >> 3) + 8 * j; const LAS float* s = scr + (8 * c) * 33 + n;
        u32x4 o; o.x = pk2(s[0 * 33], s[1 * 33]); o.y = pk2(s[2 * 33], s[3 * 33]); o.z = pk2(s[4 * 33], s[5 * 33]); o.w = pk2(s[6 * 33], s[7 * 33]);
        if (POOLF) { const int k = k0 + 8 * c, nn = n0 + n; *(u32x4*)(WT + (size_t)(((((k >> 4) * 4 + (nn >> 5)) * 2 + ((k >> 3) & 1)) * 32 + (nn & 31)) * 8)) = o; }
        else *(u32x4*)(WT + (size_t)(n0 + n) * K + k0 + 8 * c) = o; }
    asm volatile("s_waitcnt lgkmcnt(0)" ::: "memory");
}

struct Args { const float* x; const float* norm_gain; const float* w_in; const float* pool_w; const float* pool_scale; const float* rel_bias; const float* w_out; const float* fgain; float* out; unsigned char* ws; };

constexpr int PROW = 272;
constexpr int WREG = 12800;
template <int W> __device__ __forceinline__ void pool_unit(const bf16* proj, const bf16* pwf, const float* pool_scale, bf16* Y, LAS unsigned char* wl, int b, int c, int g, int th, int lane) {
    const int r32 = lane & 31, hi = lane >> 5;
    const int sb = c * CHUNK + th * 32, s = sb + r32; const size_t row = (size_t)b * SEQ + s;
#pragma unroll
    for (int i = 0; i < 12; ++i) { const int r0 = 4 * i + (lane >> 4), r = r0 < 46 ? r0 : 46, piece = lane & 15, u = sb - 15 + r, uc = u > 0 ? u : 0;
        u32x4 w = *(const u32x4*)(proj + ((size_t)b * SEQ + uc) * NPROJ + g * 128 + piece * 8);
        if (u < 0) w = (u32x4){0u, 0u, 0u, 0u};
        *(LAS u32x4*)(wl + r * PROW + piece * 16) = w; }
    const char* wt = (const char*)(pwf + (size_t)g * 128 * 128); const unsigned l16 = (unsigned)lane * 16u;
    const int cnt = (s + 1 < W) ? (s + 1) : W; const float inv = 1.f / (float)cnt;
    f32x16 acc[4];
#pragma unroll
    for (int db = 0; db < 4; ++db)
#pragma unroll
        for (int i = 0; i < 16; ++i) acc[db][i] = 0.f;
#pragma unroll 1
    for (int ks = 0; ks < 8; ++ks) {
        bf16x8 wf[4];
#pragma unroll
        for (int db = 0; db < 4; ++db) wf[db] = *(const bf16x8*)(wt + (ks * 4 + db) * 1024 + l16);
        float sum[8], own[8];
#pragma unroll
        for (int e = 0; e < 8; ++e) { sum[e] = 0.f; own[e] = 0.f; }
        const LAS unsigned char* rp = wl + (r32 + 15) * PROW + (2 * ks + hi) * 16;
#pragma unroll
        for (int i = 0; i < W; ++i) {
            const u32x4 w = *(const LAS u32x4*)(rp - i * PROW);
            const float f[8] = {bf_lo(w.x), bf_hi(w.x), bf_lo(w.y), bf_hi(w.y), bf_lo(w.z), bf_hi(w.z), bf_lo(w.w), bf_hi(w.w)};
#pragma unroll
            for (int e = 0; e < 8; ++e) { sum[e] += f[e]; if (i == 0) own[e] = f[e]; }
        }
        u32x4 o; o.x = pkbf(sum[0] * inv - own[0], sum[1] * inv - own[1]); o.y = pkbf(sum[2] * inv - own[2], sum[3] * inv - own[3]);
        o.z = pkbf(sum[4] * inv - own[4], sum[5] * inv - own[5]); o.w = pkbf(sum[6] * inv - own[6], sum[7] * inv - own[7]);
        const bf16x8 df = __builtin_bit_cast(bf16x8, o);
#pragma unroll
        for (int db = 0; db < 4; ++db) acc[db] = __builtin_amdgcn_mfma_f32_32x32x16_bf16(wf[db], df, acc[db], 0, 0, 0);
    }
    const bf16* gp = proj + row * NPROJ + (512 + g * 128 + 4 * hi); const float* sp = pool_scale + (g * 128 + 4 * hi); bf16* yp = Y + row * DM + (g * 128 + 4 * hi);
#pragma unroll
    for (int db = 0; db < 4; ++db)
#pragma unroll
        for (int i4 = 0; i4 < 4; ++i4) {
            const u32x2 gw = *(const u32x2*)(gp + (32 * db + 8 * i4)); const f32x4 sc = *(const f32x4*)(sp + (32 * db + 8 * i4));
            const float o0 = acc[db][4 * i4 + 0] * sc[0] * silu_f(bf_lo(gw.x)), o1 = acc[db][4 * i4 + 1] * sc[1] * silu_f(bf_hi(gw.x));
            const float o2 = acc[db][4 * i4 + 2] * sc[2] * silu_f(bf_lo(gw.y)), o3 = acc[db][4 * i4 + 3] * sc[3] * silu_f(bf_hi(gw.y));
            u32x2 ow; ow.x = pkbf(o0, o1); ow.y = pkbf(o2, o3); *(u32x2*)(yp + (32 * db + 8 * i4)) = ow; }
}
__device__ __forceinline__ void attn_unit(const bf16* proj, const bf16* KF, const bf16* VF, bf16* Y, const LAS float* tab, int b, int c, int h, int lane) {
    const int r32 = lane & 31, hi = lane >> 5;
    const int jstart = (c < 8) ? (8 - c) : 0;
    const char* kbase = (const char*)(KF + (size_t)(b * 8 + h) * 256 * 2048);
    const char* vbase = (const char*)(VF + (size_t)(b * 8 + h) * 256 * 2048);
    const unsigned l16 = (unsigned)lane * 16u;
    for (int qh = 0; qh < 2; ++qh) {
        const size_t rowq = (size_t)b * SEQ + c * CHUNK + qh * 32 + r32;
        bf16x8 qf[4];
#pragma unroll
        for (int ds = 0; ds < 4; ++ds) qf[ds] = *(const bf16x8*)(proj + rowq * NPROJ + 1024 + h * 64 + 16 * ds + 8 * hi);
        bf16x8 kf[8];
        { const int kblk = (c - 8 + jstart) * 2;
#pragma unroll
            for (int t = 0; t < 8; ++t) kf[t] = *(const bf16x8*)(kbase + (size_t)kblk * 4096 + t * 1024 + l16); }
        float m = -1e30f, l = 0.f; f32x16 o[2];
#pragma unroll
        for (int db = 0; db < 2; ++db)
#pragma unroll
            for (int i = 0; i < 16; ++i) o[db][i] = 0.f;
        const int dq = 4 * hi - (qh * 32 + r32);
        for (int j = jstart; j <= 8; ++j) {
            const int kblk = (c - 8 + j) * 2;
            f32x16 sc[2];
#pragma unroll
            for (int kb = 0; kb < 2; ++kb) {
#pragma unroll
                for (int i = 0; i < 16; ++i) sc[kb][i] = 0.f;
#pragma unroll
                for (int ds = 0; ds < 4; ++ds) sc[kb] = __builtin_amdgcn_mfma_f32_32x32x16_bf16(kf[kb * 4 + ds], qf[ds], sc[kb], 0, 0, 0);
            }
            __builtin_amdgcn_sched_barrier(0);
            bf16x8 vf[8];
#pragma unroll
            for (int t = 0; t < 8; ++t) vf[t] = *(const bf16x8*)(vbase + (size_t)kblk * 4096 + t * 1024 + l16);
            if (j < 8) {
#pragma unroll
                for (int t = 0; t < 8; ++t) kf[t] = *(const bf16x8*)(kbase + (size_t)(kblk + 2) * 4096 + t * 1024 + l16);
            }
            __builtin_amdgcn_sched_barrier(0);
            if (j <= 6) { const float b0 = tab[0];
#pragma unroll
                for (int kb = 0; kb < 2; ++kb)
#pragma unroll
                    for (int i = 0; i < 16; ++i) sc[kb][i] = sc[kb][i] * SCL + b0;
            } else {
                const LAS float* tp = tab + ((j == 8) ? 64 : (129 + 63)) + dq;
#pragma unroll
                for (int kb = 0; kb < 2; ++kb)
#pragma unroll
                    for (int i = 0; i < 16; ++i) sc[kb][i] = sc[kb][i] * SCL + tp[32 * kb + (i & 3) + 8 * (i >> 2)];
            }
            float mt = sc[0][0];
#pragma unroll
            for (int kb = 0; kb < 2; ++kb)
#pragma unroll
                for (int i = 0; i < 16; ++i) mt = fmaxf(mt, sc[kb][i]);
            mt = fmaxf(mt, __shfl_xor(mt, 32));
            const float mn = fmaxf(m, mt); const float alpha = __builtin_amdgcn_exp2f(m - mn); m = mn;
            float ls = 0.f;
#pragma unroll
            for (int kb = 0; kb < 2; ++kb)
#pragma unroll
                for (int i = 0; i < 16; ++i) { const float p = __builtin_amdgcn_exp2f(sc[kb][i] - mn); sc[kb][i] = p; ls += p; }
            l = l * alpha + ls;
#pragma unroll
            for (int db = 0; db < 2; ++db)
#pragma unroll
                for (int i = 0; i < 16; ++i) o[db][i] *= alpha;
#pragma unroll
            for (int kb = 0; kb < 2; ++kb)
#pragma unroll
                for (int s2 = 0; s2 < 2; ++s2) {
                    u32x4 pw; pw.x = pkbf(sc[kb][8 * s2 + 0], sc[kb][8 * s2 + 1]); pw.y = pkbf(sc[kb][8 * s2 + 2], sc[kb][8 * s2 + 3]);
                    pw.z = pkbf(sc[kb][8 * s2 + 4], sc[kb][8 * s2 + 5]); pw.w = pkbf(sc[kb][8 * s2 + 6], sc[kb][8 * s2 + 7]);
                    const bf16x8 pf = __builtin_bit_cast(bf16x8, pw);
#pragma unroll
                    for (int db = 0; db < 2; ++db) o[db] = __builtin_amdgcn_mfma_f32_32x32x16_bf16(vf[(kb * 2 + s2) * 2 + db], pf, o[db], 0, 0, 0);
                }
        }
        l += __shfl_xor(l, 32); const float inv = 1.f / l;
        const bf16* gp = proj + rowq * NPROJ + (2560 + h * 64 + 4 * hi); bf16* yp = Y + rowq * DM + (512 + h * 64 + 4 * hi);
#pragma unroll
        for (int db = 0; db < 2; ++db)
#pragma unroll
            for (int i4 = 0; i4 < 4; ++i4) {
                const u32x2 gw = *(const u32x2*)(gp + (32 * db + 8 * i4));
                const float o0 = o[db][4 * i4 + 0] * inv * silu_f(bf_lo(gw.x)), o1 = o[db][4 * i4 + 1] * inv * silu_f(bf_hi(gw.x));
                const float o2 = o[db][4 * i4 + 2] * inv * silu_f(bf_lo(gw.y)), o3 = o[db][4 * i4 + 3] * inv * silu_f(bf_hi(gw.y));
                u32x2 ow; ow.x = pkbf(o0, o1); ow.y = pkbf(o2, o3); *(u32x2*)(yp + (32 * db + 8 * i4)) = ow; }
    }
}

__global__ void __launch_bounds__(NWAVES * 64, 2) fwd_mega(Args a) {
    extern __shared__ __attribute__((aligned(16))) unsigned char lds[];
    cg::grid_group grid = cg::this_grid();
    const int tid = threadIdx.x, lane = tid & 63, wave = __builtin_amdgcn_readfirstlane(tid >> 6);
    const int G = gridDim.x, bx = blockIdx.x; const int vcu = (G % 8 == 0) ? (bx % 8) * (G / 8) + bx / 8 : bx;
    unsigned char* ws = a.ws;
    bf16* WinT = (bf16*)(ws + WS_WINT); bf16* WoutT = (bf16*)(ws + WS_WOUTT); bf16* PoolWT = (bf16*)(ws + WS_POOLWT);
    float* part = (float*)(ws + WS_PART); bf16* XN = (bf16*)(ws + WS_XN); bf16* PROJ = (bf16*)(ws + WS_PROJ); bf16* VF = (bf16*)(ws + WS_VT); bf16* KF = (bf16*)(ws + WS_KF); bf16* Y = (bf16*)(ws + WS_Y);
    const int gw = vcu * NWAVES + wave, NGW = G * NWAVES;

    {
        LAS float* scr = (LAS float*)((LAS unsigned char*)lds + wave * 16384);
        constexpr int I_IN = (DM / 64) * (NPROJ / 32), I_OUT = (DM / 64) * (DM / 32), I_PW = (128 / 64) * (128 / 32);
        constexpr int NITEMS = I_IN + I_OUT + 4 * I_PW;
        for (int it = gw; it < NITEMS; it += NGW) {
            int r = it;
            if (r < I_IN) { p0_transpose_item<false>(a.w_in, DM, NPROJ, WinT, scr, r, lane); continue; } r -= I_IN;
            if (r < I_OUT) { p0_transpose_item<false>(a.w_out, DM, DM, WoutT, scr, r, lane); continue; } r -= I_OUT;
            const int g = r / I_PW; r -= g * I_PW;
            p0_transpose_item<true>(a.pool_w + (size_t)g * 128 * 128, 128, 128, PoolWT + (size_t)g * 128 * 128, scr, r, lane);
        }
        f32x4 gv[4];
#pragma unroll
        for (int j = 0; j < 4; ++j) gv[j] = ((const f32x4*)a.norm_gain)[lane + 64 * j];
        for (int m = gw; m < M; m += NGW) {
            const f32x4* xr = (const f32x4*)(a.x + (size_t)m * DM) + lane;
            f32x4 v[4]; float ss = 0.f;
#pragma unroll
            for (int j = 0; j < 4; ++j) { v[j] = xr[64 * j]; ss += (v[j][0] * v[j][0] + v[j][1] * v[j][1]) + (v[j][2] * v[j][2] + v[j][3] * v[j][3]); }
            const float rstd = 1.0f / sqrtf(wave_sum(ss) * (1.f / DM) + EPS);
            unsigned long long* o8 = (unsigned long long*)(XN + (size_t)m * DM) + lane;
#pragma unroll
            for (int j = 0; j < 4; ++j) { const f32x4 t = v[j] * rstd * gv[j]; o8[64 * j] = (unsigned long long)pkbf(t[0], t[1]) | ((unsigned long long)pkbf(t[2], t[3]) << 32); }
        }
    }
    grid.sync();

    {
        pg8::Gemm g{XN, WinT, M, NPROJ, DM}; pg8::StaticOrder S; S.init(M, NPROJ, G, bx);
        pg8::EpiProj E{PROJ, KF, VF};
        pg8::gemm_phase<pg8::EpiProj, pg8::StaticOrder, PG8_ALIGN, PG8_SP2>((PG8_LAS unsigned char*)lds, g, S, E);
    }
    grid.sync();

    {
        LAS float* tab = (LAS float*)((LAS unsigned char*)lds + NWAVES * WREG);
        LAS unsigned char* wl = (LAS unsigned char*)lds + wave * WREG;
        for (int i = tid; i < 8 * 256; i += NWAVES * 64) { const int hh = i >> 8, e = i & 255;
            const int src_i = (e < 129) ? e : ((e - 129 - 63) > 0 ? (e - 129 - 63) : 0); tab[i] = a.rel_bias[hh * 129 + src_i] * LOG2E; }
        __syncthreads();
        for (int unit = vcu; unit < BATCH * NCHUNK; unit += G) {
            const int b = unit / NCHUNK, c = unit % NCHUNK;
            const int g = wave >> 1, th = wave & 1;
            int ln = lane; asm volatile("" : "+v"(ln));
            switch (g) {
                case 0: pool_unit<2>(PROJ, PoolWT, a.pool_scale, Y, wl, b, c, 0, th, ln); break;
                case 1: pool_unit<4>(PROJ, PoolWT, a.pool_scale, Y, wl, b, c, 1, th, ln); break;
                case 2: pool_unit<8>(PROJ, PoolWT, a.pool_scale, Y, wl, b, c, 2, th, ln); break;
                default: pool_unit<16>(PROJ, PoolWT, a.pool_scale, Y, wl, b, c, 3, th, ln); break;
            }
            asm volatile("" : "+v"(ln));
            attn_unit(PROJ, KF, VF, Y, tab + wave * 256, b, c, wave, ln);
        }
    }
    grid.sync();

    {
        pg8::Gemm g{Y, WoutT, M, DM, DM}; pg8::StaticOrder S; S.init(M, DM, G, bx);
        pg8::EpiOut E{a.x, a.out, part};
        pg8::gemm_phase<pg8::EpiOut, pg8::StaticOrder, PG8_ALIGN, PG8_SP2>((PG8_LAS unsigned char*)lds, g, S, E);
    }
    grid.sync();

    {
        f32x4 gv[4];
#pragma unroll
        for (int j = 0; j < 4; ++j) gv[j] = ((const f32x4*)a.fgain)[lane + 64 * j];
        for (int m = gw; m < M; m += NGW) {
            float ps = (lane < 16) ? part[(size_t)m * 16 + lane] : 0.f;
            const float rstd = 1.0f / sqrtf(wave_sum(ps) * (1.f / DM) + EPS);
            f32x4* xr = (f32x4*)(a.out + (size_t)m * DM) + lane;
#pragma unroll
            for (int j = 0; j < 4; ++j) { const f32x4 v = xr[64 * j]; xr[64 * j] = v * rstd * gv[j]; }
        }
    }
}

extern "C" void kernel_launch(void* const* d_in, const int* in_sizes, int n_in, void* d_out, int out_size, void* d_ws, size_t ws_size, hipStream_t stream) {
    static int grid = 0;
    if (grid == 0) {
        if (n_in != 8 || in_sizes[0] != M * DM || out_size != M * DM || ws_size < WS_END) { fprintf(stderr, "kernel_launch: unexpected shapes (n_in %d, in0 %d, out %d, ws %zu); nothing launched\n", n_in, n_in > 0 ? in_sizes[0] : -1, out_size, ws_size); grid = -1; return; }
        int dev = 0, cus = 0, per_cu = 0;
        if (hipGetDevice(&dev) != hipSuccess || hipDeviceGetAttribute(&cus, hipDeviceAttributeMultiprocessorCount, dev) != hipSuccess) { fprintf(stderr, "kernel_launch: device query failed\n"); grid = -1; return; }
        if (hipFuncSetAttribute((const void*)fwd_mega, hipFuncAttributeMaxDynamicSharedMemorySize, LDS_BYTES) != hipSuccess) { fprintf(stderr, "kernel_launch: hipFuncSetAttribute failed\n"); grid = -1; return; }
        if (hipOccupancyMaxActiveBlocksPerMultiprocessor(&per_cu, (const void*)fwd_mega, NWAVES * 64, LDS_BYTES) != hipSuccess || per_cu < 1) { fprintf(stderr, "kernel_launch: occupancy query gave %d blocks per CU\n", per_cu); (void)hipGetLastError(); grid = -1; return; }
        grid = cus * per_cu;
    }
    if (grid < 0) return;
    Args a{};
    a.x = (const float*)d_in[0]; a.norm_gain = (const float*)d_in[1]; a.w_in = (const float*)d_in[2]; a.pool_w = (const float*)d_in[3]; a.pool_scale = (const float*)d_in[4];
    a.rel_bias = (const float*)d_in[5]; a.w_out = (const float*)d_in[6]; a.fgain = (const float*)d_in[7]; a.out = (float*)d_out; a.ws = (unsigned char*)d_ws;
    void* args[] = {&a};
    hipError_t e = hipLaunchCooperativeKernel((const void*)fwd_mega, dim3(grid), dim3(NWAVES * 64), args, LDS_BYTES, stream);
    if (e != hipSuccess) fprintf(stderr, "kernel_launch: cooperative launch failed: %s (grid %d)\n", hipGetErrorString(e), grid);
}
```

```cpp
#include <hip/hip_runtime.h>
#include <hip/hip_cooperative_groups.h>
#include <cstdio>
#include <cstdint>
namespace pg8 {
#define PG8_LAS __attribute__((address_space(3)))
typedef unsigned short bf16_t;
typedef short bf16x8 __attribute__((ext_vector_type(8)));
typedef float f32x4 __attribute__((ext_vector_type(4)));
typedef unsigned u32x4 __attribute__((ext_vector_type(4)));
constexpr int BM = 256, BK = 64, HALF = 128, HTB = HALF * BK * 2  , STAGE_BYTES = 8 * HTB, NXCD = 8, WGM = 8;

__host__ __device__ __forceinline__ int lds_byte(int r, int c) { const int st = (r >> 4) * 2 + (c >> 5), rr = r & 15, cc = c & 31, ob = rr * 64 + cc * 2; return st * 1024 + (ob ^ (((ob >> 9) & 1) << 5)); }
__host__ __device__ __forceinline__ void stage_rc(int b, int& R, int& C) { const int st = b / 1024, sb = b % 1024, swz = sb ^ (((sb >> 9) & 1) << 5); R = (st >> 1) * 16 + swz / 64; C = (st & 1) * 32 + (swz % 64) / 2; }
__host__ __device__ __forceinline__ int perm32(int rho) { const int n = rho >> 4, i = rho & 15; return 8 * (i >> 2) + 4 * n + (i & 3); }

struct Unit { int pm, pn; };
struct Gemm { const bf16_t* A; const bf16_t* Bt; int M, N, K; };

struct StaticOrder {
    int nM, nN, nwg, G, c;
    __host__ __device__ void init(int M, int N, int G_, int c_) { nM = M / BM; nN = N / BM; nwg = nM * nN; G = G_; c = c_; }
    __host__ __device__ bool next(int i, Unit& u) const {
        const long L = (long)i * G + c; if (L >= nwg) return false;
        int wgid = (int)L; { const int q = nwg / NXCD, r = nwg % NXCD, xcd = wgid % NXCD, off = wgid / NXCD; wgid = (xcd < r ? xcd * (q + 1) : r * (q + 1) + (xcd - r) * q) + off; }
        const int nig = WGM * nN, gid = wgid / nig, fm = gid * WGM, gsz = (nM - fm) < WGM ? (nM - fm) : WGM;
        u.pm = fm + ((wgid % nig) % gsz); u.pn = (wgid % nig) / gsz; return true;
    }
    __device__ __forceinline__ void a_ready(const Unit&) const {}
    __device__ __forceinline__ void done(const Unit&) const {}
};

__device__ __forceinline__ unsigned cvt_pk_bf16(float lo, float hi) { unsigned r; asm volatile("v_cvt_pk_bf16_f32 %0, %1, %2" : "=v"(r) : "v"(lo), "v"(hi)); return r; }
__device__ __forceinline__ unsigned short bf16_1(float v) { return (unsigned short)(cvt_pk_bf16(v, v) & 0xffffu); }
struct EpiProj {
    static constexpr bool PERM = true, AFTER_DRAIN = false;
    bf16_t* P; bf16_t* KF; bf16_t* VF;
    __device__ __forceinline__ void operator()(const f32x4 (&acc)[2][2][4][2], const Unit& u, int wr, int wc, int fr, int fq) const {
        const int row0 = u.pm * BM + wr * 64 + fr, col0 = u.pn * BM + wc * 32 + 8 * fq;
        if (u.pn == 6 || u.pn == 7) {
            const int b = row0 >> 13, s0 = row0 & 8191;
#pragma unroll
            for (int ai = 0; ai < 2; ++ai)
#pragma unroll
                for (int m = 0; m < 4; ++m) { const int s = s0 + ai * HALF + m * 16;
#pragma unroll
                    for (int bj = 0; bj < 2; ++bj) { const int ck = col0 - 1536 + bj * HALF, h = ck >> 6, d0 = ck & 63;
                        const size_t idx = ((((((size_t)(b * 8 + h) * 256 + (s >> 5)) * 4 + (d0 >> 4)) * 2 + ((d0 >> 3) & 1)) * 32 + (s & 31))) * 8;
                        const f32x4 v0 = acc[ai][bj][m][0], v1 = acc[ai][bj][m][1];
                        u32x4 w; w.x = cvt_pk_bf16(v0[0], v0[1]); w.y = cvt_pk_bf16(v0[2], v0[3]); w.z = cvt_pk_bf16(v1[0], v1[1]); w.w = cvt_pk_bf16(v1[2], v1[3]);
                        *(u32x4*)(KF + idx) = w; } }
        } else if (u.pn == 8 || u.pn == 9) {
            const int b = row0 >> 13, s0 = row0 & 8191;
#pragma unroll
            for (int ai = 0; ai < 2; ++ai)
#pragma unroll
                for (int m = 0; m < 4; ++m) { const int s = s0 + ai * HALF + m * 16;
                    const int sj = ((s >> 3) & 1) * 4 + (s & 3), shi = (s >> 2) & 1, ss2 = (s >> 4) & 1, sblk = s >> 5;
#pragma unroll
                    for (int bj = 0; bj < 2; ++bj) { const int cv = col0 - 2048 + bj * HALF, h = cv >> 6, d0 = cv & 63;
                        bf16_t* base = VF + (((((((size_t)(b * 8 + h) * 256 + sblk) * 2 + ss2) * 2 + (d0 >> 5)) * 2 + shi) * 32 + (d0 & 31))) * 8 + sj;
#pragma unroll
                        for (int n = 0; n < 2; ++n)
#pragma unroll
                            for (int e = 0; e < 4; ++e) base[(4 * n + e) * 8] = bf16_1(acc[ai][bj][m][n][e]); } }
        } else {
#pragma unroll
            for (int ai = 0; ai < 2; ++ai)
#pragma unroll
                for (int m = 0; m < 4; ++m) { bf16_t* rowp = P + (size_t)(row0 + ai * HALF + m * 16) * 3072 + col0;
#pragma unroll
                    for (int bj = 0; bj < 2; ++bj) { const f32x4 v0 = acc[ai][bj][m][0], v1 = acc[ai][bj][m][1];
                        u32x4 w; w.x = cvt_pk_bf16(v0[0], v0[1]); w.y = cvt_pk_bf16(v0[2], v0[3]); w.z = cvt_pk_bf16(v1[0], v1[1]); w.w = cvt_pk_bf16(v1[2], v1[3]);
                        *(u32x4*)(rowp + bj * HALF) = w; } }
        }
    }
};
struct EpiOut {
    static constexpr bool PERM = false, AFTER_DRAIN = false;
    const float* X; float* O; float* part;
    __device__ __forceinline__ void operator()(const f32x4 (&acc)[2][2][4][2], const Unit& u, int wr, int wc, int fr, int fq) const {
        const int row0 = u.pm * BM + wr * 64 + fr, col0 = u.pn * BM + wc * 32 + 4 * fq;
#pragma unroll
        for (int ai = 0; ai < 2; ++ai)
#pragma unroll
            for (int m = 0; m < 4; ++m) { const int row = row0 + ai * HALF + m * 16; const size_t off = (size_t)row * 1024 + col0; float ss = 0.f;
#pragma unroll
                for (int bj = 0; bj < 2; ++bj)
#pragma unroll
                    for (int n = 0; n < 2; ++n) { const f32x4 xv = *(const f32x4*)(X + off + bj * HALF + n * 16); const f32x4 o = xv + acc[ai][bj][m][n];
                        *(f32x4*)(O + off + bj * HALF + n * 16) = o; ss += (o[0] * o[0] + o[1] * o[1]) + (o[2] * o[2] + o[3] * o[3]); }
                ss += __shfl_xor(ss, 16); ss += __shfl_xor(ss, 32);
                if (fq == 0) part[(size_t)row * 16 + u.pn * 4 + wc] = ss; }
    }
};
template <class Epi, class Sched, bool ALIGN_EPI = false, bool SP2 = false>
__device__ __forceinline__ void gemm_phase(PG8_LAS unsigned char* lds, const Gemm g, const Sched& S, const Epi& E) {
    const int tid = threadIdx.x, wid = __builtin_amdgcn_readfirstlane(tid >> 6), lane = tid & 63, wr = wid >> 2, wc = wid & 3, fr = lane & 15, fq = lane >> 4;
    const int K = g.K, nt = K / BK;
    unsigned voffA[2], voffB[2];
#pragma unroll
    for (int i = 0; i < 2; ++i) { int R, C; stage_rc(tid * 16 + i * 8192, R, C); const int Rb = Epi::PERM ? ((R & ~31) + perm32(R & 31)) : R;
        voffA[i] = (unsigned)(R * K + C) * 2u; voffB[i] = (unsigned)(Rb * K + C) * 2u; }
    const size_t kstep = (size_t)(BK * 2);
    const size_t hstep = (size_t)HALF * K * 2;
    const size_t tstep = 2 * hstep;
    const unsigned ldsw = (unsigned)wid * 1024u;
    const int aoff = lds_byte(wr * 64 + fr, fq * 8), boff = lds_byte(wc * 32 + fr, fq * 8);
#define PG8_SA(b, h) (((b) * 2 + (h)) * HTB)
#define PG8_SB(b, h) ((4 + (b) * 2 + (h)) * HTB)
#define PG8_STAGE(bufoff, gbase, voff) do { _Pragma("unroll") for (int _i = 0; _i < 2; ++_i) \
        __builtin_amdgcn_global_load_lds((const unsigned*)((const char*)(gbase) + (voff)[_i]), (PG8_LAS unsigned*)(lds + (bufoff) + ldsw + _i * 8192), 16, 0, 0); } while (0)
#define PG8_LDA(dst, b, h) do { _Pragma("unroll") for (int m = 0; m < 4; ++m) _Pragma("unroll") for (int k = 0; k < 2; ++k) dst[m][k] = *(const PG8_LAS bf16x8*)(lds + PG8_SA(b, h) + aoff + m * 2048 + k * 1024); } while (0)
#define PG8_LDB(dst, b, h) do { _Pragma("unroll") for (int n = 0; n < 2; ++n) _Pragma("unroll") for (int k = 0; k < 2; ++k) dst[n][k] = *(const PG8_LAS bf16x8*)(lds + PG8_SB(b, h) + boff + n * 2048 + k * 1024); } while (0)
#define PG8_MMA(ai, bj, At, Bt) do { __builtin_amdgcn_s_setprio(1); _Pragma("unroll") for (int m = 0; m < 4; ++m) _Pragma("unroll") for (int n = 0; n < 2; ++n) _Pragma("unroll") for (int k = 0; k < 2; ++k) \
        acc[ai][bj][m][n] = __builtin_amdgcn_mfma_f32_16x16x32_bf16(Bt[n][k], At[m][k], acc[ai][bj][m][n], 0, 0, 0); __builtin_amdgcn_s_setprio(0); } while (0)
#define PG8_WAIT_V(n) asm volatile("s_waitcnt vmcnt(" #n ")" ::: "memory")
#define PG8_WAIT_L(n) asm volatile("s_waitcnt lgkmcnt(" #n ")" ::: "memory")
#define PG8_BAR __builtin_amdgcn_s_barrier()
#define PG8_SCHED __builtin_amdgcn_sched_barrier(0)
    Unit cur, nxt; int ui = 0;
    if (!S.next(0, cur)) return;
    f32x4 acc[2][2][4][2];
#pragma unroll
    for (int a = 0; a < 2; ++a)
#pragma unroll
        for (int b = 0; b < 2; ++b)
#pragma unroll
            for (int m = 0; m < 4; ++m)
#pragma unroll
                for (int n = 0; n < 2; ++n) acc[a][b][m][n] = (f32x4){0.f, 0.f, 0.f, 0.f};
    bf16x8 At[4][2], B0[2][2], B1[2][2];
    const char* cA = (const char*)g.A + (size_t)cur.pm * tstep; const char* cB = (const char*)g.Bt + (size_t)cur.pn * tstep;
    S.a_ready(cur);
    if constexpr (SP2) {
        PG8_STAGE(PG8_SB(0, 0), cB, voffB); PG8_STAGE(PG8_SB(0, 1), cB + hstep, voffB); PG8_STAGE(PG8_SA(0, 0), cA, voffA); PG8_STAGE(PG8_SA(0, 1), cA + hstep, voffA);
        if (wr == 1) PG8_BAR;
        PG8_WAIT_V(2); PG8_BAR;
        PG8_STAGE(PG8_SB(1, 0), cB + kstep, voffB); PG8_STAGE(PG8_SA(1, 0), cA + kstep, voffA); PG8_STAGE(PG8_SB(1, 1), cB + hstep + kstep, voffB);
        PG8_WAIT_V(6); PG8_BAR;
    } else {
        PG8_STAGE(PG8_SB(0, 0), cB, voffB); PG8_STAGE(PG8_SA(0, 0), cA, voffA); PG8_STAGE(PG8_SB(0, 1), cB + hstep, voffB); PG8_STAGE(PG8_SA(0, 1), cA + hstep, voffA);
        if (wr == 1) PG8_BAR;
        PG8_WAIT_V(4); PG8_BAR;
        PG8_STAGE(PG8_SB(1, 0), cB + kstep, voffB); PG8_STAGE(PG8_SA(1, 0), cA + kstep, voffA); PG8_STAGE(PG8_SB(1, 1), cB + hstep + kstep, voffB);
        PG8_WAIT_V(6); PG8_BAR;
    }
    for (;;) {
        const bool has_next = S.next(ui + 1, nxt);
        const char* nA = has_next ? (const char*)g.A + (size_t)nxt.pm * tstep : cA; const char* nB = has_next ? (const char*)g.Bt + (size_t)nxt.pn * tstep : cB;
        for (int t = 0; t < nt; t += 2) {
            const bool last = (t == nt - 2);
            const char* a1 = cA + (size_t)(t + 1) * kstep;
            const char* a2 = last ? nA : cA + (size_t)(t + 2) * kstep; const char* b2 = last ? nB : cB + (size_t)(t + 2) * kstep;
            const char* a3 = a2 + kstep; const char* b3 = b2 + kstep;
            if (last && has_next) S.a_ready(nxt);
            if constexpr (SP2) {
            PG8_LDB(B0, 0, 0); PG8_LDB(B1, 0, 1); PG8_SCHED; PG8_LDA(At, 0, 0); PG8_STAGE(PG8_SA(1, 1), a1 + hstep, voffA);
            PG8_WAIT_V(8); PG8_WAIT_L(0); PG8_BAR; PG8_MMA(0, 0, At, B0); PG8_MMA(0, 1, At, B1); PG8_BAR; PG8_SCHED;
            PG8_LDA(At, 0, 1); PG8_STAGE(PG8_SB(0, 0), b2, voffB); PG8_STAGE(PG8_SB(0, 1), b2 + hstep, voffB); PG8_STAGE(PG8_SA(0, 0), a2, voffA);
            PG8_WAIT_V(8); PG8_WAIT_L(0); PG8_BAR; PG8_MMA(1, 0, At, B0); PG8_MMA(1, 1, At, B1); PG8_BAR; PG8_SCHED;
            PG8_LDB(B0, 1, 0); PG8_LDB(B1, 1, 1); PG8_SCHED; PG8_LDA(At, 1, 0); PG8_STAGE(PG8_SA(0, 1), a2 + hstep, voffA);
            PG8_WAIT_V(8); PG8_WAIT_L(0); PG8_BAR; PG8_MMA(0, 0, At, B0); PG8_MMA(0, 1, At, B1); PG8_BAR; PG8_SCHED;
            PG8_LDA(At, 1, 1); PG8_STAGE(PG8_SB(1, 0), b3, voffB); PG8_STAGE(PG8_SB(1, 1), b3 + hstep, voffB); PG8_STAGE(PG8_SA(1, 0), a3, voffA);
            PG8_WAIT_V(8); PG8_WAIT_L(0); PG8_BAR; PG8_MMA(1, 0, At, B0); PG8_MMA(1, 1, At, B1); PG8_BAR; PG8_SCHED;
            } else {
            PG8_LDB(B0, 0, 0); PG8_SCHED; PG8_LDA(At, 0, 0); PG8_STAGE(PG8_SA(1, 1), a1 + hstep, voffA);
            PG8_WAIT_L(8); PG8_BAR; PG8_WAIT_L(0); PG8_MMA(0, 0, At, B0); PG8_BAR; PG8_SCHED;
            PG8_LDB(B1, 0, 1); PG8_STAGE(PG8_SB(0, 0), b2, voffB);
            PG8_BAR; PG8_WAIT_L(0); PG8_MMA(0, 1, At, B1); PG8_BAR;
            PG8_LDA(At, 0, 1); PG8_STAGE(PG8_SA(0, 0), a2, voffA);
            PG8_BAR; PG8_WAIT_L(0); PG8_MMA(1, 0, At, B0); PG8_BAR; PG8_SCHED;
            PG8_STAGE(PG8_SB(0, 1), b2 + hstep, voffB);
            PG8_WAIT_V(6); PG8_BAR; PG8_MMA(1, 1, At, B1); PG8_BAR;
            PG8_LDB(B0, 1, 0); PG8_SCHED; PG8_LDA(At, 1, 0); PG8_STAGE(PG8_SA(0, 1), a2 + hstep, voffA);
            PG8_WAIT_L(8); PG8_BAR; PG8_WAIT_L(0); PG8_MMA(0, 0, At, B0); PG8_BAR; PG8_SCHED;
            PG8_LDB(B1, 1, 1); PG8_STAGE(PG8_SB(1, 0), b3, voffB);
            PG8_BAR; PG8_WAIT_L(0); PG8_MMA(0, 1, At, B1); PG8_BAR;
            PG8_LDA(At, 1, 1); PG8_STAGE(PG8_SA(1, 0), a3, voffA);
            PG8_BAR; PG8_WAIT_L(0); PG8_MMA(1, 0, At, B0); PG8_BAR; PG8_SCHED;
            PG8_STAGE(PG8_SB(1, 1), b3 + hstep, voffB);
            PG8_WAIT_V(6); PG8_BAR; PG8_MMA(1, 1, At, B1); PG8_BAR;
            }
        }
        if constexpr (ALIGN_EPI) { if (wr == 0) PG8_BAR; }
        if constexpr (!Epi::AFTER_DRAIN) { E(acc, cur, wr, wc, fr, fq); S.done(cur); }
        if (!has_next) break;
#pragma unroll
        for (int a = 0; a < 2; ++a)
#pragma unroll
            for (int b = 0; b < 2; ++b)
#pragma unroll
                for (int m = 0; m < 4; ++m)
#pragma unroll
                    for (int n = 0; n < 2; ++n) acc[a][b][m][n] = (f32x4){0.f, 0.f, 0.f, 0.f};
        cur = nxt; cA = nA; cB = nB; ++ui;
        if constexpr (ALIGN_EPI) { if (wr == 1) PG8_BAR; }
    }
    PG8_WAIT_V(0);
    if constexpr (!ALIGN_EPI) { if (wr == 0) PG8_BAR; }
    PG8_BAR;
    if constexpr (Epi::AFTER_DRAIN) { E.fused(acc, cur, wr, wc, fr, fq, lds, wid, lane); S.done(cur); }
#undef PG8_SA
#undef PG8_SB
#undef PG8_STAGE
#undef PG8_LDA
#undef PG8_LDB
#undef PG8_MMA
#undef PG8_WAIT_V
#undef PG8_WAIT_L
#undef PG8_BAR
#undef PG8_SCHED
}
}
#ifndef PG8_SP2
#define PG8_SP2 true
#endif
#ifndef PG8_ALIGN
#define PG8_ALIGN true
#endif
namespace cg = cooperative_groups;
#define LAS __attribute__((address_space(3)))
typedef unsigned short bf16;
typedef float f32x4 __attribute__((ext_vector_type(4)));
typedef float f32x16 __attribute__((ext_vector_type(16)));
typedef short bf16x8 __attribute__((ext_vector_type(8)));
typedef unsigned u32x4 __attribute__((ext_vector_type(4)));
typedef unsigned u32x2 __attribute__((ext_vector_type(2)));

constexpr int NWAVES = 8;
constexpr int BATCH = 8, SEQ = 8192, DM = 1024, M = BATCH * SEQ, NPROJ = 3072, CHUNK = 64, NCHUNK = SEQ / CHUNK;
constexpr float EPS = 1e-6f, LOG2E = 1.4426950408889634f, SCL = 0.125f * 1.4426950408889634f;
constexpr size_t MiB = 1u << 20;
constexpr size_t WS_WINT = 1 * MiB, WS_WOUTT = 8 * MiB, WS_POOLWT = 10 * MiB, WS_PART = 12 * MiB, WS_XN = 16 * MiB, WS_PROJ = 144 * MiB, WS_VT = 528 * MiB, WS_Y = 592 * MiB, WS_KF = 720 * MiB, WS_END = 784 * MiB;
constexpr int LDS_BYTES = 147456;

__device__ __forceinline__ unsigned f2bf(float f) { unsigned u = __builtin_bit_cast(unsigned, f); return (u + 0x7fffu + ((u >> 16) & 1u)) >> 16; }
__device__ __forceinline__ unsigned pk2(float lo, float hi) { return f2bf(lo) | (f2bf(hi) << 16); }
typedef float f32x2_t __attribute__((ext_vector_type(2))); typedef __bf16 bf16x2_t __attribute__((ext_vector_type(2)));
__device__ __forceinline__ unsigned pkbf(float lo, float hi) { f32x2_t v = {lo, hi}; bf16x2_t b = __builtin_convertvector(v, bf16x2_t); return __builtin_bit_cast(unsigned, b); }
__device__ __forceinline__ float bf_lo(unsigned w) { return __builtin_bit_cast(float, w << 16); }
__device__ __forceinline__ float bf_hi(unsigned w) { return __builtin_bit_cast(float, w & 0xffff0000u); }
__device__ __forceinline__ float silu_f(float x) { return x * __builtin_amdgcn_rcpf(1.f + __builtin_amdgcn_exp2f(-x * LOG2E)); }
__device__ __forceinline__ float wave_sum(float v) {
#pragma unroll
    for (int o = 1; o < 64; o <<= 1) v += __shfl_xor(v, o);
    return v;
}

template <bool POOLF> __device__ __forceinline__ void p0_transpose_item(const float* W, int K, int N, bf16* WT, LAS float* scr, int item, int lane) {
    const int nblk = N / 32, kb = item / nblk, nb = item % nblk, k0 = 64 * kb, n0 = 32 * nb;
#pragma unroll 8
    for (int i = 0; i < 32; ++i) { const int kk = 2 * i + (lane >> 5); scr[kk * 33 + (lane & 31)] = W[(size_t)(k0 + kk) * N + n0 + (lane & 31)]; }
    asm volatile("s_waitcnt lgkmcnt(0)" ::: "memory");
    const int c = lane & 7;
#pragma unroll
    for (int j = 0; j < 4; ++j) { const int n = (lane >> 3) + 8 * j; const LAS float* s = scr + (8 * c) * 33 + n;
        u32x4 o; o.x = pk2(s[0 * 33], s[1 * 33]); o.y = pk2(s[2 * 33], s[3 * 33]); o.z = pk2(s[4 * 33], s[5 * 33]); o.w = pk2(s[6 * 33], s[7 * 33]);
        if (POOLF) { const int k = k0 + 8 * c, nn = n0 + n; *(u32x4*)(WT + (size_t)(((((k >> 4) * 4 + (nn >> 5)) * 2 + ((k >> 3) & 1)) * 32 + (nn & 31)) * 8)) = o; }
        else *(u32x4*)(WT + (size_t)(n0 + n) * K + k0 + 8 * c) = o; }
    asm volatile("s_waitcnt lgkmcnt(0)" ::: "memory");
}

typedef unsigned v4u __attribute__((ext_vector_type(4)));
#define XB_TMO      128
#define XB_XCNT(j)  (256  + 64 * (j))
#define XB_XSUB(j)  (1280 + 64 * (j))
#define XB_XGEN(j)  (2304 + 64 * (j))
#define XB_TOP      3328
#define XB_TOPGEN   3392
#define XCD_BAR_WORDS 3456
#define XB_SPIN_CAP (1u << 18)

__device__ __forceinline__ unsigned xb_ld(unsigned* p)              { return __hip_atomic_load(p, __ATOMIC_RELAXED, __HIP_MEMORY_SCOPE_AGENT); }
__device__ __forceinline__ unsigned xb_add(unsigned* p, unsigned v) { return __hip_atomic_fetch_add(p, v, __ATOMIC_RELAXED, __HIP_MEMORY_SCOPE_AGENT); }
__device__ __forceinline__ unsigned xb_xcc_id() { return (unsigned)__builtin_amdgcn_s_getreg((3 << 11) | 20) & 0xFu; }
#define XB_SPIN(cond, bar) do { unsigned _sp = 0; while (cond) { __builtin_amdgcn_s_sleep(1); \
    if ((++_sp & 255u) == 0u) { if (xb_ld(&(bar)[XB_TMO])) break; if (_sp > XB_SPIN_CAP) { atomicAdd(&(bar)[XB_TMO], 1u); break; } } } } while (0)

struct XcdBarrier {
    unsigned* bar; unsigned x;
    volatile LAS unsigned* st;
};

__device__ __forceinline__ XcdBarrier xcd_barrier_post(unsigned* bar, volatile LAS unsigned* st) {
    XcdBarrier b; b.bar = bar; b.x = xb_xcc_id(); b.st = st;
    if (threadIdx.x == 0) (void)xb_add(&bar[XB_XCNT(b.x)], 1u);
    return b;
}
__device__ __forceinline__ void xcd_barrier_complete(unsigned* bar, unsigned x, unsigned& nloc, unsigned& nx) {
    const unsigned G = gridDim.x * gridDim.y * gridDim.z;
    unsigned sum, cnt, mine, sp = 0u;
    for (;;) {
        sum = 0u; cnt = 0u; mine = 0u;
#pragma unroll
        for (unsigned j = 0; j < 16; ++j) { const unsigned c = xb_ld(&bar[XB_XCNT(j)]); sum += c; cnt += (c > 0u) ? 1u : 0u; mine = (j == x) ? c : mine; }
        if (sum == G) break;
        __builtin_amdgcn_s_sleep(1);
        if ((++sp & 255u) == 0u) { if (xb_ld(&bar[XB_TMO])) break; if (sp > XB_SPIN_CAP) { atomicAdd(&bar[XB_TMO], 1u); break; } }
    }
    nloc = mine > 0u ? mine : 1u; nx = cnt > 0u ? cnt : 1u;
}

__device__ __forceinline__ void xcd_barrier(const XcdBarrier& b) {
    asm volatile("s_waitcnt vmcnt(0)" ::: "memory");
    __syncthreads();
    if (threadIdx.x == 0) {
        unsigned* bar = b.bar;
        __builtin_amdgcn_s_waitcnt(0);
        unsigned nloc = b.st[0], nx = b.st[1];
        if (nloc == 0u) { xcd_barrier_complete(bar, b.x, nloc, nx); b.st[0] = nloc; b.st[1] = nx; }
        const unsigned old = xb_add(&bar[XB_XSUB(b.x)], 1u);
        const unsigned gen = old / nloc;
        if (old + 1u == (gen + 1u) * nloc) {
            __builtin_amdgcn_fence(__ATOMIC_RELEASE, "agent");
            asm volatile("s_waitcnt vmcnt(0)" ::: "memory");
            const unsigned og = xb_add(&bar[XB_TOP], 1u);
            const unsigned tg = og / nx;
            if (og + 1u == (tg + 1u) * nx) xb_add(&bar[XB_TOPGEN], 1u);
            else XB_SPIN(xb_ld(&bar[XB_TOPGEN]) == tg, bar);
            __builtin_amdgcn_fence(__ATOMIC_ACQUIRE, "agent");
            xb_add(&bar[XB_XGEN(b.x)], 1u);
            asm volatile("s_waitcnt vmcnt(0)" ::: "memory");
        } else {
            XB_SPIN(xb_ld(&bar[XB_XGEN(b.x)]) == gen, bar);
            __builtin_amdgcn_fence(__ATOMIC_ACQUIRE, "agent");
            asm volatile("s_waitcnt vmcnt(0)" ::: "memory");
        }
    }
    __syncthreads();
}

struct Args { const float* x; const float* norm_gain; const float* w_in; const float* pool_w; const float* pool_scale; const float* rel_bias; const float* w_out; const float* fgain; float* out; unsigned char* ws; };

constexpr int PROW = 272;
constexpr int WREG = 12800;
template <int W> __device__ __forceinline__ void pool_unit(const bf16* proj, const bf16* pwf, const float* pool_scale, bf16* Y, LAS unsigned char* wl, int b, int c, int g, int th, int lane) {
    const int r32 = lane & 31, hi = lane >> 5;
    const int sb = c * CHUNK + th * 32, s = sb + r32; const size_t row = (size_t)b * SEQ + s;
#pragma unroll
    for (int i = 0; i < 12; ++i) { const int r0 = 4 * i + (lane >> 4), r = r0 < 46 ? r0 : 46, piece = lane & 15, u = sb - 15 + r, uc = u > 0 ? u : 0;
        u32x4 w = *(const u32x4*)(proj + ((size_t)b * SEQ + uc) * NPROJ + g * 128 + piece * 8);
        if (u < 0) w = (u32x4){0u, 0u, 0u, 0u};
        *(LAS u32x4*)(wl + r * PROW + piece * 16) = w; }
    const char* wt = (const char*)(pwf + (size_t)g * 128 * 128); const unsigned l16 = (unsigned)lane * 16u;
    const int cnt = (s + 1 < W) ? (s + 1) : W; const float inv = 1.f / (float)cnt;
    f32x16 acc[4];
#pragma unroll
    for (int db = 0; db < 4; ++db)
#pragma unroll
        for (int i = 0; i < 16; ++i) acc[db][i] = 0.f;
#pragma unroll 1
    for (int ks = 0; ks < 8; ++ks) {
        bf16x8 wf[4];
#pragma unroll
        for (int db = 0; db < 4; ++db) wf[db] = *(const bf16x8*)(wt + (ks * 4 + db) * 1024 + l16);
        float sum[8], own[8];
#pragma unroll
        for (int e = 0; e < 8; ++e) { sum[e] = 0.f; own[e] = 0.f; }
        const LAS unsigned char* rp = wl + (r32 + 15) * PROW + (2 * ks + hi) * 16;
#pragma unroll
        for (int i = 0; i < W; ++i) {
            const u32x4 w = *(const LAS u32x4*)(rp - i * PROW);
            const float f[8] = {bf_lo(w.x), bf_hi(w.x), bf_lo(w.y), bf_hi(w.y), bf_lo(w.z), bf_hi(w.z), bf_lo(w.w), bf_hi(w.w)};
#pragma unroll
            for (int e = 0; e < 8; ++e) { sum[e] += f[e]; if (i == 0) own[e] = f[e]; }
        }
        u32x4 o; o.x = pkbf(sum[0] * inv - own[0], sum[1] * inv - own[1]); o.y = pkbf(sum[2] * inv - own[2], sum[3] * inv - own[3]);
        o.z = pkbf(sum[4] * inv - own[4], sum[5] * inv - own[5]); o.w = pkbf(sum[6] * inv - own[6], sum[7] * inv - own[7]);
        const bf16x8 df = __builtin_bit_cast(bf16x8, o);
#pragma unroll
        for (int db = 0; db < 4; ++db) acc[db] = __builtin_amdgcn_mfma_f32_32x32x16_bf16(wf[db], df, acc[db], 0, 0, 0);
    }
    const bf16* gp = proj + row * NPROJ + (512 + g * 128 + 4 * hi); const float* sp = pool_scale + (g * 128 + 4 * hi); bf16* yp = Y + row * DM + (g * 128 + 4 * hi);
#pragma unroll
    for (int db = 0; db < 4; ++db)
#pragma unroll
        for (int i4 = 0; i4 < 4; ++i4) {
            const u32x2 gw = *(const u32x2*)(gp + (32 * db + 8 * i4)); const f32x4 sc = *(const f32x4*)(sp + (32 * db + 8 * i4));
            const float o0 = acc[db][4 * i4 + 0] * sc[0] * silu_f(bf_lo(gw.x)), o1 = acc[db][4 * i4 + 1] * sc[1] * silu_f(bf_hi(gw.x));
            const float o2 = acc[db][4 * i4 + 2] * sc[2] * silu_f(bf_lo(gw.y)), o3 = acc[db][4 * i4 + 3] * sc[3] * silu_f(bf_hi(gw.y));
            u32x2 ow; ow.x = pkbf(o0, o1); ow.y = pkbf(o2, o3); *(u32x2*)(yp + (32 * db + 8 * i4)) = ow; }
}
__device__ __forceinline__ void attn_unit(const bf16* proj, const bf16* KF, const bf16* VF, bf16* Y, const LAS float* tab, int b, int c, int h, int lane) {
    const int r32 = lane & 31, hi = lane >> 5;
    const int jstart = (c < 8) ? (8 - c) : 0;
    const char* kbase = (const char*)(KF + (size_t)(b * 8 + h) * 256 * 2048);
    const char* vbase = (const char*)(VF + (size_t)(b * 8 + h) * 256 * 2048);
    const unsigned l16 = (unsigned)lane * 16u;
    for (int qh = 0; qh < 2; ++qh) {
        const size_t rowq = (size_t)b * SEQ + c * CHUNK + qh * 32 + r32;
        bf16x8 qf[4];
#pragma unroll
        for (int ds = 0; ds < 4; ++ds) qf[ds] = *(const bf16x8*)(proj + rowq * NPROJ + 1024 + h * 64 + 16 * ds + 8 * hi);
        bf16x8 kf[8];
        { const int kblk = (c - 8 + jstart) * 2;
#pragma unroll
            for (int t = 0; t < 8; ++t) kf[t] = *(const bf16x8*)(kbase + (size_t)kblk * 4096 + t * 1024 + l16); }
        float m = -1e30f, l = 0.f; f32x16 o[2];
#pragma unroll
        for (int db = 0; db < 2; ++db)
#pragma unroll
            for (int i = 0; i < 16; ++i) o[db][i] = 0.f;
        const int dq = 4 * hi - (qh * 32 + r32);
        for (int j = jstart; j <= 8; ++j) {
            const int kblk = (c - 8 + j) * 2;
            f32x16 sc[2];
#pragma unroll
            for (int kb = 0; kb < 2; ++kb) {
#pragma unroll
                for (int i = 0; i < 16; ++i) sc[kb][i] = 0.f;
#pragma unroll
                for (int ds = 0; ds < 4; ++ds) sc[kb] = __builtin_amdgcn_mfma_f32_32x32x16_bf16(kf[kb * 4 + ds], qf[ds], sc[kb], 0, 0, 0);
            }
            __builtin_amdgcn_sched_barrier(0);
            bf16x8 vf[8];
#pragma unroll
            for (int t = 0; t < 8; ++t) vf[t] = *(const bf16x8*)(vbase + (size_t)kblk * 4096 + t * 1024 + l16);
            if (j < 8) {
#pragma unroll
                for (int t = 0; t < 8; ++t) kf[t] = *(const bf16x8*)(kbase + (size_t)(kblk + 2) * 4096 + t * 1024 + l16);
            }
            __builtin_amdgcn_sched_barrier(0);
            if (j <= 6) { const float b0 = tab[0];
#pragma unroll
                for (int kb = 0; kb < 2; ++kb)
#pragma unroll
                    for (int i = 0; i < 16; ++i) sc[kb][i] = sc[kb][i] * SCL + b0;
            } else {
                const LAS float* tp = tab + ((j == 8) ? 64 : (129 + 63)) + dq;
#pragma unroll
                for (int kb = 0; kb < 2; ++kb)
#pragma unroll
                    for (int i = 0; i < 16; ++i) sc[kb][i] = sc[kb][i] * SCL + tp[32 * kb + (i & 3) + 8 * (i >> 2)];
            }
            float mt = sc[0][0];
#pragma unroll
            for (int kb = 0; kb < 2; ++kb)
#pragma unroll
                for (int i = 0; i < 16; ++i) mt = fmaxf(mt, sc[kb][i]);
            mt = fmaxf(mt, __shfl_xor(mt, 32));
            const float mn = fmaxf(m, mt); const float alpha = __builtin_amdgcn_exp2f(m - mn); m = mn;
            float ls = 0.f;
#pragma unroll
            for (int kb = 0; kb < 2; ++kb)
#pragma unroll
                for (int i = 0; i < 16; ++i) { const float p = __builtin_amdgcn_exp2f(sc[kb][i] - mn); sc[kb][i] = p; ls += p; }
            l = l * alpha + ls;
#pragma unroll
            for (int db = 0; db < 2; ++db)
#pragma unroll
                for (int i = 0; i < 16; ++i) o[db][i] *= alpha;
#pragma unroll
            for (int kb = 0; kb < 2; ++kb)
#pragma unroll
                for (int s2 = 0; s2 < 2; ++s2) {
                    u32x4 pw; pw.x = pkbf(sc[kb][8 * s2 + 0], sc[kb][8 * s2 + 1]); pw.y = pkbf(sc[kb][8 * s2 + 2], sc[kb][8 * s2 + 3]);
                    pw.z = pkbf(sc[kb][8 * s2 + 4], sc[kb][8 * s2 + 5]); pw.w = pkbf(sc[kb][8 * s2 + 6], sc[kb][8 * s2 + 7]);
                    const bf16x8 pf = __builtin_bit_cast(bf16x8, pw);
#pragma unroll
                    for (int db = 0; db < 2; ++db) o[db] = __builtin_amdgcn_mfma_f32_32x32x16_bf16(vf[(kb * 2 + s2) * 2 + db], pf, o[db], 0, 0, 0);
                }
        }
        l += __shfl_xor(l, 32); const float inv = 1.f / l;
        const bf16* gp = proj + rowq * NPROJ + (2560 + h * 64 + 4 * hi); bf16* yp = Y + rowq * DM + (512 + h * 64 + 4 * hi);
#pragma unroll
        for (int db = 0; db < 2; ++db)
#pragma unroll
            for (int i4 = 0; i4 < 4; ++i4) {
                const u32x2 gw = *(const u32x2*)(gp + (32 * db + 8 * i4));
                const float o0 = o[db][4 * i4 + 0] * inv * silu_f(bf_lo(gw.x)), o1 = o[db][4 * i4 + 1] * inv * silu_f(bf_hi(gw.x));
                const float o2 = o[db][4 * i4 + 2] * inv * silu_f(bf_lo(gw.y)), o3 = o[db][4 * i4 + 3] * inv * silu_f(bf_hi(gw.y));
                u32x2 ow; ow.x = pkbf(o0, o1); ow.y = pkbf(o2, o3); *(u32x2*)(yp + (32 * db + 8 * i4)) = ow; }
    }
}

__global__ void __launch_bounds__(NWAVES * 64, 2) fwd_mega(Args a) {
    extern __shared__ __attribute__((aligned(16))) unsigned char lds[];
    cg::grid_group grid = cg::this_grid();
    const int tid = threadIdx.x, lane = tid & 63, wave = __builtin_amdgcn_readfirstlane(tid >> 6);
    const int G = gridDim.x, bx = blockIdx.x; const int vcu = (G % 8 == 0) ? (bx % 8) * (G / 8) + bx / 8 : bx;
    unsigned char* ws = a.ws;
    bf16* WinT = (bf16*)(ws + WS_WINT); bf16* WoutT = (bf16*)(ws + WS_WOUTT); bf16* PoolWT = (bf16*)(ws + WS_POOLWT);
    float* part = (float*)(ws + WS_PART); bf16* XN = (bf16*)(ws + WS_XN); bf16* PROJ = (bf16*)(ws + WS_PROJ); bf16* VF = (bf16*)(ws + WS_VT); bf16* KF = (bf16*)(ws + WS_KF); bf16* Y = (bf16*)(ws + WS_Y);
    const int gw = vcu * NWAVES + wave, NGW = G * NWAVES;
    volatile LAS unsigned* xst = (volatile LAS unsigned*)((LAS unsigned char*)lds + 131072);
    if (tid < 2) xst[tid] = 0u;
    __syncthreads();
    const XcdBarrier xbar = xcd_barrier_post((unsigned*)ws, xst);

    {
        LAS float* scr = (LAS float*)((LAS unsigned char*)lds + wave * 16384);
        constexpr int I_IN = (DM / 64) * (NPROJ / 32), I_OUT = (DM / 64) * (DM / 32), I_PW = (128 / 64) * (128 / 32);
        constexpr int NITEMS = I_IN + I_OUT + 4 * I_PW;
        for (int it = gw; it < NITEMS; it += NGW) {
            int r = it;
            if (r < I_IN) { p0_transpose_item<false>(a.w_in, DM, NPROJ, WinT, scr, r, lane); continue; } r -= I_IN;
            if (r < I_OUT) { p0_transpose_item<false>(a.w_out, DM, DM, WoutT, scr, r, lane); continue; } r -= I_OUT;
            const int g = r / I_PW; r -= g * I_PW;
            p0_transpose_item<true>(a.pool_w + (size_t)g * 128 * 128, 128, 128, PoolWT + (size_t)g * 128 * 128, scr, r, lane);
        }
        f32x4 gv[4];
#pragma unroll
        for (int j = 0; j < 4; ++j) gv[j] = ((const f32x4*)a.norm_gain)[lane + 64 * j];
        for (int m0 = gw * 4; m0 < M; m0 += NGW * 4) {
            f32x4 v[4][4];
#pragma unroll
            for (int r = 0; r < 4; ++r) { const f32x4* xr = (const f32x4*)(a.x + (size_t)(m0 + r) * DM) + lane;
#pragma unroll
                for (int j = 0; j < 4; ++j) v[r][j] = __builtin_nontemporal_load(xr + 64 * j); }
#pragma unroll
            for (int r = 0; r < 4; ++r) { float ss = 0.f;
#pragma unroll
                for (int j = 0; j < 4; ++j) ss += (v[r][j][0] * v[r][j][0] + v[r][j][1] * v[r][j][1]) + (v[r][j][2] * v[r][j][2] + v[r][j][3] * v[r][j][3]);
                const float rstd = 1.0f / sqrtf(wave_sum(ss) * (1.f / DM) + EPS);
                unsigned long long* o8 = (unsigned long long*)(XN + (size_t)(m0 + r) * DM) + lane;
#pragma unroll
                for (int j = 0; j < 4; ++j) { const f32x4 t = v[r][j] * rstd * gv[j]; o8[64 * j] = (unsigned long long)pkbf(t[0], t[1]) | ((unsigned long long)pkbf(t[2], t[3]) << 32); } }
        }
    }
    grid.sync();

    {
        pg8::Gemm g{XN, WinT, M, NPROJ, DM}; pg8::StaticOrder S; S.init(M, NPROJ, G, bx);
        pg8::EpiProj E{PROJ, KF, VF};
        pg8::gemm_phase<pg8::EpiProj, pg8::StaticOrder, PG8_ALIGN, PG8_SP2>((PG8_LAS unsigned char*)lds, g, S, E);
    }
    xcd_barrier(xbar);

    {
        LAS float* tab = (LAS float*)((LAS unsigned char*)lds + NWAVES * WREG);
        LAS unsigned char* wl = (LAS unsigned char*)lds + wave * WREG;
        for (int i = tid; i < 8 * 256; i += NWAVES * 64) { const int hh = i >> 8, e = i & 255;
            const int src_i = (e < 129) ? e : ((e - 129 - 63) > 0 ? (e - 129 - 63) : 0); tab[i] = a.rel_bias[hh * 129 + src_i] * LOG2E; }
        __syncthreads();
        for (int unit = vcu; unit < BATCH * NCHUNK; unit += G) {
            const int b = unit / NCHUNK, c = unit % NCHUNK;
            const int g = wave >> 1, th = wave & 1;
            int ln = lane; asm volatile("" : "+v"(ln));
            switch (g) {
                case 0: pool_unit<2>(PROJ, PoolWT, a.pool_scale, Y, wl, b, c, 0, th, ln); break;
                case 1: pool_unit<4>(PROJ, PoolWT, a.pool_scale, Y, wl, b, c, 1, th, ln); break;
                case 2: pool_unit<8>(PROJ, PoolWT, a.pool_scale, Y, wl, b, c, 2, th, ln); break;
                default: pool_unit<16>(PROJ, PoolWT, a.pool_scale, Y, wl, b, c, 3, th, ln); break;
            }
            asm volatile("" : "+v"(ln));
            attn_unit(PROJ, KF, VF, Y, tab + wave * 256, b, c, wave, ln);
        }
    }
    xcd_barrier(xbar);

    {
        pg8::Gemm g{Y, WoutT, M, DM, DM}; pg8::StaticOrder S; S.init(M, DM, G, bx);
        pg8::EpiOut E{a.x, a.out, part};
        pg8::gemm_phase<pg8::EpiOut, pg8::StaticOrder, PG8_ALIGN, PG8_SP2>((PG8_LAS unsigned char*)lds, g, S, E);
    }
    xcd_barrier(xbar);

    {
        f32x4 gv[4];
#pragma unroll
        for (int j = 0; j < 4; ++j) gv[j] = ((const f32x4*)a.fgain)[lane + 64 * j];
        for (int m0 = gw * 4; m0 < M; m0 += NGW * 4) {
            f32x4 v[4][4]; float ps[4];
#pragma unroll
            for (int r = 0; r < 4; ++r) { ps[r] = (lane < 16) ? part[(size_t)(m0 + r) * 16 + lane] : 0.f;
                const f32x4* xr = (const f32x4*)(a.out + (size_t)(m0 + r) * DM) + lane;
#pragma unroll
                for (int j = 0; j < 4; ++j) v[r][j] = xr[64 * j]; }
#pragma unroll
            for (int r = 0; r < 4; ++r) { const float rstd = 1.0f / sqrtf(wave_sum(ps[r]) * (1.f / DM) + EPS);
                f32x4* xr = (f32x4*)(a.out + (size_t)(m0 + r) * DM) + lane;
#pragma unroll
                for (int j = 0; j < 4; ++j) __builtin_nontemporal_store(v[r][j] * rstd * gv[j], xr + 64 * j); }
        }
    }
}

extern "C" void kernel_launch(void* const* d_in, const int* in_sizes, int n_in, void* d_out, int out_size, void* d_ws, size_t ws_size, hipStream_t stream) {
    static int grid = 0;
    if (grid == 0) {
        if (n_in != 8 || in_sizes[0] != M * DM || out_size != M * DM || ws_size < WS_END) { fprintf(stderr, "kernel_launch: unexpected shapes (n_in %d, in0 %d, out %d, ws %zu); nothing launched\n", n_in, n_in > 0 ? in_sizes[0] : -1, out_size, ws_size); grid = -1; return; }
        int dev = 0, cus = 0, per_cu = 0;
        if (hipGetDevice(&dev) != hipSuccess || hipDeviceGetAttribute(&cus, hipDeviceAttributeMultiprocessorCount, dev) != hipSuccess) { fprintf(stderr, "kernel_launch: device query failed\n"); grid = -1; return; }
        if (hipFuncSetAttribute((const void*)fwd_mega, hipFuncAttributeMaxDynamicSharedMemorySize, LDS_BYTES) != hipSuccess) { fprintf(stderr, "kernel_launch: hipFuncSetAttribute failed\n"); grid = -1; return; }
        if (hipOccupancyMaxActiveBlocksPerMultiprocessor(&per_cu, (const void*)fwd_mega, NWAVES * 64, LDS_BYTES) != hipSuccess || per_cu < 1) { fprintf(stderr, "kernel_launch: occupancy query gave %d blocks per CU\n", per_cu); (void)hipGetLastError(); grid = -1; return; }
        grid = cus * per_cu;
    }
    if (grid < 0) return;
    if (hipMemsetAsync(d_ws, 0, 65536, stream) != hipSuccess) { fprintf(stderr, "kernel_launch: hipMemsetAsync failed\n"); return; }
    Args a{};
    a.x = (const float*)d_in[0]; a.norm_gain = (const float*)d_in[1]; a.w_in = (const float*)d_in[2]; a.pool_w = (const float*)d_in[3]; a.pool_scale = (const float*)d_in[4];
    a.rel_bias = (const float*)d_in[5]; a.w_out = (const float*)d_in[6]; a.fgain = (const float*)d_in[7]; a.out = (float*)d_out; a.ws = (unsigned char*)d_ws;
    void* args[] = {&a};
    hipError_t e = hipLaunchCooperativeKernel((const void*)fwd_mega, dim3(grid), dim3(NWAVES * 64), args, LDS_BYTES, stream);
    if (e != hipSuccess) fprintf(stderr, "kernel_launch: cooperative launch failed: %s (grid %d)\n", hipGetErrorString(e), grid);
}
```

```cpp
#include <hip/hip_runtime.h>
#include <hip/hip_cooperative_groups.h>
#include <cstdio>
#include <cstdint>
namespace pg8 {
#define PG8_LAS __attribute__((address_space(3)))
typedef unsigned short bf16_t;
typedef short bf16x8 __attribute__((ext_vector_type(8)));
typedef float f32x4 __attribute__((ext_vector_type(4)));
typedef unsigned u32x4 __attribute__((ext_vector_type(4)));
constexpr int BM = 256, BK = 64, HALF = 128, HTB = HALF * BK * 2  , STAGE_BYTES = 8 * HTB, NXCD = 8, WGM = 8;

__host__ __device__ __forceinline__ int lds_byte(int r, int c) { const int st = (r >> 4) * 2 + (c >> 5), rr = r & 15, cc = c & 31, ob = rr * 64 + cc * 2; return st * 1024 + (ob ^ (((ob >> 9) & 1) << 5)); }
__host__ __device__ __forceinline__ void stage_rc(int b, int& R, int& C) { const int st = b / 1024, sb = b % 1024, swz = sb ^ (((sb >> 9) & 1) << 5); R = (st >> 1) * 16 + swz / 64; C = (st & 1) * 32 + (swz % 64) / 2; }
__host__ __device__ __forceinline__ int perm32(int rho) { const int n = rho >> 4, i = rho & 15; return 8 * (i >> 2) + 4 * n + (i & 3); }

struct Unit { int pm, pn; };
struct Gemm { const bf16_t* A; const bf16_t* Bt; int M, N, K; };

struct StaticOrder {
    int nM, nN, nwg, G, c;
    __host__ __device__ void init(int M, int N, int G_, int c_) { nM = M / BM; nN = N / BM; nwg = nM * nN; G = G_; c = c_; }
    __host__ __device__ bool next(int i, Unit& u) const {
        const long L = (long)i * G + c; if (L >= nwg) return false;
        int wgid = (int)L; { const int q = nwg / NXCD, r = nwg % NXCD, xcd = wgid % NXCD, off = wgid / NXCD; wgid = (xcd < r ? xcd * (q + 1) : r * (q + 1) + (xcd - r) * q) + off; }
        const int nig = WGM * nN, gid = wgid / nig, fm = gid * WGM, gsz = (nM - fm) < WGM ? (nM - fm) : WGM;
        u.pm = fm + ((wgid % nig) % gsz); u.pn = (wgid % nig) / gsz; return true;
    }
    __device__ __forceinline__ void a_ready(const Unit&) const {}
    __device__ __forceinline__ void done(const Unit&) const {}
};

__device__ __forceinline__ unsigned cvt_pk_bf16(float lo, float hi) { unsigned r; asm volatile("v_cvt_pk_bf16_f32 %0, %1, %2" : "=v"(r) : "v"(lo), "v"(hi)); return r; }
__device__ __forceinline__ unsigned short bf16_1(float v) { return (unsigned short)(cvt_pk_bf16(v, v) & 0xffffu); }
struct EpiProj {
    static constexpr bool PERM = true, AFTER_DRAIN = false;
    bf16_t* P; bf16_t* KF; bf16_t* VF;
    __device__ __forceinline__ void operator()(const f32x4 (&acc)[2][2][4][2], const Unit& u, int wr, int wc, int fr, int fq) const {
        const int row0 = u.pm * BM + wr * 64 + fr, col0 = u.pn * BM + wc * 32 + 8 * fq;
        if (u.pn == 6 || u.pn == 7) {
            const int b = row0 >> 13, s0 = row0 & 8191;
#pragma unroll
            for (int ai = 0; ai < 2; ++ai)
#pragma unroll
                for (int m = 0; m < 4; ++m) { const int s = s0 + ai * HALF + m * 16;
#pragma unroll
                    for (int bj = 0; bj < 2; ++bj) { const int ck = col0 - 1536 + bj * HALF, h = ck >> 6, d0 = ck & 63;
                        const size_t idx = ((((((size_t)(b * 8 + h) * 256 + (s >> 5)) * 4 + (d0 >> 4)) * 2 + ((d0 >> 3) & 1)) * 32 + (s & 31))) * 8;
                        const f32x4 v0 = acc[ai][bj][m][0], v1 = acc[ai][bj][m][1];
                        u32x4 w; w.x = cvt_pk_bf16(v0[0], v0[1]); w.y = cvt_pk_bf16(v0[2], v0[3]); w.z = cvt_pk_bf16(v1[0], v1[1]); w.w = cvt_pk_bf16(v1[2], v1[3]);
                        *(u32x4*)(KF + idx) = w; } }
        } else if (u.pn == 8 || u.pn == 9) {
            const int b = row0 >> 13, s0 = row0 & 8191;
#pragma unroll
            for (int ai = 0; ai < 2; ++ai)
#pragma unroll
                for (int m = 0; m < 4; ++m) { const int s = s0 + ai * HALF + m * 16;
                    const int sj = ((s >> 3) & 1) * 4 + (s & 3), shi = (s >> 2) & 1, ss2 = (s >> 4) & 1, sblk = s >> 5;
#pragma unroll
                    for (int bj = 0; bj < 2; ++bj) { const int cv = col0 - 2048 + bj * HALF, h = cv >> 6, d0 = cv & 63;
                        bf16_t* base = VF + (((((((size_t)(b * 8 + h) * 256 + sblk) * 2 + ss2) * 2 + (d0 >> 5)) * 2 + shi) * 32 + (d0 & 31))) * 8 + sj;
#pragma unroll
                        for (int n = 0; n < 2; ++n)
#pragma unroll
                            for (int e = 0; e < 4; ++e) base[(4 * n + e) * 8] = bf16_1(acc[ai][bj][m][n][e]); } }
        } else {
#pragma unroll
            for (int ai = 0; ai < 2; ++ai)
#pragma unroll
                for (int m = 0; m < 4; ++m) { bf16_t* rowp = P + (size_t)(row0 + ai * HALF + m * 16) * 3072 + col0;
#pragma unroll
                    for (int bj = 0; bj < 2; ++bj) { const f32x4 v0 = acc[ai][bj][m][0], v1 = acc[ai][bj][m][1];
                        u32x4 w; w.x = cvt_pk_bf16(v0[0], v0[1]); w.y = cvt_pk_bf16(v0[2], v0[3]); w.z = cvt_pk_bf16(v1[0], v1[1]); w.w = cvt_pk_bf16(v1[2], v1[3]);
                        *(u32x4*)(rowp + bj * HALF) = w; } }
        }
    }
};
struct EpiOut {
    static constexpr bool PERM = false, AFTER_DRAIN = false;
    const float* X; float* O; unsigned* part; unsigned* cnt; const float* gain;
    __device__ __forceinline__ void operator()(f32x4 (&acc)[2][2][4][2], const Unit& u, int wr, int wc, int fr, int fq) const {
        const int row0 = u.pm * BM + wr * 64 + fr, col0 = u.pn * BM + wc * 32 + 4 * fq;
#pragma unroll
        for (int ai = 0; ai < 2; ++ai)
#pragma unroll
            for (int m = 0; m < 4; ++m) { const int row = row0 + ai * HALF + m * 16; const size_t off = (size_t)row * 1024 + col0; float ss = 0.f;
#pragma unroll
                for (int bj = 0; bj < 2; ++bj)
#pragma unroll
                    for (int n = 0; n < 2; ++n) { const f32x4 xv = *(const f32x4*)(X + off + bj * HALF + n * 16); const f32x4 o = xv + acc[ai][bj][m][n];
                        acc[ai][bj][m][n] = o; ss += (o[0] * o[0] + o[1] * o[1]) + (o[2] * o[2] + o[3] * o[3]); }
                ss += __shfl_xor(ss, 16); ss += __shfl_xor(ss, 32);
                if (fq == 0) __hip_atomic_store(part + (size_t)row * 16 + u.pn * 4 + wc, __builtin_bit_cast(unsigned, ss), __ATOMIC_RELAXED, __HIP_MEMORY_SCOPE_AGENT); }
        asm volatile("s_waitcnt vmcnt(0)" ::: "memory");
        unsigned* cw = cnt + 64 * u.pm;
        if ((threadIdx.x & 63) == 0) __hip_atomic_fetch_add(cw, 1u, __ATOMIC_RELAXED, __HIP_MEMORY_SCOPE_AGENT);
        { unsigned sp = 0;
          while ((unsigned)__builtin_amdgcn_readfirstlane(__hip_atomic_load(cw, __ATOMIC_RELAXED, __HIP_MEMORY_SCOPE_AGENT)) < 32u) { __builtin_amdgcn_s_sleep(1); if (++sp > (1u << 22)) break; } }
        asm volatile("" ::: "memory");
        f32x4 gv[2][2];
#pragma unroll
        for (int bj = 0; bj < 2; ++bj)
#pragma unroll
            for (int n = 0; n < 2; ++n) gv[bj][n] = *(const f32x4*)(gain + col0 + bj * HALF + n * 16);
        unsigned long long w0[8], w1[8];
#pragma unroll
        for (int t = 0; t < 8; ++t) { const int row = row0 + (t >> 2) * HALF + (t & 3) * 16;
            const unsigned long long* pp = (const unsigned long long*)(part + (size_t)row * 16 + 4 * fq);
            w0[t] = __hip_atomic_load(pp, __ATOMIC_RELAXED, __HIP_MEMORY_SCOPE_AGENT); w1[t] = __hip_atomic_load(pp + 1, __ATOMIC_RELAXED, __HIP_MEMORY_SCOPE_AGENT); }
        asm volatile("" ::: "memory");
#pragma unroll
        for (int ai = 0; ai < 2; ++ai)
#pragma unroll
            for (int m = 0; m < 4; ++m) { const int t = ai * 4 + m; const int row = row0 + ai * HALF + m * 16; const size_t off = (size_t)row * 1024 + col0;
                float tot = (__builtin_bit_cast(float, (unsigned)w0[t]) + __builtin_bit_cast(float, (unsigned)(w0[t] >> 32))) + (__builtin_bit_cast(float, (unsigned)w1[t]) + __builtin_bit_cast(float, (unsigned)(w1[t] >> 32)));
                tot += __shfl_xor(tot, 16); tot += __shfl_xor(tot, 32);
                const float rstd = 1.0f / sqrtf(tot * (1.f / 1024.f) + 1e-6f);
#pragma unroll
                for (int bj = 0; bj < 2; ++bj)
#pragma unroll
                    for (int n = 0; n < 2; ++n) __builtin_nontemporal_store(acc[ai][bj][m][n] * rstd * gv[bj][n], (f32x4*)(O + off + bj * HALF + n * 16)); }
    }
};
template <class Epi, class Sched, bool ALIGN_EPI = false, bool SP2 = false>
__device__ __forceinline__ void gemm_phase(PG8_LAS unsigned char* lds, const Gemm g, const Sched& S, const Epi& E) {
    int tid_ = threadIdx.x; asm volatile("" : "+v"(tid_));
    const int tid = tid_, wid = __builtin_amdgcn_readfirstlane(tid >> 6), lane = tid & 63, wr = wid >> 2, wc = wid & 3, fr = lane & 15, fq = lane >> 4;
    const int K = g.K, nt = K / BK;
    unsigned voffA[2], voffB[2];
#pragma unroll
    for (int i = 0; i < 2; ++i) { int R, C; stage_rc(tid * 16 + i * 8192, R, C); const int Rb = Epi::PERM ? ((R & ~31) + perm32(R & 31)) : R;
        voffA[i] = (unsigned)(R * K + C) * 2u; voffB[i] = (unsigned)(Rb * K + C) * 2u; }
    const size_t kstep = (size_t)(BK * 2);
    const size_t hstep = (size_t)HALF * K * 2;
    const size_t tstep = 2 * hstep;
    const unsigned ldsw = (unsigned)wid * 1024u;
    const int aoff = lds_byte(wr * 64 + fr, fq * 8), boff = lds_byte(wc * 32 + fr, fq * 8);
#define PG8_SA(b, h) (((b) * 2 + (h)) * HTB)
#define PG8_SB(b, h) ((4 + (b) * 2 + (h)) * HTB)
#define PG8_STAGE(bufoff, gbase, voff) do { _Pragma("unroll") for (int _i = 0; _i < 2; ++_i) \
        __builtin_amdgcn_global_load_lds((const unsigned*)((const char*)(gbase) + (voff)[_i]), (PG8_LAS unsigned*)(lds + (bufoff) + ldsw + _i * 8192), 16, 0, 0); } while (0)
#define PG8_LDA(dst, b, h) do { _Pragma("unroll") for (int m = 0; m < 4; ++m) _Pragma("unroll") for (int k = 0; k < 2; ++k) dst[m][k] = *(const PG8_LAS bf16x8*)(lds + PG8_SA(b, h) + aoff + m * 2048 + k * 1024); } while (0)
#define PG8_LDB(dst, b, h) do { _Pragma("unroll") for (int n = 0; n < 2; ++n) _Pragma("unroll") for (int k = 0; k < 2; ++k) dst[n][k] = *(const PG8_LAS bf16x8*)(lds + PG8_SB(b, h) + boff + n * 2048 + k * 1024); } while (0)
#define PG8_MMA(ai, bj, At, Bt) do { __builtin_amdgcn_s_setprio(1); _Pragma("unroll") for (int m = 0; m < 4; ++m) _Pragma("unroll") for (int n = 0; n < 2; ++n) _Pragma("unroll") for (int k = 0; k < 2; ++k) \
        acc[ai][bj][m][n] = __builtin_amdgcn_mfma_f32_16x16x32_bf16(Bt[n][k], At[m][k], acc[ai][bj][m][n], 0, 0, 0); __builtin_amdgcn_s_setprio(0); } while (0)
#define PG8_WAIT_V(n) asm volatile("s_waitcnt vmcnt(" #n ")" ::: "memory")
#define PG8_WAIT_L(n) asm volatile("s_waitcnt lgkmcnt(" #n ")" ::: "memory")
#define PG8_BAR __builtin_amdgcn_s_barrier()
#define PG8_SCHED __builtin_amdgcn_sched_barrier(0)
    Unit cur, nxt; int ui = 0;
    if (!S.next(0, cur)) return;
    f32x4 acc[2][2][4][2];
#pragma unroll
    for (int a = 0; a < 2; ++a)
#pragma unroll
        for (int b = 0; b < 2; ++b)
#pragma unroll
            for (int m = 0; m < 4; ++m)
#pragma unroll
                for (int n = 0; n < 2; ++n) acc[a][b][m][n] = (f32x4){0.f, 0.f, 0.f, 0.f};
    bf16x8 At[4][2], B0[2][2], B1[2][2];
    const char* cA = (const char*)g.A + (size_t)cur.pm * tstep; const char* cB = (const char*)g.Bt + (size_t)cur.pn * tstep;
    S.a_ready(cur);
    if constexpr (SP2) {
        PG8_STAGE(PG8_SB(0, 0), cB, voffB); PG8_STAGE(PG8_SB(0, 1), cB + hstep, voffB); PG8_STAGE(PG8_SA(0, 0), cA, voffA); PG8_STAGE(PG8_SA(0, 1), cA + hstep, voffA);
        if (wr == 1) PG8_BAR;
        PG8_WAIT_V(2); PG8_BAR;
        PG8_STAGE(PG8_SB(1, 0), cB + kstep, voffB); PG8_STAGE(PG8_SA(1, 0), cA + kstep, voffA); PG8_STAGE(PG8_SB(1, 1), cB + hstep + kstep, voffB);
        PG8_WAIT_V(6); PG8_BAR;
    } else {
        PG8_STAGE(PG8_SB(0, 0), cB, voffB); PG8_STAGE(PG8_SA(0, 0), cA, voffA); PG8_STAGE(PG8_SB(0, 1), cB + hstep, voffB); PG8_STAGE(PG8_SA(0, 1), cA + hstep, voffA);
        if (wr == 1) PG8_BAR;
        PG8_WAIT_V(4); PG8_BAR;
        PG8_STAGE(PG8_SB(1, 0), cB + kstep, voffB); PG8_STAGE(PG8_SA(1, 0), cA + kstep, voffA); PG8_STAGE(PG8_SB(1, 1), cB + hstep + kstep, voffB);
        PG8_WAIT_V(6); PG8_BAR;
    }
    for (;;) {
        const bool has_next = S.next(ui + 1, nxt);
        const char* nA = has_next ? (const char*)g.A + (size_t)nxt.pm * tstep : cA; const char* nB = has_next ? (const char*)g.Bt + (size_t)nxt.pn * tstep : cB;
        for (int t = 0; t < nt; t += 2) {
            const bool last = (t == nt - 2);
            const char* a1 = cA + (size_t)(t + 1) * kstep;
            const char* a2 = last ? nA : cA + (size_t)(t + 2) * kstep; const char* b2 = last ? nB : cB + (size_t)(t + 2) * kstep;
            const char* a3 = a2 + kstep; const char* b3 = b2 + kstep;
            if (last && has_next) S.a_ready(nxt);
            if constexpr (SP2) {
            PG8_LDB(B0, 0, 0); PG8_LDB(B1, 0, 1); PG8_SCHED; PG8_LDA(At, 0, 0); PG8_STAGE(PG8_SA(1, 1), a1 + hstep, voffA);
            PG8_WAIT_V(8); PG8_WAIT_L(0); PG8_BAR; PG8_MMA(0, 0, At, B0); PG8_MMA(0, 1, At, B1); PG8_BAR; PG8_SCHED;
            PG8_LDA(At, 0, 1); PG8_STAGE(PG8_SB(0, 0), b2, voffB); PG8_STAGE(PG8_SB(0, 1), b2 + hstep, voffB); PG8_STAGE(PG8_SA(0, 0), a2, voffA);
            PG8_WAIT_V(8); PG8_WAIT_L(0); PG8_BAR; PG8_MMA(1, 0, At, B0); PG8_MMA(1, 1, At, B1); PG8_BAR; PG8_SCHED;
            PG8_LDB(B0, 1, 0); PG8_LDB(B1, 1, 1); PG8_SCHED; PG8_LDA(At, 1, 0); PG8_STAGE(PG8_SA(0, 1), a2 + hstep, voffA);
            PG8_WAIT_V(8); PG8_WAIT_L(0); PG8_BAR; PG8_MMA(0, 0, At, B0); PG8_MMA(0, 1, At, B1); PG8_BAR; PG8_SCHED;
            PG8_LDA(At, 1, 1); PG8_STAGE(PG8_SB(1, 0), b3, voffB); PG8_STAGE(PG8_SB(1, 1), b3 + hstep, voffB); PG8_STAGE(PG8_SA(1, 0), a3, voffA);
            PG8_WAIT_V(8); PG8_WAIT_L(0); PG8_BAR; PG8_MMA(1, 0, At, B0); PG8_MMA(1, 1, At, B1); PG8_BAR; PG8_SCHED;
            } else {
            PG8_LDB(B0, 0, 0); PG8_SCHED; PG8_LDA(At, 0, 0); PG8_STAGE(PG8_SA(1, 1), a1 + hstep, voffA);
            PG8_WAIT_L(8); PG8_BAR; PG8_WAIT_L(0); PG8_MMA(0, 0, At, B0); PG8_BAR; PG8_SCHED;
            PG8_LDB(B1, 0, 1); PG8_STAGE(PG8_SB(0, 0), b2, voffB);
            PG8_BAR; PG8_WAIT_L(0); PG8_MMA(0, 1, At, B1); PG8_BAR;
            PG8_LDA(At, 0, 1); PG8_STAGE(PG8_SA(0, 0), a2, voffA);
            PG8_BAR; PG8_WAIT_L(0); PG8_MMA(1, 0, At, B0); PG8_BAR; PG8_SCHED;
            PG8_STAGE(PG8_SB(0, 1), b2 + hstep, voffB);
            PG8_WAIT_V(6); PG8_BAR; PG8_MMA(1, 1, At, B1); PG8_BAR;
            PG8_LDB(B0, 1, 0); PG8_SCHED; PG8_LDA(At, 1, 0); PG8_STAGE(PG8_SA(0, 1), a2 + hstep, voffA);
            PG8_WAIT_L(8); PG8_BAR; PG8_WAIT_L(0); PG8_MMA(0, 0, At, B0); PG8_BAR; PG8_SCHED;
            PG8_LDB(B1, 1, 1); PG8_STAGE(PG8_SB(1, 0), b3, voffB);
            PG8_BAR; PG8_WAIT_L(0); PG8_MMA(0, 1, At, B1); PG8_BAR;
            PG8_LDA(At, 1, 1); PG8_STAGE(PG8_SA(1, 0), a3, voffA);
            PG8_BAR; PG8_WAIT_L(0); PG8_MMA(1, 0, At, B0); PG8_BAR; PG8_SCHED;
            PG8_STAGE(PG8_SB(1, 1), b3 + hstep, voffB);
            PG8_WAIT_V(6); PG8_BAR; PG8_MMA(1, 1, At, B1); PG8_BAR;
            }
        }
        if constexpr (ALIGN_EPI) { if (wr == 0) PG8_BAR; }
        if constexpr (!Epi::AFTER_DRAIN) { E(acc, cur, wr, wc, fr, fq); S.done(cur); }
        if (!has_next) break;
#pragma unroll
        for (int a = 0; a < 2; ++a)
#pragma unroll
            for (int b = 0; b < 2; ++b)
#pragma unroll
                for (int m = 0; m < 4; ++m)
#pragma unroll
                    for (int n = 0; n < 2; ++n) acc[a][b][m][n] = (f32x4){0.f, 0.f, 0.f, 0.f};
        cur = nxt; cA = nA; cB = nB; ++ui;
        if constexpr (ALIGN_EPI) { if (wr == 1) PG8_BAR; }
    }
    PG8_WAIT_V(0);
    if constexpr (!ALIGN_EPI) { if (wr == 0) PG8_BAR; }
    PG8_BAR;
    if constexpr (Epi::AFTER_DRAIN) { E.fused(acc, cur, wr, wc, fr, fq, lds, wid, lane); S.done(cur); }
#undef PG8_SA
#undef PG8_SB
#undef PG8_STAGE
#undef PG8_LDA
#undef PG8_LDB
#undef PG8_MMA
#undef PG8_WAIT_V
#undef PG8_WAIT_L
#undef PG8_BAR
#undef PG8_SCHED
}
}
#ifndef PG8_SP2
#define PG8_SP2 true
#endif
#ifndef PG8_ALIGN
#define PG8_ALIGN true
#endif
namespace cg = cooperative_groups;
#define LAS __attribute__((address_space(3)))
typedef unsigned short bf16;
typedef float f32x4 __attribute__((ext_vector_type(4)));
typedef float f32x16 __attribute__((ext_vector_type(16)));
typedef short bf16x8 __attribute__((ext_vector_type(8)));
typedef unsigned u32x4 __attribute__((ext_vector_type(4)));
typedef unsigned u32x2 __attribute__((ext_vector_type(2)));

constexpr int NWAVES = 8;
constexpr int BATCH = 8, SEQ = 8192, DM = 1024, M = BATCH * SEQ, NPROJ = 3072, CHUNK = 64, NCHUNK = SEQ / CHUNK;
constexpr float EPS = 1e-6f, LOG2E = 1.4426950408889634f, SCL = 0.125f * 1.4426950408889634f;
constexpr size_t MiB = 1u << 20;
constexpr size_t WS_WINT = 1 * MiB, WS_WOUTT = 8 * MiB, WS_POOLWT = 10 * MiB, WS_PART = 12 * MiB, WS_XN = 16 * MiB, WS_PROJ = 144 * MiB, WS_VT = 528 * MiB, WS_Y = 592 * MiB, WS_KF = 720 * MiB, WS_END = 784 * MiB;
constexpr int LDS_BYTES = 147456;

__device__ __forceinline__ unsigned f2bf(float f) { unsigned u = __builtin_bit_cast(unsigned, f); return (u + 0x7fffu + ((u >> 16) & 1u)) >> 16; }
__device__ __forceinline__ unsigned pk2(float lo, float hi) { return f2bf(lo) | (f2bf(hi) << 16); }
typedef float f32x2_t __attribute__((ext_vector_type(2))); typedef __bf16 bf16x2_t __attribute__((ext_vector_type(2)));
__device__ __forceinline__ unsigned pkbf(float lo, float hi) { f32x2_t v = {lo, hi}; bf16x2_t b = __builtin_convertvector(v, bf16x2_t); return __builtin_bit_cast(unsigned, b); }
__device__ __forceinline__ float bf_lo(unsigned w) { return __builtin_bit_cast(float, w << 16); }
__device__ __forceinline__ float bf_hi(unsigned w) { return __builtin_bit_cast(float, w & 0xffff0000u); }
__device__ __forceinline__ float silu_f(float x) { return x * __builtin_amdgcn_rcpf(1.f + __builtin_amdgcn_exp2f(-x * LOG2E)); }
__device__ __forceinline__ float wave_sum(float v) {
#pragma unroll
    for (int o = 1; o < 64; o <<= 1) v += __shfl_xor(v, o);
    return v;
}

template <bool POOLF> __device__ __forceinline__ void p0_transpose_item(const float* W, int K, int N, bf16* WT, LAS float* scr, int item, int lane) {
    const int nblk = N / 32, kb = item / nblk, nb = item % nblk, k0 = 64 * kb, n0 = 32 * nb;
#pragma unroll 8
    for (int i = 0; i < 32; ++i) { const int kk = 2 * i + (lane >> 5); scr[kk * 33 + (lane & 31)] = W[(size_t)(k0 + kk) * N + n0 + (lane & 31)]; }
    asm volatile("s_waitcnt lgkmcnt(0)" ::: "memory");
    const int c = lane & 7;
#pragma unroll
    for (int j = 0; j < 4; ++j) { const int n = (lane >> 3) + 8 * j; const LAS float* s = scr + (8 * c) * 33 + n;
        u32x4 o; o.x = pk2(s[0 * 33], s[1 * 33]); o.y = pk2(s[2 * 33], s[3 * 33]); o.z = pk2(s[4 * 33], s[5 * 33]); o.w = pk2(s[6 * 33], s[7 * 33]);
        if (POOLF) { const int k = k0 + 8 * c, nn = n0 + n; *(u32x4*)(WT + (size_t)(((((k >> 4) * 4 + (nn >> 5)) * 2 + ((k >> 3) & 1)) * 32 + (nn & 31)) * 8)) = o; }
        else *(u32x4*)(WT + (size_t)(n0 + n) * K + k0 + 8 * c) = o; }
    asm volatile("s_waitcnt lgkmcnt(0)" ::: "memory");
}

typedef unsigned v4u __attribute__((ext_vector_type(4)));
#define XB_TMO      128
#define XB_XCNT(j)  (256  + 64 * (j))
#define XB_XSUB(j)  (1280 + 64 * (j))
#define XB_XGEN(j)  (2304 + 64 * (j))
#define XB_TOP      3328
#define XB_TOPGEN   3392
#define XCD_BAR_WORDS 3456
#define XB_SPIN_CAP (1u << 18)

__device__ __forceinline__ unsigned xb_ld(unsigned* p)              { return __hip_atomic_load(p, __ATOMIC_RELAXED, __HIP_MEMORY_SCOPE_AGENT); }
__device__ __forceinline__ unsigned xb_add(unsigned* p, unsigned v) { return __hip_atomic_fetch_add(p, v, __ATOMIC_RELAXED, __HIP_MEMORY_SCOPE_AGENT); }
__device__ __forceinline__ unsigned xb_xcc_id() { return (unsigned)__builtin_amdgcn_s_getreg((3 << 11) | 20) & 0xFu; }
#define XB_SPIN(cond, bar) do { unsigned _sp = 0; while (cond) { __builtin_amdgcn_s_sleep(1); \
    if ((++_sp & 255u) == 0u) { if (xb_ld(&(bar)[XB_TMO])) break; if (_sp > XB_SPIN_CAP) { atomicAdd(&(bar)[XB_TMO], 1u); break; } } } } while (0)

struct XcdBarrier {
    unsigned* bar; unsigned x;
    volatile LAS unsigned* st;
};

__device__ __forceinline__ XcdBarrier xcd_barrier_post(unsigned* bar, volatile LAS unsigned* st) {
    XcdBarrier b; b.bar = bar; b.x = xb_xcc_id(); b.st = st;
    if (threadIdx.x == 0) (void)xb_add(&bar[XB_XCNT(b.x)], 1u);
    return b;
}
__device__ __forceinline__ void xcd_barrier_complete(unsigned* bar, unsigned x, unsigned& nloc, unsigned& nx) {
    const unsigned G = gridDim.x * gridDim.y * gridDim.z;
    unsigned sum, cnt, mine, sp = 0u;
    for (;;) {
        sum = 0u; cnt = 0u; mine = 0u;
#pragma unroll
        for (unsigned j = 0; j < 16; ++j) { const unsigned c = xb_ld(&bar[XB_XCNT(j)]); sum += c; cnt += (c > 0u) ? 1u : 0u; mine = (j == x) ? c : mine; }
        if (sum == G) break;
        __builtin_amdgcn_s_sleep(1);
        if ((++sp & 255u) == 0u) { if (xb_ld(&bar[XB_TMO])) break; if (sp > XB_SPIN_CAP) { atomicAdd(&bar[XB_TMO], 1u); break; } }
    }
    nloc = mine > 0u ? mine : 1u; nx = cnt > 0u ? cnt : 1u;
}

__device__ __forceinline__ void xcd_barrier(const XcdBarrier& b) {
    asm volatile("s_waitcnt vmcnt(0)" ::: "memory");
    __syncthreads();
    if (threadIdx.x == 0) {
        unsigned* bar = b.bar;
        __builtin_amdgcn_s_waitcnt(0);
        unsigned nloc = b.st[0], nx = b.st[1];
        if (nloc == 0u) { xcd_barrier_complete(bar, b.x, nloc, nx); b.st[0] = nloc; b.st[1] = nx; }
        const unsigned old = xb_add(&bar[XB_XSUB(b.x)], 1u);
        const unsigned gen = old / nloc;
        if (old + 1u == (gen + 1u) * nloc) {
            __builtin_amdgcn_fence(__ATOMIC_RELEASE, "agent");
            asm volatile("s_waitcnt vmcnt(0)" ::: "memory");
            const unsigned og = xb_add(&bar[XB_TOP], 1u);
            const unsigned tg = og / nx;
            if (og + 1u == (tg + 1u) * nx) xb_add(&bar[XB_TOPGEN], 1u);
            else XB_SPIN(xb_ld(&bar[XB_TOPGEN]) == tg, bar);
            __builtin_amdgcn_fence(__ATOMIC_ACQUIRE, "agent");
            xb_add(&bar[XB_XGEN(b.x)], 1u);
            asm volatile("s_waitcnt vmcnt(0)" ::: "memory");
        } else {
            XB_SPIN(xb_ld(&bar[XB_XGEN(b.x)]) == gen, bar);
            __builtin_amdgcn_fence(__ATOMIC_ACQUIRE, "agent");
            asm volatile("s_waitcnt vmcnt(0)" ::: "memory");
        }
    }
    __syncthreads();
}

struct Args { const float* x; const float* norm_gain; const float* w_in; const float* pool_w; const float* pool_scale; const float* rel_bias; const float* w_out; const float* fgain; float* out; unsigned char* ws; };

constexpr int PROW = 272;
constexpr int WREG = 12800;
template <bool SCALE> __device__ __forceinline__ void epi_tile(LAS unsigned char* wl, const f32x16& v0, const f32x16& v1, float mul, const bf16* gbase, bf16* ybase, const float* scale, int lane) {
    LAS unsigned char* wp = wl + (lane & 31) * PROW + (lane >> 5) * 16;
#pragma unroll
    for (int i4 = 0; i4 < 4; ++i4) {
        *(LAS f32x4*)(wp + i4 * 32) = (f32x4){v0[4 * i4] * mul, v0[4 * i4 + 1] * mul, v0[4 * i4 + 2] * mul, v0[4 * i4 + 3] * mul};
        *(LAS f32x4*)(wp + 128 + i4 * 32) = (f32x4){v1[4 * i4] * mul, v1[4 * i4 + 1] * mul, v1[4 * i4 + 2] * mul, v1[4 * i4 + 3] * mul};
    }
    const int rr = lane >> 4, piece = lane & 15;
    f32x4 s = (f32x4){1.f, 1.f, 1.f, 1.f};
    if (SCALE) s = *(const f32x4*)(scale + 4 * piece);
#pragma unroll
    for (int it = 0; it < 8; ++it) { const int row = 4 * it + rr;
        const f32x4 x = *(const LAS f32x4*)(wl + row * PROW + piece * 16);
        const u32x2 gw = *(const u32x2*)(gbase + (size_t)row * NPROJ + 4 * piece);
        const float o0 = x[0] * s[0] * silu_f(bf_lo(gw.x)), o1 = x[1] * s[1] * silu_f(bf_hi(gw.x)), o2 = x[2] * s[2] * silu_f(bf_lo(gw.y)), o3 = x[3] * s[3] * silu_f(bf_hi(gw.y));
        u32x2 ow; ow.x = pkbf(o0, o1); ow.y = pkbf(o2, o3); *(u32x2*)(ybase + (size_t)row * DM + 4 * piece) = ow; }
}
template <int W> __device__ __forceinline__ void pool_unit(const bf16* proj, const bf16* pwf, const float* pool_scale, bf16* Y, LAS unsigned char* wl, int b, int c, int g, int th, int lane) {
    const int r32 = lane & 31, hi = lane >> 5;
    const int sb = c * CHUNK + th * 32, s = sb + r32; const size_t row = (size_t)b * SEQ + s;
#pragma unroll
    for (int i = 0; i < 12; ++i) { const int r0 = 4 * i + (lane >> 4), r = r0 < 46 ? r0 : 46, piece = lane & 15, u = sb - 15 + r, uc = u > 0 ? u : 0;
        u32x4 w = *(const u32x4*)(proj + ((size_t)b * SEQ + uc) * NPROJ + g * 128 + piece * 8);
        if (u < 0) w = (u32x4){0u, 0u, 0u, 0u};
        *(LAS u32x4*)(wl + r * PROW + piece * 16) = w; }
    const char* wt = (const char*)(pwf + (size_t)g * 128 * 128); const unsigned l16 = (unsigned)lane * 16u;
    const int cnt = (s + 1 < W) ? (s + 1) : W; const float inv = 1.f / (float)cnt;
    f32x16 acc[4];
#pragma unroll
    for (int db = 0; db < 4; ++db)
#pragma unroll
        for (int i = 0; i < 16; ++i) acc[db][i] = 0.f;
#pragma unroll 1
    for (int ks = 0; ks < 8; ++ks) {
        bf16x8 wf[4];
#pragma unroll
        for (int db = 0; db < 4; ++db) wf[db] = *(const bf16x8*)(wt + (ks * 4 + db) * 1024 + l16);
        float sum[8], own[8];
#pragma unroll
        for (int e = 0; e < 8; ++e) { sum[e] = 0.f; own[e] = 0.f; }
        const LAS unsigned char* rp = wl + (r32 + 15) * PROW + (2 * ks + hi) * 16;
#pragma unroll
        for (int i = 0; i < W; ++i) {
            const u32x4 w = *(const LAS u32x4*)(rp - i * PROW);
            const float f[8] = {bf_lo(w.x), bf_hi(w.x), bf_lo(w.y), bf_hi(w.y), bf_lo(w.z), bf_hi(w.z), bf_lo(w.w), bf_hi(w.w)};
#pragma unroll
            for (int e = 0; e < 8; ++e) { sum[e] += f[e]; if (i == 0) own[e] = f[e]; }
        }
        u32x4 o; o.x = pkbf(sum[0] * inv - own[0], sum[1] * inv - own[1]); o.y = pkbf(sum[2] * inv - own[2], sum[3] * inv - own[3]);
        o.z = pkbf(sum[4] * inv - own[4], sum[5] * inv - own[5]); o.w = pkbf(sum[6] * inv - own[6], sum[7] * inv - own[7]);
        const bf16x8 df = __builtin_bit_cast(bf16x8, o);
#pragma unroll
        for (int db = 0; db < 4; ++db) acc[db] = __builtin_amdgcn_mfma_f32_32x32x16_bf16(wf[db], df, acc[db], 0, 0, 0);
    }
    const size_t row0 = (size_t)b * SEQ + sb;
    epi_tile<true>(wl, acc[0], acc[1], 1.f, proj + row0 * NPROJ + (512 + g * 128), Y + row0 * DM + g * 128, pool_scale + g * 128, lane);
    epi_tile<true>(wl, acc[2], acc[3], 1.f, proj + row0 * NPROJ + (512 + g * 128 + 64), Y + row0 * DM + (g * 128 + 64), pool_scale + (g * 128 + 64), lane);
}
__device__ __forceinline__ void attn_unit(const bf16* proj, const bf16* KF, const bf16* VF, bf16* Y, const LAS float* tab, LAS unsigned char* wl, int b, int c, int h, int lane) {
    const int r32 = lane & 31, hi = lane >> 5;
    const int jstart = (c < 8) ? (8 - c) : 0;
    const char* kbase = (const char*)(KF + (size_t)(b * 8 + h) * 256 * 2048);
    const char* vbase = (const char*)(VF + (size_t)(b * 8 + h) * 256 * 2048);
    const unsigned l16 = (unsigned)lane * 16u;
    for (int qh = 0; qh < 2; ++qh) {
        const size_t rowq = (size_t)b * SEQ + c * CHUNK + qh * 32 + r32;
        bf16x8 qf[4];
#pragma unroll
        for (int ds = 0; ds < 4; ++ds) qf[ds] = *(const bf16x8*)(proj + rowq * NPROJ + 1024 + h * 64 + 16 * ds + 8 * hi);
        bf16x8 kf[8];
        { const int kblk = (c - 8 + jstart) * 2;
#pragma unroll
            for (int t = 0; t < 8; ++t) kf[t] = *(const bf16x8*)(kbase + (size_t)kblk * 4096 + t * 1024 + l16); }
        float m = -1e30f, l = 0.f; f32x16 o[2];
#pragma unroll
        for (int db = 0; db < 2; ++db)
#pragma unroll
            for (int i = 0; i < 16; ++i) o[db][i] = 0.f;
        const int dq = 4 * hi - (qh * 32 + r32);
        for (int j = jstart; j <= 8; ++j) {
            const int kblk = (c - 8 + j) * 2;
            f32x16 sc[2];
#pragma unroll
            for (int kb = 0; kb < 2; ++kb) {
#pragma unroll
                for (int i = 0; i < 16; ++i) sc[kb][i] = 0.f;
#pragma unroll
                for (int ds = 0; ds < 4; ++ds) sc[kb] = __builtin_amdgcn_mfma_f32_32x32x16_bf16(kf[kb * 4 + ds], qf[ds], sc[kb], 0, 0, 0);
            }
            __builtin_amdgcn_sched_barrier(0);
            bf16x8 vf[8];
#pragma unroll
            for (int t = 0; t < 8; ++t) vf[t] = *(const bf16x8*)(vbase + (size_t)kblk * 4096 + t * 1024 + l16);
            if (j < 8) {
#pragma unroll
                for (int t = 0; t < 8; ++t) kf[t] = *(const bf16x8*)(kbase + (size_t)(kblk + 2) * 4096 + t * 1024 + l16);
            }
            __builtin_amdgcn_sched_barrier(0);
            if (j <= 6) { const float b0 = tab[0];
#pragma unroll
                for (int kb = 0; kb < 2; ++kb)
#pragma unroll
                    for (int i = 0; i < 16; ++i) sc[kb][i] = sc[kb][i] * SCL + b0;
            } else {
                const LAS float* tp = tab + ((j == 8) ? 64 : (129 + 63)) + dq;
#pragma unroll
                for (int kb = 0; kb < 2; ++kb)
#pragma unroll
                    for (int i = 0; i < 16; ++i) sc[kb][i] = sc[kb][i] * SCL + tp[32 * kb + (i & 3) + 8 * (i >> 2)];
            }
            float mt = sc[0][0];
#pragma unroll
            for (int kb = 0; kb < 2; ++kb)
#pragma unroll
                for (int i = 0; i < 16; ++i) mt = fmaxf(mt, sc[kb][i]);
            mt = fmaxf(mt, __shfl_xor(mt, 32));
            const float mn = fmaxf(m, mt); const float alpha = __builtin_amdgcn_exp2f(m - mn); m = mn;
            float ls = 0.f;
#pragma unroll
            for (int kb = 0; kb < 2; ++kb)
#pragma unroll
                for (int i = 0; i < 16; ++i) { const float p = __builtin_amdgcn_exp2f(sc[kb][i] - mn); sc[kb][i] = p; ls += p; }
            l = l * alpha + ls;
#pragma unroll
            for (int db = 0; db < 2; ++db)
#pragma unroll
                for (int i = 0; i < 16; ++i) o[db][i] *= alpha;
#pragma unroll
            for (int kb = 0; kb < 2; ++kb)
#pragma unroll
                for (int s2 = 0; s2 < 2; ++s2) {
                    u32x4 pw; pw.x = pkbf(sc[kb][8 * s2 + 0], sc[kb][8 * s2 + 1]); pw.y = pkbf(sc[kb][8 * s2 + 2], sc[kb][8 * s2 + 3]);
                    pw.z = pkbf(sc[kb][8 * s2 + 4], sc[kb][8 * s2 + 5]); pw.w = pkbf(sc[kb][8 * s2 + 6], sc[kb][8 * s2 + 7]);
                    const bf16x8 pf = __builtin_bit_cast(bf16x8, pw);
#pragma unroll
                    for (int db = 0; db < 2; ++db) o[db] = __builtin_amdgcn_mfma_f32_32x32x16_bf16(vf[(kb * 2 + s2) * 2 + db], pf, o[db], 0, 0, 0);
                }
        }
        l += __shfl_xor(l, 32); const float inv = 1.f / l;
        const size_t row0 = (size_t)b * SEQ + c * CHUNK + qh * 32;
        epi_tile<false>(wl, o[0], o[1], inv, proj + row0 * NPROJ + (2560 + h * 64), Y + row0 * DM + (512 + h * 64), nullptr, lane);
    }
}

__global__ void __launch_bounds__(NWAVES * 64, 2) fwd_mega(Args a) {
    extern __shared__ __attribute__((aligned(16))) unsigned char lds[];
    cg::grid_group grid = cg::this_grid();
    const int tid = threadIdx.x, lane = tid & 63, wave = __builtin_amdgcn_readfirstlane(tid >> 6);
    const int G = gridDim.x, bx = blockIdx.x; const int vcu = (G % 8 == 0) ? (bx % 8) * (G / 8) + bx / 8 : bx;
    unsigned char* ws = a.ws;
    bf16* WinT = (bf16*)(ws + WS_WINT); bf16* WoutT = (bf16*)(ws + WS_WOUTT); bf16* PoolWT = (bf16*)(ws + WS_POOLWT);
    float* part = (float*)(ws + WS_PART); bf16* XN = (bf16*)(ws + WS_XN); bf16* PROJ = (bf16*)(ws + WS_PROJ); bf16* VF = (bf16*)(ws + WS_VT); bf16* KF = (bf16*)(ws + WS_KF); bf16* Y = (bf16*)(ws + WS_Y);
    const int gw = vcu * NWAVES + wave, NGW = G * NWAVES;
    volatile LAS unsigned* xst = (volatile LAS unsigned*)((LAS unsigned char*)lds + 131072);
    if (tid < 2) xst[tid] = 0u;
    __syncthreads();
    const XcdBarrier xbar = xcd_barrier_post((unsigned*)ws, xst);

    {
        LAS float* scr = (LAS float*)((LAS unsigned char*)lds + wave * 16384);
        constexpr int I_IN = (DM / 64) * (NPROJ / 32), I_OUT = (DM / 64) * (DM / 32), I_PW = (128 / 64) * (128 / 32);
        constexpr int NITEMS = I_IN + I_OUT + 4 * I_PW;
        for (int it = gw; it < NITEMS; it += NGW) {
            int r = it;
            if (r < I_IN) { p0_transpose_item<false>(a.w_in, DM, NPROJ, WinT, scr, r, lane); continue; } r -= I_IN;
            if (r < I_OUT) { p0_transpose_item<false>(a.w_out, DM, DM, WoutT, scr, r, lane); continue; } r -= I_OUT;
            const int g = r / I_PW; r -= g * I_PW;
            p0_transpose_item<true>(a.pool_w + (size_t)g * 128 * 128, 128, 128, PoolWT + (size_t)g * 128 * 128, scr, r, lane);
        }
        f32x4 gv[4];
#pragma unroll
        for (int j = 0; j < 4; ++j) gv[j] = ((const f32x4*)a.norm_gain)[lane + 64 * j];
        for (int m0 = gw * 4; m0 < M; m0 += NGW * 4) {
            f32x4 v[4][4];
#pragma unroll
            for (int r = 0; r < 4; ++r) { const f32x4* xr = (const f32x4*)(a.x + (size_t)(m0 + r) * DM) + lane;
#pragma unroll
                for (int j = 0; j < 4; ++j) v[r][j] = __builtin_nontemporal_load(xr + 64 * j); }
#pragma unroll
            for (int r = 0; r < 4; ++r) { float ss = 0.f;
#pragma unroll
                for (int j = 0; j < 4; ++j) ss += (v[r][j][0] * v[r][j][0] + v[r][j][1] * v[r][j][1]) + (v[r][j][2] * v[r][j][2] + v[r][j][3] * v[r][j][3]);
                const float rstd = 1.0f / sqrtf(wave_sum(ss) * (1.f / DM) + EPS);
                unsigned long long* o8 = (unsigned long long*)(XN + (size_t)(m0 + r) * DM) + lane;
#pragma unroll
                for (int j = 0; j < 4; ++j) { const f32x4 t = v[r][j] * rstd * gv[j]; o8[64 * j] = (unsigned long long)pkbf(t[0], t[1]) | ((unsigned long long)pkbf(t[2], t[3]) << 32); } }
        }
    }
    grid.sync();

    {
        pg8::Gemm g{XN, WinT, M, NPROJ, DM}; pg8::StaticOrder S; S.init(M, NPROJ, G, bx);
        pg8::EpiProj E{PROJ, KF, VF};
        pg8::gemm_phase<pg8::EpiProj, pg8::StaticOrder, PG8_ALIGN, PG8_SP2>((PG8_LAS unsigned char*)lds, g, S, E);
    }
    xcd_barrier(xbar);

    {
        LAS float* tab = (LAS float*)((LAS unsigned char*)lds + NWAVES * WREG);
        LAS unsigned char* wl = (LAS unsigned char*)lds + wave * WREG;
        for (int i = tid; i < 8 * 256; i += NWAVES * 64) { const int hh = i >> 8, e = i & 255;
            const int src_i = (e < 129) ? e : ((e - 129 - 63) > 0 ? (e - 129 - 63) : 0); tab[i] = a.rel_bias[hh * 129 + src_i] * LOG2E; }
        __syncthreads();
        for (int unit = vcu; unit < BATCH * NCHUNK; unit += G) {
            const int b = unit / NCHUNK, c = unit % NCHUNK;
            const int g = wave >> 1, th = wave & 1;
            int ln = lane; asm volatile("" : "+v"(ln));
            switch (g) {
                case 0: pool_unit<2>(PROJ, PoolWT, a.pool_scale, Y, wl, b, c, 0, th, ln); break;
                case 1: pool_unit<4>(PROJ, PoolWT, a.pool_scale, Y, wl, b, c, 1, th, ln); break;
                case 2: pool_unit<8>(PROJ, PoolWT, a.pool_scale, Y, wl, b, c, 2, th, ln); break;
                default: pool_unit<16>(PROJ, PoolWT, a.pool_scale, Y, wl, b, c, 3, th, ln); break;
            }
            asm volatile("" : "+v"(ln));
            attn_unit(PROJ, KF, VF, Y, tab + wave * 256, wl, b, c, wave, ln);
        }
    }
    xcd_barrier(xbar);

    {
        pg8::Gemm g{Y, WoutT, M, DM, DM}; pg8::StaticOrder S; S.init(M, DM, G, bx);
        pg8::EpiOut E{a.x, a.out, (unsigned*)part, (unsigned*)(ws + 65536), a.fgain};
        pg8::gemm_phase<pg8::EpiOut, pg8::StaticOrder, PG8_ALIGN, PG8_SP2>((PG8_LAS unsigned char*)lds, g, S, E);
    }
}

extern "C" void kernel_launch(void* const* d_in, const int* in_sizes, int n_in, void* d_out, int out_size, void* d_ws, size_t ws_size, hipStream_t stream) {
    static int grid = 0;
    if (grid == 0) {
        if (n_in != 8 || in_sizes[0] != M * DM || out_size != M * DM || ws_size < WS_END) { fprintf(stderr, "kernel_launch: unexpected shapes (n_in %d, in0 %d, out %d, ws %zu); nothing launched\n", n_in, n_in > 0 ? in_sizes[0] : -1, out_size, ws_size); grid = -1; return; }
        int dev = 0, cus = 0, per_cu = 0;
        if (hipGetDevice(&dev) != hipSuccess || hipDeviceGetAttribute(&cus, hipDeviceAttributeMultiprocessorCount, dev) != hipSuccess) { fprintf(stderr, "kernel_launch: device query failed\n"); grid = -1; return; }
        if (hipFuncSetAttribute((const void*)fwd_mega, hipFuncAttributeMaxDynamicSharedMemorySize, LDS_BYTES) != hipSuccess) { fprintf(stderr, "kernel_launch: hipFuncSetAttribute failed\n"); grid = -1; return; }
        if (hipOccupancyMaxActiveBlocksPerMultiprocessor(&per_cu, (const void*)fwd_mega, NWAVES * 64, LDS_BYTES) != hipSuccess || per_cu < 1) { fprintf(stderr, "kernel_launch: occupancy query gave %d blocks per CU\n", per_cu); (void)hipGetLastError(); grid = -1; return; }
        grid = cus * per_cu;
    }
    if (grid < 0) return;
    if (hipMemsetAsync(d_ws, 0, 65536 + 65536, stream) != hipSuccess) { fprintf(stderr, "kernel_launch: hipMemsetAsync failed\n"); return; }
    Args a{};
    a.x = (const float*)d_in[0]; a.norm_gain = (const float*)d_in[1]; a.w_in = (const float*)d_in[2]; a.pool_w = (const float*)d_in[3]; a.pool_scale = (const float*)d_in[4];
    a.rel_bias = (const float*)d_in[5]; a.w_out = (const float*)d_in[6]; a.fgain = (const float*)d_in[7]; a.out = (float*)d_out; a.ws = (unsigned char*)d_ws;
    void* args[] = {&a};
    hipError_t e = hipLaunchCooperativeKernel((const void*)fwd_mega, dim3(grid), dim3(NWAVES * 64), args, LDS_BYTES, stream);
    if (e != hipSuccess) fprintf(stderr, "kernel_launch: cooperative launch failed: %s (grid %d)\n", hipGetErrorString(e), grid);
}
```

```cpp
#include <hip/hip_runtime.h>
#include <hip/hip_cooperative_groups.h>
#include <cstdio>
#include <cstdint>
namespace pg8 {
#define PG8_LAS __attribute__((address_space(3)))
typedef unsigned short bf16_t;
typedef short bf16x8 __attribute__((ext_vector_type(8)));
typedef float f32x4 __attribute__((ext_vector_type(4)));
typedef unsigned u32x4 __attribute__((ext_vector_type(4)));
constexpr int BM = 256, BK = 64, HALF = 128, HTB = HALF * BK * 2  , STAGE_BYTES = 8 * HTB, NXCD = 8, WGM = 8;

__host__ __device__ __forceinline__ int lds_byte(int r, int c) { const int st = (r >> 4) * 2 + (c >> 5), rr = r & 15, cc = c & 31, ob = rr * 64 + cc * 2; return st * 1024 + (ob ^ (((ob >> 9) & 1) << 5)); }
__host__ __device__ __forceinline__ void stage_rc(int b, int& R, int& C) { const int st = b / 1024, sb = b % 1024, swz = sb ^ (((sb >> 9) & 1) << 5); R = (st >> 1) * 16 + swz / 64; C = (st & 1) * 32 + (swz % 64) / 2; }
__host__ __device__ __forceinline__ int perm32(int rho) { const int n = rho >> 4, i = rho & 15; return 8 * (i >> 2) + 4 * n + (i & 3); }

struct Unit { int pm, pn; };
struct Gemm { const bf16_t* A; const bf16_t* Bt; int M, N, K; };

struct StaticOrder {
    int nM, nN, nwg, G, c;
    __host__ __device__ void init(int M, int N, int G_, int c_) { nM = M / BM; nN = N / BM; nwg = nM * nN; G = G_; c = c_; }
    __host__ __device__ bool next(int i, Unit& u) const {
        const long L = (long)i * G + c; if (L >= nwg) return false;
        int wgid = (int)L; { const int q = nwg / NXCD, r = nwg % NXCD, xcd = wgid % NXCD, off = wgid / NXCD; wgid = (xcd < r ? xcd * (q + 1) : r * (q + 1) + (xcd - r) * q) + off; }
        const int nig = WGM * nN, gid = wgid / nig, fm = gid * WGM, gsz = (nM - fm) < WGM ? (nM - fm) : WGM;
        u.pm = fm + ((wgid % nig) % gsz); u.pn = (wgid % nig) / gsz; return true;
    }
    __device__ __forceinline__ void a_ready(const Unit&) const {}
    __device__ __forceinline__ void done(const Unit&) const {}
};

__device__ __forceinline__ unsigned cvt_pk_bf16(float lo, float hi) { unsigned r; asm volatile("v_cvt_pk_bf16_f32 %0, %1, %2" : "=v"(r) : "v"(lo), "v"(hi)); return r; }
__device__ __forceinline__ unsigned short bf16_1(float v) { return (unsigned short)(cvt_pk_bf16(v, v) & 0xffffu); }
struct EpiProj {
    static constexpr bool PERM = true, AFTER_DRAIN = false;
    bf16_t* P; bf16_t* KF; bf16_t* VF;
    __device__ __forceinline__ void operator()(const f32x4 (&acc)[2][2][4][2], const Unit& u, int wr, int wc, int fr, int fq) const {
        const int row0 = u.pm * BM + wr * 64 + fr, col0 = u.pn * BM + wc * 32 + 8 * fq;
        if (u.pn == 6 || u.pn == 7) {
            const int b = row0 >> 13, s0 = row0 & 8191;
#pragma unroll
            for (int ai = 0; ai < 2; ++ai)
#pragma unroll
                for (int m = 0; m < 4; ++m) { const int s = s0 + ai * HALF + m * 16;
#pragma unroll
                    for (int bj = 0; bj < 2; ++bj) { const int ck = col0 - 1536 + bj * HALF, h = ck >> 6, d0 = ck & 63;
                        const size_t idx = ((((((size_t)(b * 8 + h) * 256 + (s >> 5)) * 4 + (d0 >> 4)) * 2 + ((d0 >> 3) & 1)) * 32 + (s & 31))) * 8;
                        const f32x4 v0 = acc[ai][bj][m][0], v1 = acc[ai][bj][m][1];
                        u32x4 w; w.x = cvt_pk_bf16(v0[0], v0[1]); w.y = cvt_pk_bf16(v0[2], v0[3]); w.z = cvt_pk_bf16(v1[0], v1[1]); w.w = cvt_pk_bf16(v1[2], v1[3]);
                        *(u32x4*)(KF + idx) = w; } }
        } else if (u.pn == 8 || u.pn == 9) {
            const int b = row0 >> 13, s0 = row0 & 8191;
#pragma unroll
            for (int ai = 0; ai < 2; ++ai)
#pragma unroll
                for (int m = 0; m < 4; ++m) { const int s = s0 + ai * HALF + m * 16;
                    const int sj = ((s >> 3) & 1) * 4 + (s & 3), shi = (s >> 2) & 1, ss2 = (s >> 4) & 1, sblk = s >> 5;
#pragma unroll
                    for (int bj = 0; bj < 2; ++bj) { const int cv = col0 - 2048 + bj * HALF, h = cv >> 6, d0 = cv & 63;
                        bf16_t* base = VF + (((((((size_t)(b * 8 + h) * 256 + sblk) * 2 + ss2) * 2 + (d0 >> 5)) * 2 + shi) * 32 + (d0 & 31))) * 8 + sj;
#pragma unroll
                        for (int n = 0; n < 2; ++n)
#pragma unroll
                            for (int e = 0; e < 4; ++e) base[(4 * n + e) * 8] = bf16_1(acc[ai][bj][m][n][e]); } }
        } else {
#pragma unroll
            for (int ai = 0; ai < 2; ++ai)
#pragma unroll
                for (int m = 0; m < 4; ++m) { bf16_t* rowp = P + (size_t)(row0 + ai * HALF + m * 16) * 3072 + col0;
#pragma unroll
                    for (int bj = 0; bj < 2; ++bj) { const f32x4 v0 = acc[ai][bj][m][0], v1 = acc[ai][bj][m][1];
                        u32x4 w; w.x = cvt_pk_bf16(v0[0], v0[1]); w.y = cvt_pk_bf16(v0[2], v0[3]); w.z = cvt_pk_bf16(v1[0], v1[1]); w.w = cvt_pk_bf16(v1[2], v1[3]);
                        *(u32x4*)(rowp + bj * HALF) = w; } }
        }
    }
};
struct EpiOut {
    static constexpr bool PERM = false, AFTER_DRAIN = false;
    const float* X; float* O; unsigned* part; unsigned* cnt; const float* gain;
    __device__ __forceinline__ void operator()(f32x4 (&acc)[2][2][4][2], const Unit& u, int wr, int wc, int fr, int fq) const {
        const int row0 = u.pm * BM + wr * 64 + fr, col0 = u.pn * BM + wc * 32 + 4 * fq;
#pragma unroll
        for (int ai = 0; ai < 2; ++ai)
#pragma unroll
            for (int m = 0; m < 4; ++m) { const int row = row0 + ai * HALF + m * 16; const size_t off = (size_t)row * 1024 + col0; float ss = 0.f;
#pragma unroll
                for (int bj = 0; bj < 2; ++bj)
#pragma unroll
                    for (int n = 0; n < 2; ++n) { const f32x4 xv = *(const f32x4*)(X + off + bj * HALF + n * 16); const f32x4 o = xv + acc[ai][bj][m][n];
                        acc[ai][bj][m][n] = o; ss += (o[0] * o[0] + o[1] * o[1]) + (o[2] * o[2] + o[3] * o[3]); }
                ss += __shfl_xor(ss, 16); ss += __shfl_xor(ss, 32);
                if (fq == 0) __hip_atomic_store(part + (size_t)row * 16 + u.pn * 4 + wc, __builtin_bit_cast(unsigned, ss), __ATOMIC_RELAXED, __HIP_MEMORY_SCOPE_AGENT); }
        asm volatile("s_waitcnt vmcnt(0)" ::: "memory");
        unsigned* cw = cnt + 64 * u.pm;
        if ((threadIdx.x & 63) == 0) __hip_atomic_fetch_add(cw, 1u, __ATOMIC_RELAXED, __HIP_MEMORY_SCOPE_AGENT);
        { unsigned sp = 0;
          while ((unsigned)__builtin_amdgcn_readfirstlane(__hip_atomic_load(cw, __ATOMIC_RELAXED, __HIP_MEMORY_SCOPE_AGENT)) < 32u) { __builtin_amdgcn_s_sleep(1); if (++sp > (1u << 22)) break; } }
        asm volatile("" ::: "memory");
        f32x4 gv[2][2];
#pragma unroll
        for (int bj = 0; bj < 2; ++bj)
#pragma unroll
            for (int n = 0; n < 2; ++n) gv[bj][n] = *(const f32x4*)(gain + col0 + bj * HALF + n * 16);
        unsigned long long w0[8], w1[8];
#pragma unroll
        for (int t = 0; t < 8; ++t) { const int row = row0 + (t >> 2) * HALF + (t & 3) * 16;
            const unsigned long long* pp = (const unsigned long long*)(part + (size_t)row * 16 + 4 * fq);
            w0[t] = __hip_atomic_load(pp, __ATOMIC_RELAXED, __HIP_MEMORY_SCOPE_AGENT); w1[t] = __hip_atomic_load(pp + 1, __ATOMIC_RELAXED, __HIP_MEMORY_SCOPE_AGENT); }
        asm volatile("" ::: "memory");
#pragma unroll
        for (int ai = 0; ai < 2; ++ai)
#pragma unroll
            for (int m = 0; m < 4; ++m) { const int t = ai * 4 + m; const int row = row0 + ai * HALF + m * 16; const size_t off = (size_t)row * 1024 + col0;
                float tot = (__builtin_bit_cast(float, (unsigned)w0[t]) + __builtin_bit_cast(float, (unsigned)(w0[t] >> 32))) + (__builtin_bit_cast(float, (unsigned)w1[t]) + __builtin_bit_cast(float, (unsigned)(w1[t] >> 32)));
                tot += __shfl_xor(tot, 16); tot += __shfl_xor(tot, 32);
                const float rstd = 1.0f / sqrtf(tot * (1.f / 1024.f) + 1e-6f);
#pragma unroll
                for (int bj = 0; bj < 2; ++bj)
#pragma unroll
                    for (int n = 0; n < 2; ++n) __builtin_nontemporal_store(acc[ai][bj][m][n] * rstd * gv[bj][n], (f32x4*)(O + off + bj * HALF + n * 16)); }
    }
};
template <class Epi, class Sched, bool ALIGN_EPI = false, bool SP2 = false>
__device__ __forceinline__ void gemm_phase(PG8_LAS unsigned char* lds, const Gemm g, const Sched& S, const Epi& E) {
    int tid_ = threadIdx.x; asm volatile("" : "+v"(tid_));
    const int tid = tid_, wid = __builtin_amdgcn_readfirstlane(tid >> 6), lane = tid & 63, wr = wid >> 2, wc = wid & 3, fr = lane & 15, fq = lane >> 4;
    const int K = g.K, nt = K / BK;
    unsigned voffA[2], voffB[2];
#pragma unroll
    for (int i = 0; i < 2; ++i) { int R, C; stage_rc(tid * 16 + i * 8192, R, C); const int Rb = Epi::PERM ? ((R & ~31) + perm32(R & 31)) : R;
        voffA[i] = (unsigned)(R * K + C) * 2u; voffB[i] = (unsigned)(Rb * K + C) * 2u; }
    const size_t kstep = (size_t)(BK * 2);
    const size_t hstep = (size_t)HALF * K * 2;
    const size_t tstep = 2 * hstep;
    const unsigned ldsw = (unsigned)wid * 1024u;
    const int aoff = lds_byte(wr * 64 + fr, fq * 8), boff = lds_byte(wc * 32 + fr, fq * 8);
#define PG8_SA(b, h) (((b) * 2 + (h)) * HTB)
#define PG8_SB(b, h) ((4 + (b) * 2 + (h)) * HTB)
#define PG8_STAGE(bufoff, gbase, voff) do { _Pragma("unroll") for (int _i = 0; _i < 2; ++_i) \
        __builtin_amdgcn_global_load_lds((const unsigned*)((const char*)(gbase) + (voff)[_i]), (PG8_LAS unsigned*)(lds + (bufoff) + ldsw + _i * 8192), 16, 0, 0); } while (0)
#define PG8_LDA(dst, b, h) do { _Pragma("unroll") for (int m = 0; m < 4; ++m) _Pragma("unroll") for (int k = 0; k < 2; ++k) dst[m][k] = *(const PG8_LAS bf16x8*)(lds + PG8_SA(b, h) + aoff + m * 2048 + k * 1024); } while (0)
#define PG8_LDB(dst, b, h) do { _Pragma("unroll") for (int n = 0; n < 2; ++n) _Pragma("unroll") for (int k = 0; k < 2; ++k) dst[n][k] = *(const PG8_LAS bf16x8*)(lds + PG8_SB(b, h) + boff + n * 2048 + k * 1024); } while (0)
#define PG8_MMA(ai, bj, At, Bt) do { __builtin_amdgcn_s_setprio(1); _Pragma("unroll") for (int m = 0; m < 4; ++m) _Pragma("unroll") for (int n = 0; n < 2; ++n) _Pragma("unroll") for (int k = 0; k < 2; ++k) \
        acc[ai][bj][m][n] = __builtin_amdgcn_mfma_f32_16x16x32_bf16(Bt[n][k], At[m][k], acc[ai][bj][m][n], 0, 0, 0); __builtin_amdgcn_s_setprio(0); } while (0)
#define PG8_WAIT_V(n) asm volatile("s_waitcnt vmcnt(" #n ")" ::: "memory")
#define PG8_WAIT_L(n) asm volatile("s_waitcnt lgkmcnt(" #n ")" ::: "memory")
#define PG8_BAR __builtin_amdgcn_s_barrier()
#define PG8_SCHED __builtin_amdgcn_sched_barrier(0)
    Unit cur, nxt; int ui = 0;
    if (!S.next(0, cur)) return;
    f32x4 acc[2][2][4][2];
#pragma unroll
    for (int a = 0; a < 2; ++a)
#pragma unroll
        for (int b = 0; b < 2; ++b)
#pragma unroll
            for (int m = 0; m < 4; ++m)
#pragma unroll
                for (int n = 0; n < 2; ++n) acc[a][b][m][n] = (f32x4){0.f, 0.f, 0.f, 0.f};
    bf16x8 At[4][2], B0[2][2], B1[2][2];
    const char* cA = (const char*)g.A + (size_t)cur.pm * tstep; const char* cB = (const char*)g.Bt + (size_t)cur.pn * tstep;
    S.a_ready(cur);
    if constexpr (SP2) {
        PG8_STAGE(PG8_SB(0, 0), cB, voffB); PG8_STAGE(PG8_SB(0, 1), cB + hstep, voffB); PG8_STAGE(PG8_SA(0, 0), cA, voffA); PG8_STAGE(PG8_SA(0, 1), cA + hstep, voffA);
        if (wr == 1) PG8_BAR;
        PG8_WAIT_V(2); PG8_BAR;
        PG8_STAGE(PG8_SB(1, 0), cB + kstep, voffB); PG8_STAGE(PG8_SA(1, 0), cA + kstep, voffA); PG8_STAGE(PG8_SB(1, 1), cB + hstep + kstep, voffB);
        PG8_WAIT_V(6); PG8_BAR;
    } else {
        PG8_STAGE(PG8_SB(0, 0), cB, voffB); PG8_STAGE(PG8_SA(0, 0), cA, voffA); PG8_STAGE(PG8_SB(0, 1), cB + hstep, voffB); PG8_STAGE(PG8_SA(0, 1), cA + hstep, voffA);
        if (wr == 1) PG8_BAR;
        PG8_WAIT_V(4); PG8_BAR;
        PG8_STAGE(PG8_SB(1, 0), cB + kstep, voffB); PG8_STAGE(PG8_SA(1, 0), cA + kstep, voffA); PG8_STAGE(PG8_SB(1, 1), cB + hstep + kstep, voffB);
        PG8_WAIT_V(6); PG8_BAR;
    }
    for (;;) {
        const bool has_next = S.next(ui + 1, nxt);
        const char* nA = has_next ? (const char*)g.A + (size_t)nxt.pm * tstep : cA; const char* nB = has_next ? (const char*)g.Bt + (size_t)nxt.pn * tstep : cB;
        for (int t = 0; t < nt; t += 2) {
            const bool last = (t == nt - 2);
            const char* a1 = cA + (size_t)(t + 1) * kstep;
            const char* a2 = last ? nA : cA + (size_t)(t + 2) * kstep; const char* b2 = last ? nB : cB + (size_t)(t + 2) * kstep;
            const char* a3 = a2 + kstep; const char* b3 = b2 + kstep;
            if (last && has_next) S.a_ready(nxt);
            if constexpr (SP2) {
            PG8_LDB(B0, 0, 0); PG8_LDB(B1, 0, 1); PG8_SCHED; PG8_LDA(At, 0, 0); PG8_STAGE(PG8_SA(1, 1), a1 + hstep, voffA);
            PG8_WAIT_V(8); PG8_WAIT_L(0); PG8_BAR; PG8_MMA(0, 0, At, B0); PG8_MMA(0, 1, At, B1); PG8_BAR; PG8_SCHED;
            PG8_LDA(At, 0, 1); PG8_STAGE(PG8_SB(0, 0), b2, voffB); PG8_STAGE(PG8_SB(0, 1), b2 + hstep, voffB); PG8_STAGE(PG8_SA(0, 0), a2, voffA);
            PG8_WAIT_V(8); PG8_WAIT_L(0); PG8_BAR; PG8_MMA(1, 0, At, B0); PG8_MMA(1, 1, At, B1); PG8_BAR; PG8_SCHED;
            PG8_LDB(B0, 1, 0); PG8_LDB(B1, 1, 1); PG8_SCHED; PG8_LDA(At, 1, 0); PG8_STAGE(PG8_SA(0, 1), a2 + hstep, voffA);
            PG8_WAIT_V(8); PG8_WAIT_L(0); PG8_BAR; PG8_MMA(0, 0, At, B0); PG8_MMA(0, 1, At, B1); PG8_BAR; PG8_SCHED;
            PG8_LDA(At, 1, 1); PG8_STAGE(PG8_SB(1, 0), b3, voffB); PG8_STAGE(PG8_SB(1, 1), b3 + hstep, voffB); PG8_STAGE(PG8_SA(1, 0), a3, voffA);
            PG8_WAIT_V(8); PG8_WAIT_L(0); PG8_BAR; PG8_MMA(1, 0, At, B0); PG8_MMA(1, 1, At, B1); PG8_BAR; PG8_SCHED;
            } else {
            PG8_LDB(B0, 0, 0); PG8_SCHED; PG8_LDA(At, 0, 0); PG8_STAGE(PG8_SA(1, 1), a1 + hstep, voffA);
            PG8_WAIT_L(8); PG8_BAR; PG8_WAIT_L(0); PG8_MMA(0, 0, At, B0); PG8_BAR; PG8_SCHED;
            PG8_LDB(B1, 0, 1); PG8_STAGE(PG8_SB(0, 0), b2, voffB);
            PG8_BAR; PG8_WAIT_L(0); PG8_MMA(0, 1, At, B1); PG8_BAR;
            PG8_LDA(At, 0, 1); PG8_STAGE(PG8_SA(0, 0), a2, voffA);
            PG8_BAR; PG8_WAIT_L(0); PG8_MMA(1, 0, At, B0); PG8_BAR; PG8_SCHED;
            PG8_STAGE(PG8_SB(0, 1), b2 + hstep, voffB);
            PG8_WAIT_V(6); PG8_BAR; PG8_MMA(1, 1, At, B1); PG8_BAR;
            PG8_LDB(B0, 1, 0); PG8_SCHED; PG8_LDA(At, 1, 0); PG8_STAGE(PG8_SA(0, 1), a2 + hstep, voffA);
            PG8_WAIT_L(8); PG8_BAR; PG8_WAIT_L(0); PG8_MMA(0, 0, At, B0); PG8_BAR; PG8_SCHED;
            PG8_LDB(B1, 1, 1); PG8_STAGE(PG8_SB(1, 0), b3, voffB);
            PG8_BAR; PG8_WAIT_L(0); PG8_MMA(0, 1, At, B1); PG8_BAR;
            PG8_LDA(At, 1, 1); PG8_STAGE(PG8_SA(1, 0), a3, voffA);
            PG8_BAR; PG8_WAIT_L(0); PG8_MMA(1, 0, At, B0); PG8_BAR; PG8_SCHED;
            PG8_STAGE(PG8_SB(1, 1), b3 + hstep, voffB);
            PG8_WAIT_V(6); PG8_BAR; PG8_MMA(1, 1, At, B1); PG8_BAR;
            }
        }
        if constexpr (ALIGN_EPI) { if (wr == 0) PG8_BAR; }
        if constexpr (!Epi::AFTER_DRAIN) { E(acc, cur, wr, wc, fr, fq); S.done(cur); }
        if (!has_next) break;
#pragma unroll
        for (int a = 0; a < 2; ++a)
#pragma unroll
            for (int b = 0; b < 2; ++b)
#pragma unroll
                for (int m = 0; m < 4; ++m)
#pragma unroll
                    for (int n = 0; n < 2; ++n) acc[a][b][m][n] = (f32x4){0.f, 0.f, 0.f, 0.f};
        cur = nxt; cA = nA; cB = nB; ++ui;
        if constexpr (ALIGN_EPI) { if (wr == 1) PG8_BAR; }
    }
    PG8_WAIT_V(0);
    if constexpr (!ALIGN_EPI) { if (wr == 0) PG8_BAR; }
    PG8_BAR;
    if constexpr (Epi::AFTER_DRAIN) { E.fused(acc, cur, wr, wc, fr, fq, lds, wid, lane); S.done(cur); }
#undef PG8_SA
#undef PG8_SB
#undef PG8_STAGE
#undef PG8_LDA
#undef PG8_LDB
#undef PG8_MMA
#undef PG8_WAIT_V
#undef PG8_WAIT_L
#undef PG8_BAR
#undef PG8_SCHED
}
}
#ifndef PG8_SP2
#define PG8_SP2 true
#endif
#ifndef PG8_ALIGN
#define PG8_ALIGN true
#endif
namespace cg = cooperative_groups;
#define LAS __attribute__((address_space(3)))
typedef unsigned short bf16;
typedef float f32x4 __attribute__((ext_vector_type(4)));
typedef float f32x16 __attribute__((ext_vector_type(16)));
typedef short bf16x8 __attribute__((ext_vector_type(8)));
typedef unsigned u32x4 __attribute__((ext_vector_type(4)));
typedef unsigned u32x2 __attribute__((ext_vector_type(2)));

constexpr int NWAVES = 8;
constexpr int BATCH = 8, SEQ = 8192, DM = 1024, M = BATCH * SEQ, NPROJ = 3072, CHUNK = 64, NCHUNK = SEQ / CHUNK;
constexpr float EPS = 1e-6f, LOG2E = 1.4426950408889634f, SCL = 0.125f * 1.4426950408889634f;
constexpr size_t MiB = 1u << 20;
constexpr size_t WS_WINT = 1 * MiB, WS_WOUTT = 8 * MiB, WS_POOLWT = 10 * MiB, WS_PART = 12 * MiB, WS_XN = 16 * MiB, WS_PROJ = 144 * MiB, WS_VT = 528 * MiB, WS_Y = 592 * MiB, WS_KF = 720 * MiB, WS_END = 784 * MiB;
constexpr int LDS_BYTES = 147456;

__device__ __forceinline__ unsigned f2bf(float f) { unsigned u = __builtin_bit_cast(unsigned, f); return (u + 0x7fffu + ((u >> 16) & 1u)) >> 16; }
__device__ __forceinline__ unsigned pk2(float lo, float hi) { return f2bf(lo) | (f2bf(hi) << 16); }
typedef float f32x2_t __attribute__((ext_vector_type(2))); typedef __bf16 bf16x2_t __attribute__((ext_vector_type(2)));
__device__ __forceinline__ unsigned pkbf(float lo, float hi) { f32x2_t v = {lo, hi}; bf16x2_t b = __builtin_convertvector(v, bf16x2_t); return __builtin_bit_cast(unsigned, b); }
__device__ __forceinline__ float bf_lo(unsigned w) { return __builtin_bit_cast(float, w << 16); }
__device__ __forceinline__ float bf_hi(unsigned w) { return __builtin_bit_cast(float, w & 0xffff0000u); }
__device__ __forceinline__ float silu_f(float x) { return x * __builtin_amdgcn_rcpf(1.f + __builtin_amdgcn_exp2f(-x * LOG2E)); }
__device__ __forceinline__ float wave_sum(float v) {
#pragma unroll
    for (int o = 1; o < 64; o <<= 1) v += __shfl_xor(v, o);
    return v;
}

template <bool POOLF> __device__ __forceinline__ void p0_transpose_item(const float* W, int K, int N, bf16* WT, LAS float* scr, int item, int lane) {
    const int nblk = N / 32, kb = item / nblk, nb = item % nblk, k0 = 64 * kb, n0 = 32 * nb;
#pragma unroll 8
    for (int i = 0; i < 32; ++i) { const int kk = 2 * i + (lane >> 5); scr[kk * 33 + (lane & 31)] = W[(size_t)(k0 + kk) * N + n0 + (lane & 31)]; }
    asm volatile("s_waitcnt lgkmcnt(0)" ::: "memory");
    const int c = lane & 7;
#pragma unroll
    for (int j = 0; j < 4; ++j) { const int n = (lane >> 3) + 8 * j; const LAS float* s = scr + (8 * c) * 33 + n;
        u32x4 o; o.x = pk2(s[0 * 33], s[1 * 33]); o.y = pk2(s[2 * 33], s[3 * 33]); o.z = pk2(s[4 * 33], s[5 * 33]); o.w = pk2(s[6 * 33], s[7 * 33]);
        if (POOLF) { const int k = k0 + 8 * c, nn = n0 + n; *(u32x4*)(WT + (size_t)(((((k >> 4) * 4 + (nn >> 5)) * 2 + ((k >> 3) & 1)) * 32 + (nn & 31)) * 8)) = o; }
        else *(u32x4*)(WT + (size_t)(n0 + n) * K + k0 + 8 * c) = o; }
    asm volatile("s_waitcnt lgkmcnt(0)" ::: "memory");
}

typedef unsigned v4u __attribute__((ext_vector_type(4)));
#define XB_TMO      128
#define XB_XCNT(j)  (256  + 64 * (j))
#define XB_XSUB(j)  (1280 + 64 * (j))
#define XB_XGEN(j)  (2304 + 64 * (j))
#define XB_TOP      3328
#define XB_TOPGEN   3392
#define XCD_BAR_WORDS 3456
#define XB_SPIN_CAP (1u << 18)

__device__ __forceinline__ unsigned xb_ld(unsigned* p)              { return __hip_atomic_load(p, __ATOMIC_RELAXED, __HIP_MEMORY_SCOPE_AGENT); }
__device__ __forceinline__ unsigned xb_add(unsigned* p, unsigned v) { return __hip_atomic_fetch_add(p, v, __ATOMIC_RELAXED, __HIP_MEMORY_SCOPE_AGENT); }
__device__ __forceinline__ unsigned xb_xcc_id() { return (unsigned)__builtin_amdgcn_s_getreg((3 << 11) | 20) & 0xFu; }
#define XB_SPIN(cond, bar) do { unsigned _sp = 0; while (cond) { __builtin_amdgcn_s_sleep(1); \
    if ((++_sp & 255u) == 0u) { if (xb_ld(&(bar)[XB_TMO])) break; if (_sp > XB_SPIN_CAP) { atomicAdd(&(bar)[XB_TMO], 1u); break; } } } } while (0)

struct XcdBarrier {
    unsigned* bar; unsigned x;
    volatile LAS unsigned* st;
};

__device__ __forceinline__ XcdBarrier xcd_barrier_post(unsigned* bar, volatile LAS unsigned* st) {
    XcdBarrier b; b.bar = bar; b.x = xb_xcc_id(); b.st = st;
    if (threadIdx.x == 0) (void)xb_add(&bar[XB_XCNT(b.x)], 1u);
    return b;
}
__device__ __forceinline__ void xcd_barrier_complete(unsigned* bar, unsigned x, unsigned& nloc, unsigned& nx) {
    const unsigned G = gridDim.x * gridDim.y * gridDim.z;
    unsigned sum, cnt, mine, sp = 0u;
    for (;;) {
        sum = 0u; cnt = 0u; mine = 0u;
#pragma unroll
        for (unsigned j = 0; j < 16; ++j) { const unsigned c = xb_ld(&bar[XB_XCNT(j)]); sum += c; cnt += (c > 0u) ? 1u : 0u; mine = (j == x) ? c : mine; }
        if (sum == G) break;
        __builtin_amdgcn_s_sleep(1);
        if ((++sp & 255u) == 0u) { if (xb_ld(&bar[XB_TMO])) break; if (sp > XB_SPIN_CAP) { atomicAdd(&bar[XB_TMO], 1u); break; } }
    }
    nloc = mine > 0u ? mine : 1u; nx = cnt > 0u ? cnt : 1u;
}

__device__ __forceinline__ void xcd_barrier(const XcdBarrier& b) {
    asm volatile("s_waitcnt vmcnt(0)" ::: "memory");
    __syncthreads();
    if (threadIdx.x == 0) {
        unsigned* bar = b.bar;
        __builtin_amdgcn_s_waitcnt(0);
        unsigned nloc = b.st[0], nx = b.st[1];
        if (nloc == 0u) { xcd_barrier_complete(bar, b.x, nloc, nx); b.st[0] = nloc; b.st[1] = nx; }
        const unsigned old = xb_add(&bar[XB_XSUB(b.x)], 1u);
        const unsigned gen = old / nloc;
        if (old + 1u == (gen + 1u) * nloc) {
            __builtin_amdgcn_fence(__ATOMIC_RELEASE, "agent");
            asm volatile("s_waitcnt vmcnt(0)" ::: "memory");
            const unsigned og = xb_add(&bar[XB_TOP], 1u);
            const unsigned tg = og / nx;
            if (og + 1u == (tg + 1u) * nx) xb_add(&bar[XB_TOPGEN], 1u);
            else XB_SPIN(xb_ld(&bar[XB_TOPGEN]) == tg, bar);
            __builtin_amdgcn_fence(__ATOMIC_ACQUIRE, "agent");
            xb_add(&bar[XB_XGEN(b.x)], 1u);
            asm volatile("s_waitcnt vmcnt(0)" ::: "memory");
        } else {
            XB_SPIN(xb_ld(&bar[XB_XGEN(b.x)]) == gen, bar);
            __builtin_amdgcn_fence(__ATOMIC_ACQUIRE, "agent");
            asm volatile("s_waitcnt vmcnt(0)" ::: "memory");
        }
    }
    __syncthreads();
}

struct Args { const float* x; const float* norm_gain; const float* w_in; const float* pool_w; const float* pool_scale; const float* rel_bias; const float* w_out; const float* fgain; float* out; unsigned char* ws; };

constexpr int PROW = 272;
constexpr int WREG = 12800;
template <bool SCALE> __device__ __forceinline__ void epi_tile(LAS unsigned char* wl, const f32x16& v0, const f32x16& v1, float mul, const bf16* gbase, bf16* ybase, const float* scale, int lane) {
    LAS unsigned char* wp = wl + (lane & 31) * PROW + (lane >> 5) * 16;
#pragma unroll
    for (int i4 = 0; i4 < 4; ++i4) {
        *(LAS f32x4*)(wp + i4 * 32) = (f32x4){v0[4 * i4] * mul, v0[4 * i4 + 1] * mul, v0[4 * i4 + 2] * mul, v0[4 * i4 + 3] * mul};
        *(LAS f32x4*)(wp + 128 + i4 * 32) = (f32x4){v1[4 * i4] * mul, v1[4 * i4 + 1] * mul, v1[4 * i4 + 2] * mul, v1[4 * i4 + 3] * mul};
    }
    const int rr = lane >> 4, piece = lane & 15;
    f32x4 s = (f32x4){1.f, 1.f, 1.f, 1.f};
    if (SCALE) s = *(const f32x4*)(scale + 4 * piece);
#pragma unroll
    for (int it = 0; it < 8; ++it) { const int row = 4 * it + rr;
        const f32x4 x = *(const LAS f32x4*)(wl + row * PROW + piece * 16);
        const u32x2 gw = *(const u32x2*)(gbase + (size_t)row * NPROJ + 4 * piece);
        const float o0 = x[0] * s[0] * silu_f(bf_lo(gw.x)), o1 = x[1] * s[1] * silu_f(bf_hi(gw.x)), o2 = x[2] * s[2] * silu_f(bf_lo(gw.y)), o3 = x[3] * s[3] * silu_f(bf_hi(gw.y));
        u32x2 ow; ow.x = pkbf(o0, o1); ow.y = pkbf(o2, o3); *(u32x2*)(ybase + (size_t)row * DM + 4 * piece) = ow; }
}
template <int W> __device__ __forceinline__ void pool_unit(const bf16* proj, const bf16* pwf, const float* pool_scale, bf16* Y, LAS unsigned char* wl, int b, int c, int g, int th, int lane) {
    const int r32 = lane & 31, hi = lane >> 5;
    const int sb = c * CHUNK + th * 32, s = sb + r32; const size_t row = (size_t)b * SEQ + s;
#pragma unroll
    for (int i = 0; i < 12; ++i) { const int r0 = 4 * i + (lane >> 4), r = r0 < 46 ? r0 : 46, piece = lane & 15, u = sb - 15 + r, uc = u > 0 ? u : 0;
        u32x4 w = *(const u32x4*)(proj + ((size_t)b * SEQ + uc) * NPROJ + g * 128 + piece * 8);
        if (u < 0) w = (u32x4){0u, 0u, 0u, 0u};
        *(LAS u32x4*)(wl + r * PROW + piece * 16) = w; }
    const char* wt = (const char*)(pwf + (size_t)g * 128 * 128); const unsigned l16 = (unsigned)lane * 16u;
    const int cnt = (s + 1 < W) ? (s + 1) : W; const float inv = 1.f / (float)cnt;
    f32x16 acc[4];
#pragma unroll
    for (int db = 0; db < 4; ++db)
#pragma unroll
        for (int i = 0; i < 16; ++i) acc[db][i] = 0.f;
#pragma unroll 1
    for (int ks = 0; ks < 8; ++ks) {
        bf16x8 wf[4];
#pragma unroll
        for (int db = 0; db < 4; ++db) wf[db] = *(const bf16x8*)(wt + (ks * 4 + db) * 1024 + l16);
        float sum[8], own[8];
#pragma unroll
        for (int e = 0; e < 8; ++e) { sum[e] = 0.f; own[e] = 0.f; }
        const LAS unsigned char* rp = wl + (r32 + 15) * PROW + (2 * ks + hi) * 16;
#pragma unroll
        for (int i = 0; i < W; ++i) {
            const u32x4 w = *(const LAS u32x4*)(rp - i * PROW);
            const float f[8] = {bf_lo(w.x), bf_hi(w.x), bf_lo(w.y), bf_hi(w.y), bf_lo(w.z), bf_hi(w.z), bf_lo(w.w), bf_hi(w.w)};
#pragma unroll
            for (int e = 0; e < 8; ++e) { sum[e] += f[e]; if (i == 0) own[e] = f[e]; }
        }
        u32x4 o; o.x = pkbf(sum[0] * inv - own[0], sum[1] * inv - own[1]); o.y = pkbf(sum[2] * inv - own[2], sum[3] * inv - own[3]);
        o.z = pkbf(sum[4] * inv - own[4], sum[5] * inv - own[5]); o.w = pkbf(sum[6] * inv - own[6], sum[7] * inv - own[7]);
        const bf16x8 df = __builtin_bit_cast(bf16x8, o);
#pragma unroll
        for (int db = 0; db < 4; ++db) acc[db] = __builtin_amdgcn_mfma_f32_32x32x16_bf16(wf[db], df, acc[db], 0, 0, 0);
    }
    const size_t row0 = (size_t)b * SEQ + sb;
    epi_tile<true>(wl, acc[0], acc[1], 1.f, proj + row0 * NPROJ + (512 + g * 128), Y + row0 * DM + g * 128, pool_scale + g * 128, lane);
    epi_tile<true>(wl, acc[2], acc[3], 1.f, proj + row0 * NPROJ + (512 + g * 128 + 64), Y + row0 * DM + (g * 128 + 64), pool_scale + (g * 128 + 64), lane);
}
__device__ __forceinline__ void attn_unit(const bf16* proj, const bf16* KF, const bf16* VF, bf16* Y, const LAS float* tab, LAS unsigned char* wl, int b, int c, int h, int lane) {
    const int r32 = lane & 31, hi = lane >> 5;
    const int jstart = (c < 8) ? (8 - c) : 0;
    const char* kbase = (const char*)(KF + (size_t)(b * 8 + h) * 256 * 2048);
    const char* vbase = (const char*)(VF + (size_t)(b * 8 + h) * 256 * 2048);
    const unsigned l16 = (unsigned)lane * 16u;
    for (int qh = 0; qh < 2; ++qh) {
        const size_t rowq = (size_t)b * SEQ + c * CHUNK + qh * 32 + r32;
        bf16x8 qf[4];
#pragma unroll
        for (int ds = 0; ds < 4; ++ds) qf[ds] = *(const bf16x8*)(proj + rowq * NPROJ + 1024 + h * 64 + 16 * ds + 8 * hi);
        bf16x8 kf[8];
        { const int kblk = (c - 8 + jstart) * 2;
#pragma unroll
            for (int t = 0; t < 8; ++t) kf[t] = *(const bf16x8*)(kbase + (size_t)kblk * 4096 + t * 1024 + l16); }
        float m = -1e30f, l = 0.f; f32x16 o[2];
#pragma unroll
        for (int db = 0; db < 2; ++db)
#pragma unroll
            for (int i = 0; i < 16; ++i) o[db][i] = 0.f;
        const int dq = 4 * hi - (qh * 32 + r32);
        for (int j = jstart; j <= 8; ++j) {
            const int kblk = (c - 8 + j) * 2;
            f32x16 sc[2];
#pragma unroll
            for (int kb = 0; kb < 2; ++kb) {
#pragma unroll
                for (int i = 0; i < 16; ++i) sc[kb][i] = 0.f;
#pragma unroll
                for (int ds = 0; ds < 4; ++ds) sc[kb] = __builtin_amdgcn_mfma_f32_32x32x16_bf16(kf[kb * 4 + ds], qf[ds], sc[kb], 0, 0, 0);
            }
            __builtin_amdgcn_sched_barrier(0);
            bf16x8 vf[8];
#pragma unroll
            for (int t = 0; t < 8; ++t) vf[t] = *(const bf16x8*)(vbase + (size_t)kblk * 4096 + t * 1024 + l16);
            if (j < 8) {
#pragma unroll
                for (int t = 0; t < 8; ++t) kf[t] = *(const bf16x8*)(kbase + (size_t)(kblk + 2) * 4096 + t * 1024 + l16);
            }
            __builtin_amdgcn_sched_barrier(0);
            if (j <= 6) { const float b0 = tab[0];
#pragma unroll
                for (int kb = 0; kb < 2; ++kb)
#pragma unroll
                    for (int i = 0; i < 16; ++i) sc[kb][i] = sc[kb][i] * SCL + b0;
            } else {
                const LAS float* tp = tab + ((j == 8) ? 64 : (129 + 63)) + dq;
#pragma unroll
                for (int kb = 0; kb < 2; ++kb)
#pragma unroll
                    for (int i = 0; i < 16; ++i) sc[kb][i] = sc[kb][i] * SCL + tp[32 * kb + (i & 3) + 8 * (i >> 2)];
            }
            float mt = sc[0][0];
#pragma unroll
            for (int kb = 0; kb < 2; ++kb)
#pragma unroll
                for (int i = 0; i < 16; ++i) mt = fmaxf(mt, sc[kb][i]);
            mt = fmaxf(mt, __shfl_xor(mt, 32));
            const float mn = fmaxf(m, mt); const float alpha = __builtin_amdgcn_exp2f(m - mn); m = mn;
            float ls = 0.f;
#pragma unroll
            for (int kb = 0; kb < 2; ++kb)
#pragma unroll
                for (int i = 0; i < 16; ++i) { const float p = __builtin_amdgcn_exp2f(sc[kb][i] - mn); sc[kb][i] = p; ls += p; }
            l = l * alpha + ls;
#pragma unroll
            for (int db = 0; db < 2; ++db)
#pragma unroll
                for (int i = 0; i < 16; ++i) o[db][i] *= alpha;
#pragma unroll
            for (int kb = 0; kb < 2; ++kb)
#pragma unroll
                for (int s2 = 0; s2 < 2; ++s2) {
                    u32x4 pw; pw.x = pkbf(sc[kb][8 * s2 + 0], sc[kb][8 * s2 + 1]); pw.y = pkbf(sc[kb][8 * s2 + 2], sc[kb][8 * s2 + 3]);
                    pw.z = pkbf(sc[kb][8 * s2 + 4], sc[kb][8 * s2 + 5]); pw.w = pkbf(sc[kb][8 * s2 + 6], sc[kb][8 * s2 + 7]);
                    const bf16x8 pf = __builtin_bit_cast(bf16x8, pw);
#pragma unroll
                    for (int db = 0; db < 2; ++db) o[db] = __builtin_amdgcn_mfma_f32_32x32x16_bf16(vf[(kb * 2 + s2) * 2 + db], pf, o[db], 0, 0, 0);
                }
        }
        l += __shfl_xor(l, 32); const float inv = 1.f / l;
        const size_t row0 = (size_t)b * SEQ + c * CHUNK + qh * 32;
        epi_tile<false>(wl, o[0], o[1], inv, proj + row0 * NPROJ + (2560 + h * 64), Y + row0 * DM + (512 + h * 64), nullptr, lane);
    }
}

__global__ void __launch_bounds__(NWAVES * 64, 2) fwd_mega(Args a) {
    extern __shared__ __attribute__((aligned(16))) unsigned char lds[];
    cg::grid_group grid = cg::this_grid();
    const int tid = threadIdx.x, lane = tid & 63, wave = __builtin_amdgcn_readfirstlane(tid >> 6);
    const int G = gridDim.x, bx = blockIdx.x; const int vcu = (G % 8 == 0) ? (bx % 8) * (G / 8) + bx / 8 : bx;
    unsigned char* ws = a.ws;
    bf16* WinT = (bf16*)(ws + WS_WINT); bf16* WoutT = (bf16*)(ws + WS_WOUTT); bf16* PoolWT = (bf16*)(ws + WS_POOLWT);
    float* part = (float*)(ws + WS_PART); bf16* XN = (bf16*)(ws + WS_XN); bf16* PROJ = (bf16*)(ws + WS_PROJ); bf16* VF = (bf16*)(ws + WS_VT); bf16* KF = (bf16*)(ws + WS_KF); bf16* Y = (bf16*)(ws + WS_Y);
    const int gw = vcu * NWAVES + wave, NGW = G * NWAVES;
    volatile LAS unsigned* xst = (volatile LAS unsigned*)((LAS unsigned char*)lds + 131072);
    if (tid < 2) xst[tid] = 0u;
    __syncthreads();
    const XcdBarrier xbar = xcd_barrier_post((unsigned*)ws, xst);

    {
        LAS float* scr = (LAS float*)((LAS unsigned char*)lds + wave * 16384);
        constexpr int I_IN = (DM / 64) * (NPROJ / 32), I_OUT = (DM / 64) * (DM / 32), I_PW = (128 / 64) * (128 / 32);
        constexpr int NITEMS = I_IN + I_OUT + 4 * I_PW;
        for (int it = gw; it < NITEMS; it += NGW) {
            int r = it;
            if (r < I_IN) { p0_transpose_item<false>(a.w_in, DM, NPROJ, WinT, scr, r, lane); continue; } r -= I_IN;
            if (r < I_OUT) { p0_transpose_item<false>(a.w_out, DM, DM, WoutT, scr, r, lane); continue; } r -= I_OUT;
            const int g = r / I_PW; r -= g * I_PW;
            p0_transpose_item<true>(a.pool_w + (size_t)g * 128 * 128, 128, 128, PoolWT + (size_t)g * 128 * 128, scr, r, lane);
        }
        f32x4 gv[4];
#pragma unroll
        for (int j = 0; j < 4; ++j) gv[j] = ((const f32x4*)a.norm_gain)[lane + 64 * j];
        for (int m0 = gw * 8; m0 < M; m0 += NGW * 8) {
            f32x4 v[8][4];
#pragma unroll
            for (int r = 0; r < 8; ++r) { const f32x4* xr = (const f32x4*)(a.x + (size_t)(m0 + r) * DM) + lane;
#pragma unroll
                for (int j = 0; j < 4; ++j) v[r][j] = __builtin_nontemporal_load(xr + 64 * j); }
#pragma unroll
            for (int r = 0; r < 8; ++r) { float ss = 0.f;
#pragma unroll
                for (int j = 0; j < 4; ++j) ss += (v[r][j][0] * v[r][j][0] + v[r][j][1] * v[r][j][1]) + (v[r][j][2] * v[r][j][2] + v[r][j][3] * v[r][j][3]);
                const float rstd = 1.0f / sqrtf(wave_sum(ss) * (1.f / DM) + EPS);
                unsigned long long* o8 = (unsigned long long*)(XN + (size_t)(m0 + r) * DM) + lane;
#pragma unroll
                for (int j = 0; j < 4; ++j) { const f32x4 t = v[r][j] * rstd * gv[j]; o8[64 * j] = (unsigned long long)pkbf(t[0], t[1]) | ((unsigned long long)pkbf(t[2], t[3]) << 32); } }
        }
    }
    if (a.ws == nullptr) grid.sync();
    xcd_barrier(xbar);

    {
        pg8::Gemm g{XN, WinT, M, NPROJ, DM}; pg8::StaticOrder S; S.init(M, NPROJ, G, bx);
        pg8::EpiProj E{PROJ, KF, VF};
        pg8::gemm_phase<pg8::EpiProj, pg8::StaticOrder, PG8_ALIGN, PG8_SP2>((PG8_LAS unsigned char*)lds, g, S, E);
    }
    xcd_barrier(xbar);

    {
        LAS float* tab = (LAS float*)((LAS unsigned char*)lds + NWAVES * WREG);
        LAS unsigned char* wl = (LAS unsigned char*)lds + wave * WREG;
        for (int i = tid; i < 8 * 256; i += NWAVES * 64) { const int hh = i >> 8, e = i & 255;
            const int src_i = (e < 129) ? e : ((e - 129 - 63) > 0 ? (e - 129 - 63) : 0); tab[i] = a.rel_bias[hh * 129 + src_i] * LOG2E; }
        __syncthreads();
        for (int unit = vcu; unit < BATCH * NCHUNK; unit += G) {
            const int b = unit / NCHUNK, c = unit % NCHUNK;
            const int g = wave >> 1, th = wave & 1;
            int ln = lane; asm volatile("" : "+v"(ln));
            switch (g) {
                case 0: pool_unit<2>(PROJ, PoolWT, a.pool_scale, Y, wl, b, c, 0, th, ln); break;
                case 1: pool_unit<4>(PROJ, PoolWT, a.pool_scale, Y, wl, b, c, 1, th, ln); break;
                case 2: pool_unit<8>(PROJ, PoolWT, a.pool_scale, Y, wl, b, c, 2, th, ln); break;
                default: pool_unit<16>(PROJ, PoolWT, a.pool_scale, Y, wl, b, c, 3, th, ln); break;
            }
            asm volatile("" : "+v"(ln));
            attn_unit(PROJ, KF, VF, Y, tab + wave * 256, wl, b, c, wave, ln);
        }
    }
    xcd_barrier(xbar);

    {
        pg8::Gemm g{Y, WoutT, M, DM, DM}; pg8::StaticOrder S; S.init(M, DM, G, bx);
        pg8::EpiOut E{a.x, a.out, (unsigned*)part, (unsigned*)(ws + 65536), a.fgain};
        pg8::gemm_phase<pg8::EpiOut, pg8::StaticOrder, PG8_ALIGN, PG8_SP2>((PG8_LAS unsigned char*)lds, g, S, E);
    }
}

extern "C" void kernel_launch(void* const* d_in, const int* in_sizes, int n_in, void* d_out, int out_size, void* d_ws, size_t ws_size, hipStream_t stream) {
    static int grid = 0;
    if (grid == 0) {
        if (n_in != 8 || in_sizes[0] != M * DM || out_size != M * DM || ws_size < WS_END) { fprintf(stderr, "kernel_launch: unexpected shapes (n_in %d, in0 %d, out %d, ws %zu); nothing launched\n", n_in, n_in > 0 ? in_sizes[0] : -1, out_size, ws_size); grid = -1; return; }
        int dev = 0, cus = 0, per_cu = 0;
        if (hipGetDevice(&dev) != hipSuccess || hipDeviceGetAttribute(&cus, hipDeviceAttributeMultiprocessorCount, dev) != hipSuccess) { fprintf(stderr, "kernel_launch: device query failed\n"); grid = -1; return; }
        if (hipFuncSetAttribute((const void*)fwd_mega, hipFuncAttributeMaxDynamicSharedMemorySize, LDS_BYTES) != hipSuccess) { fprintf(stderr, "kernel_launch: hipFuncSetAttribute failed\n"); grid = -1; return; }
        if (hipOccupancyMaxActiveBlocksPerMultiprocessor(&per_cu, (const void*)fwd_mega, NWAVES * 64, LDS_BYTES) != hipSuccess || per_cu < 1) { fprintf(stderr, "kernel_launch: occupancy query gave %d blocks per CU\n", per_cu); (void)hipGetLastError(); grid = -1; return; }
        grid = cus * per_cu;
    }
    if (grid < 0) return;
    if (hipMemsetAsync(d_ws, 0, 65536 + 65536, stream) != hipSuccess) { fprintf(stderr, "kernel_launch: hipMemsetAsync failed\n"); return; }
    Args a{};
    a.x = (const float*)d_in[0]; a.norm_gain = (const float*)d_in[1]; a.w_in = (const float*)d_in[2]; a.pool_w = (const float*)d_in[3]; a.pool_scale = (const float*)d_in[4];
    a.rel_bias = (const float*)d_in[5]; a.w_out = (const float*)d_in[6]; a.fgain = (const float*)d_in[7]; a.out = (float*)d_out; a.ws = (unsigned char*)d_ws;
    void* args[] = {&a};
    hipError_t e = hipLaunchCooperativeKernel((const void*)fwd_mega, dim3(grid), dim3(NWAVES * 64), args, LDS_BYTES, stream);
    if (e != hipSuccess) fprintf(stderr, "kernel_launch: cooperative launch failed: %s (grid %d)\n", hipGetErrorString(e), grid);
}
```

```cpp
#include <hip/hip_runtime.h>
#include <hip/hip_cooperative_groups.h>
#include <cstdio>
#include <cstdint>
__device__ __forceinline__ float xsum32(float v) { auto rr = __builtin_amdgcn_permlane32_swap(__builtin_bit_cast(unsigned, v), __builtin_bit_cast(unsigned, v), false, false); return __builtin_bit_cast(float, (unsigned)rr[0]) + __builtin_bit_cast(float, (unsigned)rr[1]); }
__device__ __forceinline__ float xmax32(float v) { auto rr = __builtin_amdgcn_permlane32_swap(__builtin_bit_cast(unsigned, v), __builtin_bit_cast(unsigned, v), false, false); return fmaxf(__builtin_bit_cast(float, (unsigned)rr[0]), __builtin_bit_cast(float, (unsigned)rr[1])); }
__device__ __forceinline__ float xsum16(float v) { auto rr = __builtin_amdgcn_permlane16_swap(__builtin_bit_cast(unsigned, v), __builtin_bit_cast(unsigned, v), false, false); return __builtin_bit_cast(float, (unsigned)rr[0]) + __builtin_bit_cast(float, (unsigned)rr[1]); }
namespace pg8 {
#define PG8_LAS __attribute__((address_space(3)))
typedef unsigned short bf16_t;
typedef short bf16x8 __attribute__((ext_vector_type(8)));
typedef float f32x4 __attribute__((ext_vector_type(4)));
typedef unsigned u32x4 __attribute__((ext_vector_type(4)));
constexpr int BM = 256, BK = 64, HALF = 128, HTB = HALF * BK * 2  , STAGE_BYTES = 8 * HTB, NXCD = 8, WGM = 8;

__host__ __device__ __forceinline__ int lds_byte(int r, int c) { const int st = (r >> 4) * 2 + (c >> 5), rr = r & 15, cc = c & 31, ob = rr * 64 + cc * 2; return st * 1024 + (ob ^ (((ob >> 9) & 1) << 5)); }
__host__ __device__ __forceinline__ void stage_rc(int b, int& R, int& C) { const int st = b / 1024, sb = b % 1024, swz = sb ^ (((sb >> 9) & 1) << 5); R = (st >> 1) * 16 + swz / 64; C = (st & 1) * 32 + (swz % 64) / 2; }
__host__ __device__ __forceinline__ int perm32(int rho) { const int n = rho >> 4, i = rho & 15; return 8 * (i >> 2) + 4 * n + (i & 3); }

struct Unit { int pm, pn; };
struct Gemm { const bf16_t* A; const bf16_t* Bt; int M, N, K; };

struct StaticOrder {
    int nM, nN, nwg, G, c;
    __host__ __device__ void init(int M, int N, int G_, int c_) { nM = M / BM; nN = N / BM; nwg = nM * nN; G = G_; c = c_; }
    __host__ __device__ bool next(int i, Unit& u) const {
        const long L = (long)i * G + c; if (L >= nwg) return false;
        int wgid = (int)L; { const int q = nwg / NXCD, r = nwg % NXCD, xcd = wgid % NXCD, off = wgid / NXCD; wgid = (xcd < r ? xcd * (q + 1) : r * (q + 1) + (xcd - r) * q) + off; }
        const int nig = WGM * nN, gid = wgid / nig, fm = gid * WGM, gsz = (nM - fm) < WGM ? (nM - fm) : WGM;
        u.pm = fm + ((wgid % nig) % gsz); u.pn = (wgid % nig) / gsz; return true;
    }
    __device__ __forceinline__ void a_ready(const Unit&) const {}
    __device__ __forceinline__ void done(const Unit&) const {}
};

__device__ __forceinline__ unsigned cvt_pk_bf16(float lo, float hi) { unsigned r; asm volatile("v_cvt_pk_bf16_f32 %0, %1, %2" : "=v"(r) : "v"(lo), "v"(hi)); return r; }
__device__ __forceinline__ unsigned short bf16_1(float v) { return (unsigned short)(cvt_pk_bf16(v, v) & 0xffffu); }
struct EpiProj {
    static constexpr bool PERM = true, AFTER_DRAIN = false;
    bf16_t* P; bf16_t* KF; bf16_t* VF;
    __device__ __forceinline__ void operator()(const f32x4 (&acc)[2][2][4][2], const Unit& u, int wr, int wc, int fr, int fq) const {
        const int row0 = u.pm * BM + wr * 64 + fr, col0 = u.pn * BM + wc * 32 + 8 * fq;
        if (u.pn == 6 || u.pn == 7) {
            const int b = row0 >> 13, s0 = row0 & 8191;
#pragma unroll
            for (int ai = 0; ai < 2; ++ai)
#pragma unroll
                for (int m = 0; m < 4; ++m) { const int s = s0 + ai * HALF + m * 16;
#pragma unroll
                    for (int bj = 0; bj < 2; ++bj) { const int ck = col0 - 1536 + bj * HALF, h = ck >> 6, d0 = ck & 63;
                        const size_t idx = ((((((size_t)(b * 8 + h) * 256 + (s >> 5)) * 4 + (d0 >> 4)) * 2 + ((d0 >> 3) & 1)) * 32 + (s & 31))) * 8;
                        const f32x4 v0 = acc[ai][bj][m][0], v1 = acc[ai][bj][m][1];
                        u32x4 w; w.x = cvt_pk_bf16(v0[0], v0[1]); w.y = cvt_pk_bf16(v0[2], v0[3]); w.z = cvt_pk_bf16(v1[0], v1[1]); w.w = cvt_pk_bf16(v1[2], v1[3]);
                        *(u32x4*)(KF + idx) = w; } }
        } else if (u.pn == 8 || u.pn == 9) {
            const int b = row0 >> 13, s0 = row0 & 8191;
#pragma unroll
            for (int ai = 0; ai < 2; ++ai)
#pragma unroll
                for (int m = 0; m < 4; ++m) { const int s = s0 + ai * HALF + m * 16;
                    const int sj = ((s >> 3) & 1) * 4 + (s & 3), shi = (s >> 2) & 1, ss2 = (s >> 4) & 1, sblk = s >> 5;
#pragma unroll
                    for (int bj = 0; bj < 2; ++bj) { const int cv = col0 - 2048 + bj * HALF, h = cv >> 6, d0 = cv & 63;
                        bf16_t* base = VF + (((((((size_t)(b * 8 + h) * 256 + sblk) * 2 + ss2) * 2 + (d0 >> 5)) * 2 + shi) * 32 + (d0 & 31))) * 8 + sj;
#pragma unroll
                        for (int n = 0; n < 2; ++n)
#pragma unroll
                            for (int e = 0; e < 4; ++e) base[(4 * n + e) * 8] = bf16_1(acc[ai][bj][m][n][e]); } }
        } else {
#pragma unroll
            for (int ai = 0; ai < 2; ++ai)
#pragma unroll
                for (int m = 0; m < 4; ++m) { bf16_t* rowp = P + (size_t)(row0 + ai * HALF + m * 16) * 3072 + col0;
#pragma unroll
                    for (int bj = 0; bj < 2; ++bj) { const f32x4 v0 = acc[ai][bj][m][0], v1 = acc[ai][bj][m][1];
                        u32x4 w; w.x = cvt_pk_bf16(v0[0], v0[1]); w.y = cvt_pk_bf16(v0[2], v0[3]); w.z = cvt_pk_bf16(v1[0], v1[1]); w.w = cvt_pk_bf16(v1[2], v1[3]);
                        *(u32x4*)(rowp + bj * HALF) = w; } }
        }
    }
};
struct EpiOut {
    static constexpr bool PERM = false, AFTER_DRAIN = false;
    const float* X; float* O; unsigned* part; unsigned* cnt; const float* gain;
    __device__ __forceinline__ void operator()(f32x4 (&acc)[2][2][4][2], const Unit& u, int wr, int wc, int fr, int fq) const {
        const int row0 = u.pm * BM + wr * 64 + fr, col0 = u.pn * BM + wc * 32 + 4 * fq;
#pragma unroll
        for (int ai = 0; ai < 2; ++ai)
#pragma unroll
            for (int m = 0; m < 4; ++m) { const int row = row0 + ai * HALF + m * 16; const size_t off = (size_t)row * 1024 + col0; float ss = 0.f;
#pragma unroll
                for (int bj = 0; bj < 2; ++bj)
#pragma unroll
                    for (int n = 0; n < 2; ++n) { const f32x4 xv = *(const f32x4*)(X + off + bj * HALF + n * 16); const f32x4 o = xv + acc[ai][bj][m][n];
                        acc[ai][bj][m][n] = o; ss += (o[0] * o[0] + o[1] * o[1]) + (o[2] * o[2] + o[3] * o[3]); }
                ss = xsum16(ss); ss = xsum32(ss);
                if (fq == 0) __hip_atomic_store(part + (size_t)row * 16 + u.pn * 4 + wc, __builtin_bit_cast(unsigned, ss), __ATOMIC_RELAXED, __HIP_MEMORY_SCOPE_AGENT); }
        asm volatile("s_waitcnt vmcnt(0)" ::: "memory");
        unsigned* cw = cnt + 64 * u.pm;
        if (__builtin_amdgcn_mbcnt_hi(~0u, __builtin_amdgcn_mbcnt_lo(~0u, 0u)) == 0u) __hip_atomic_fetch_add(cw, 1u, __ATOMIC_RELAXED, __HIP_MEMORY_SCOPE_AGENT);
        { unsigned sp = 0;
          while ((unsigned)__builtin_amdgcn_readfirstlane(__hip_atomic_load(cw, __ATOMIC_RELAXED, __HIP_MEMORY_SCOPE_AGENT)) < 32u) { __builtin_amdgcn_s_sleep(1); if (++sp > (1u << 22)) break; } }
        asm volatile("" ::: "memory");
        f32x4 gv[2][2];
#pragma unroll
        for (int bj = 0; bj < 2; ++bj)
#pragma unroll
            for (int n = 0; n < 2; ++n) gv[bj][n] = *(const f32x4*)(gain + col0 + bj * HALF + n * 16);
        unsigned long long w0[8], w1[8];
#pragma unroll
        for (int t = 0; t < 8; ++t) { const int row = row0 + (t >> 2) * HALF + (t & 3) * 16;
            const unsigned long long* pp = (const unsigned long long*)(part + (size_t)row * 16 + 4 * fq);
            w0[t] = __hip_atomic_load(pp, __ATOMIC_RELAXED, __HIP_MEMORY_SCOPE_AGENT); w1[t] = __hip_atomic_load(pp + 1, __ATOMIC_RELAXED, __HIP_MEMORY_SCOPE_AGENT); }
        asm volatile("" ::: "memory");
#pragma unroll
        for (int ai = 0; ai < 2; ++ai)
#pragma unroll
            for (int m = 0; m < 4; ++m) { const int t = ai * 4 + m; const int row = row0 + ai * HALF + m * 16; const size_t off = (size_t)row * 1024 + col0;
                float tot = (__builtin_bit_cast(float, (unsigned)w0[t]) + __builtin_bit_cast(float, (unsigned)(w0[t] >> 32))) + (__builtin_bit_cast(float, (unsigned)w1[t]) + __builtin_bit_cast(float, (unsigned)(w1[t] >> 32)));
                tot = xsum16(tot); tot = xsum32(tot);
                const float rstd = 1.0f / sqrtf(tot * (1.f / 1024.f) + 1e-6f);
#pragma unroll
                for (int bj = 0; bj < 2; ++bj)
#pragma unroll
                    for (int n = 0; n < 2; ++n) __builtin_nontemporal_store(acc[ai][bj][m][n] * rstd * gv[bj][n], (f32x4*)(O + off + bj * HALF + n * 16)); }
    }
};
template <class Epi, class Sched, bool ALIGN_EPI = false, bool SP2 = false>
__device__ __forceinline__ void gemm_phase(PG8_LAS unsigned char* lds, const Gemm g, const Sched& S, const Epi& E, int wave_in) {
    int wv_ = wave_in; asm volatile("" : "+s"(wv_));
    int tid_ = (int)__builtin_amdgcn_mbcnt_hi(~0u, __builtin_amdgcn_mbcnt_lo(~0u, 0u)) + 64 * wv_; asm volatile("" : "+v"(tid_));
    const int tid = tid_, wid = __builtin_amdgcn_readfirstlane(tid >> 6), lane = tid & 63, wr = wid >> 2, wc = wid & 3, fr = lane & 15, fq = lane >> 4;
    const int K = g.K, nt = K / BK;
    unsigned voffA[2], voffB[2];
#pragma unroll
    for (int i = 0; i < 2; ++i) { int R, C; stage_rc(tid * 16 + i * 8192, R, C); const int Rb = Epi::PERM ? ((R & ~31) + perm32(R & 31)) : R;
        voffA[i] = (unsigned)(R * K + C) * 2u; voffB[i] = (unsigned)(Rb * K + C) * 2u; }
    const size_t kstep = (size_t)(BK * 2);
    const size_t hstep = (size_t)HALF * K * 2;
    const size_t tstep = 2 * hstep;
    const unsigned ldsw = (unsigned)wid * 1024u;
    const int aoff = lds_byte(wr * 64 + fr, fq * 8), boff = lds_byte(wc * 32 + fr, fq * 8);
#define PG8_SA(b, h) (((b) * 2 + (h)) * HTB)
#define PG8_SB(b, h) ((4 + (b) * 2 + (h)) * HTB)
#define PG8_STAGE(bufoff, gbase, voff) do { _Pragma("unroll") for (int _i = 0; _i < 2; ++_i) \
        __builtin_amdgcn_global_load_lds((const unsigned*)((const char*)(gbase) + (voff)[_i]), (PG8_LAS unsigned*)(lds + (bufoff) + ldsw + _i * 8192), 16, 0, 0); } while (0)
#define PG8_LDA(dst, b, h) do { _Pragma("unroll") for (int m = 0; m < 4; ++m) _Pragma("unroll") for (int k = 0; k < 2; ++k) dst[m][k] = *(const PG8_LAS bf16x8*)(lds + PG8_SA(b, h) + aoff + m * 2048 + k * 1024); } while (0)
#define PG8_LDB(dst, b, h) do { _Pragma("unroll") for (int n = 0; n < 2; ++n) _Pragma("unroll") for (int k = 0; k < 2; ++k) dst[n][k] = *(const PG8_LAS bf16x8*)(lds + PG8_SB(b, h) + boff + n * 2048 + k * 1024); } while (0)
#define PG8_MMA(ai, bj, At, Bt) do { __builtin_amdgcn_s_setprio(1); _Pragma("unroll") for (int m = 0; m < 4; ++m) _Pragma("unroll") for (int n = 0; n < 2; ++n) _Pragma("unroll") for (int k = 0; k < 2; ++k) \
        acc[ai][bj][m][n] = __builtin_amdgcn_mfma_f32_16x16x32_bf16(Bt[n][k], At[m][k], acc[ai][bj][m][n], 0, 0, 0); __builtin_amdgcn_s_setprio(0); } while (0)
#define PG8_WAIT_V(n) asm volatile("s_waitcnt vmcnt(" #n ")" ::: "memory")
#define PG8_WAIT_L(n) asm volatile("s_waitcnt lgkmcnt(" #n ")" ::: "memory")
#define PG8_BAR __builtin_amdgcn_s_barrier()
#define PG8_SCHED __builtin_amdgcn_sched_barrier(0)
    Unit cur, nxt; int ui = 0;
    if (!S.next(0, cur)) return;
    f32x4 acc[2][2][4][2];
#pragma unroll
    for (int a = 0; a < 2; ++a)
#pragma unroll
        for (int b = 0; b < 2; ++b)
#pragma unroll
            for (int m = 0; m < 4; ++m)
#pragma unroll
                for (int n = 0; n < 2; ++n) acc[a][b][m][n] = (f32x4){0.f, 0.f, 0.f, 0.f};
    bf16x8 At[4][2], B0[2][2], B1[2][2];
    const char* cA = (const char*)g.A + (size_t)cur.pm * tstep; const char* cB = (const char*)g.Bt + (size_t)cur.pn * tstep;
    S.a_ready(cur);
    if constexpr (SP2) {
        PG8_STAGE(PG8_SB(0, 0), cB, voffB); PG8_STAGE(PG8_SB(0, 1), cB + hstep, voffB); PG8_STAGE(PG8_SA(0, 0), cA, voffA); PG8_STAGE(PG8_SA(0, 1), cA + hstep, voffA);
        if (wr == 1) PG8_BAR;
        PG8_WAIT_V(2); PG8_BAR;
        PG8_STAGE(PG8_SB(1, 0), cB + kstep, voffB); PG8_STAGE(PG8_SA(1, 0), cA + kstep, voffA); PG8_STAGE(PG8_SB(1, 1), cB + hstep + kstep, voffB);
        PG8_WAIT_V(6); PG8_BAR;
    } else {
        PG8_STAGE(PG8_SB(0, 0), cB, voffB); PG8_STAGE(PG8_SA(0, 0), cA, voffA); PG8_STAGE(PG8_SB(0, 1), cB + hstep, voffB); PG8_STAGE(PG8_SA(0, 1), cA + hstep, voffA);
        if (wr == 1) PG8_BAR;
        PG8_WAIT_V(4); PG8_BAR;
        PG8_STAGE(PG8_SB(1, 0), cB + kstep, voffB); PG8_STAGE(PG8_SA(1, 0), cA + kstep, voffA); PG8_STAGE(PG8_SB(1, 1), cB + hstep + kstep, voffB);
        PG8_WAIT_V(6); PG8_BAR;
    }
    for (;;) {
        const bool has_next = S.next(ui + 1, nxt);
        const char* nA = has_next ? (const char*)g.A + (size_t)nxt.pm * tstep : cA; const char* nB = has_next ? (const char*)g.Bt + (size_t)nxt.pn * tstep : cB;
        for (int t = 0; t < nt; t += 2) {
            const bool last = (t == nt - 2);
            const char* a1 = cA + (size_t)(t + 1) * kstep;
            const char* a2 = last ? nA : cA + (size_t)(t + 2) * kstep; const char* b2 = last ? nB : cB + (size_t)(t + 2) * kstep;
            const char* a3 = a2 + kstep; const char* b3 = b2 + kstep;
            if (last && has_next) S.a_ready(nxt);
            if constexpr (SP2) {
            PG8_LDB(B0, 0, 0); PG8_LDB(B1, 0, 1); PG8_SCHED; PG8_LDA(At, 0, 0); PG8_STAGE(PG8_SA(1, 1), a1 + hstep, voffA);
            PG8_WAIT_V(8); PG8_WAIT_L(0); PG8_BAR; PG8_MMA(0, 0, At, B0); PG8_MMA(0, 1, At, B1); PG8_BAR; PG8_SCHED;
            PG8_LDA(At, 0, 1); PG8_STAGE(PG8_SB(0, 0), b2, voffB); PG8_STAGE(PG8_SB(0, 1), b2 + hstep, voffB); PG8_STAGE(PG8_SA(0, 0), a2, voffA);
            PG8_WAIT_V(8); PG8_WAIT_L(0); PG8_BAR; PG8_MMA(1, 0, At, B0); PG8_MMA(1, 1, At, B1); PG8_BAR; PG8_SCHED;
            PG8_LDB(B0, 1, 0); PG8_LDB(B1, 1, 1); PG8_SCHED; PG8_LDA(At, 1, 0); PG8_STAGE(PG8_SA(0, 1), a2 + hstep, voffA);
            PG8_WAIT_V(8); PG8_WAIT_L(0); PG8_BAR; PG8_MMA(0, 0, At, B0); PG8_MMA(0, 1, At, B1); PG8_BAR; PG8_SCHED;
            PG8_LDA(At, 1, 1); PG8_STAGE(PG8_SB(1, 0), b3, voffB); PG8_STAGE(PG8_SB(1, 1), b3 + hstep, voffB); PG8_STAGE(PG8_SA(1, 0), a3, voffA);
            PG8_WAIT_V(8); PG8_WAIT_L(0); PG8_BAR; PG8_MMA(1, 0, At, B0); PG8_MMA(1, 1, At, B1); PG8_BAR; PG8_SCHED;
            } else {
            PG8_LDB(B0, 0, 0); PG8_SCHED; PG8_LDA(At, 0, 0); PG8_STAGE(PG8_SA(1, 1), a1 + hstep, voffA);
            PG8_WAIT_L(8); PG8_BAR; PG8_WAIT_L(0); PG8_MMA(0, 0, At, B0); PG8_BAR; PG8_SCHED;
            PG8_LDB(B1, 0, 1); PG8_STAGE(PG8_SB(0, 0), b2, voffB);
            PG8_BAR; PG8_WAIT_L(0); PG8_MMA(0, 1, At, B1); PG8_BAR;
            PG8_LDA(At, 0, 1); PG8_STAGE(PG8_SA(0, 0), a2, voffA);
            PG8_BAR; PG8_WAIT_L(0); PG8_MMA(1, 0, At, B0); PG8_BAR; PG8_SCHED;
            PG8_STAGE(PG8_SB(0, 1), b2 + hstep, voffB);
            PG8_WAIT_V(6); PG8_BAR; PG8_MMA(1, 1, At, B1); PG8_BAR;
            PG8_LDB(B0, 1, 0); PG8_SCHED; PG8_LDA(At, 1, 0); PG8_STAGE(PG8_SA(0, 1), a2 + hstep, voffA);
            PG8_WAIT_L(8); PG8_BAR; PG8_WAIT_L(0); PG8_MMA(0, 0, At, B0); PG8_BAR; PG8_SCHED;
            PG8_LDB(B1, 1, 1); PG8_STAGE(PG8_SB(1, 0), b3, voffB);
            PG8_BAR; PG8_WAIT_L(0); PG8_MMA(0, 1, At, B1); PG8_BAR;
            PG8_LDA(At, 1, 1); PG8_STAGE(PG8_SA(1, 0), a3, voffA);
            PG8_BAR; PG8_WAIT_L(0); PG8_MMA(1, 0, At, B0); PG8_BAR; PG8_SCHED;
            PG8_STAGE(PG8_SB(1, 1), b3 + hstep, voffB);
            PG8_WAIT_V(6); PG8_BAR; PG8_MMA(1, 1, At, B1); PG8_BAR;
            }
        }
        if constexpr (ALIGN_EPI) { if (wr == 0) PG8_BAR; }
        if constexpr (!Epi::AFTER_DRAIN) { E(acc, cur, wr, wc, fr, fq); S.done(cur); }
        if (!has_next) break;
#pragma unroll
        for (int a = 0; a < 2; ++a)
#pragma unroll
            for (int b = 0; b < 2; ++b)
#pragma unroll
                for (int m = 0; m < 4; ++m)
#pragma unroll
                    for (int n = 0; n < 2; ++n) acc[a][b][m][n] = (f32x4){0.f, 0.f, 0.f, 0.f};
        cur = nxt; cA = nA; cB = nB; ++ui;
        if constexpr (ALIGN_EPI) { if (wr == 1) PG8_BAR; }
    }
    PG8_WAIT_V(0);
    if constexpr (!ALIGN_EPI) { if (wr == 0) PG8_BAR; }
    PG8_BAR;
    if constexpr (Epi::AFTER_DRAIN) { E.fused(acc, cur, wr, wc, fr, fq, lds, wid, lane); S.done(cur); }
#undef PG8_SA
#undef PG8_SB
#undef PG8_STAGE
#undef PG8_LDA
#undef PG8_LDB
#undef PG8_MMA
#undef PG8_WAIT_V
#undef PG8_WAIT_L
#undef PG8_BAR
#undef PG8_SCHED
}
}
#ifndef PG8_SP2
#define PG8_SP2 true
#endif
#ifndef PG8_ALIGN
#define PG8_ALIGN true
#endif
namespace cg = cooperative_groups;
#define LAS __attribute__((address_space(3)))
typedef unsigned short bf16;
typedef float f32x4 __attribute__((ext_vector_type(4)));
typedef float f32x16 __attribute__((ext_vector_type(16)));
typedef short bf16x8 __attribute__((ext_vector_type(8)));
typedef unsigned u32x4 __attribute__((ext_vector_type(4)));
typedef unsigned u32x2 __attribute__((ext_vector_type(2)));

constexpr int NWAVES = 8;
constexpr int BATCH = 8, SEQ = 8192, DM = 1024, M = BATCH * SEQ, NPROJ = 3072, CHUNK = 64, NCHUNK = SEQ / CHUNK;
constexpr float EPS = 1e-6f, LOG2E = 1.4426950408889634f, SCL = 0.125f * 1.4426950408889634f;
constexpr size_t MiB = 1u << 20;
constexpr size_t WS_WINT = 1 * MiB, WS_WOUTT = 8 * MiB, WS_POOLWT = 10 * MiB, WS_PART = 12 * MiB, WS_XN = 16 * MiB, WS_PROJ = 144 * MiB, WS_VT = 528 * MiB, WS_Y = 592 * MiB, WS_KF = 720 * MiB, WS_END = 784 * MiB;
constexpr int LDS_BYTES = 147456;

__device__ __forceinline__ unsigned f2bf(float f) { unsigned u = __builtin_bit_cast(unsigned, f); return (u + 0x7fffu + ((u >> 16) & 1u)) >> 16; }
__device__ __forceinline__ unsigned pk2(float lo, float hi) { return f2bf(lo) | (f2bf(hi) << 16); }
typedef float f32x2_t __attribute__((ext_vector_type(2))); typedef __bf16 bf16x2_t __attribute__((ext_vector_type(2)));
__device__ __forceinline__ unsigned pkbf(float lo, float hi) { f32x2_t v = {lo, hi}; bf16x2_t b = __builtin_convertvector(v, bf16x2_t); return __builtin_bit_cast(unsigned, b); }
__device__ __forceinline__ float bf_lo(unsigned w) { return __builtin_bit_cast(float, w << 16); }
__device__ __forceinline__ float bf_hi(unsigned w) { return __builtin_bit_cast(float, w & 0xffff0000u); }
__device__ __forceinline__ float silu_f(float x) { return x * __builtin_amdgcn_rcpf(1.f + __builtin_amdgcn_exp2f(-x * LOG2E)); }
__device__ __forceinline__ float wave_sum(float v) {
#pragma unroll
    for (int o = 1; o < 64; o <<= 1) v += __shfl_xor(v, o);
    return v;
}

template <bool POOLF> __device__ __forceinline__ void p0_transpose_item(const float* W, int K, int N, bf16* WT, LAS float* scr, int item, int lane) {
    const int nblk = N / 32, kb = item / nblk, nb = item % nblk, k0 = 64 * kb, n0 = 32 * nb;
#pragma unroll 8
    for (int i = 0; i < 32; ++i) { const int kk = 2 * i + (lane >> 5); scr[kk * 33 + (lane & 31)] = W[(size_t)(k0 + kk) * N + n0 + (lane & 31)]; }
    asm volatile("s_waitcnt lgkmcnt(0)" ::: "memory");
    const int c = lane & 7;
#pragma unroll
    for (int j = 0; j < 4; ++j) { const int n = (lane >> 3) + 8 * j; const LAS float* s = scr + (8 * c) * 33 + n;
        u32x4 o; o.x = pk2(s[0 * 33], s[1 * 33]); o.y = pk2(s[2 * 33], s[3 * 33]); o.z = pk2(s[4 * 33], s[5 * 33]); o.w = pk2(s[6 * 33], s[7 * 33]);
        if (POOLF) { const int k = k0 + 8 * c, nn = n0 + n; *(u32x4*)(WT + (size_t)(((((k >> 4) * 4 + (nn >> 5)) * 2 + ((k >> 3) & 1)) * 32 + (nn & 31)) * 8)) = o; }
        else *(u32x4*)(WT + (size_t)(n0 + n) * K + k0 + 8 * c) = o; }
    asm volatile("s_waitcnt lgkmcnt(0)" ::: "memory");
}

typedef unsigned v4u __attribute__((ext_vector_type(4)));
#define XB_TMO      128
#define XB_XCNT(j)  (256  + 64 * (j))
#define XB_XSUB(j)  (1280 + 64 * (j))
#define XB_XGEN(j)  (2304 + 64 * (j))
#define XB_TOP      3328
#define XB_TOPGEN   3392
#define XCD_BAR_WORDS 3456
#define XB_SPIN_CAP (1u << 18)

__device__ __forceinline__ unsigned xb_ld(unsigned* p)              { return __hip_atomic_load(p, __ATOMIC_RELAXED, __HIP_MEMORY_SCOPE_AGENT); }
__device__ __forceinline__ unsigned xb_add(unsigned* p, unsigned v) { return __hip_atomic_fetch_add(p, v, __ATOMIC_RELAXED, __HIP_MEMORY_SCOPE_AGENT); }
__device__ __forceinline__ unsigned xb_xcc_id() { return (unsigned)__builtin_amdgcn_s_getreg((3 << 11) | 20) & 0xFu; }
#define XB_SPIN(cond, bar) do { unsigned _sp = 0; while (cond) { __builtin_amdgcn_s_sleep(1); \
    if ((++_sp & 255u) == 0u) { if (xb_ld(&(bar)[XB_TMO])) break; if (_sp > XB_SPIN_CAP) { atomicAdd(&(bar)[XB_TMO], 1u); break; } } } } while (0)

struct XcdBarrier {
    unsigned* bar; unsigned x;
    volatile LAS unsigned* st;
};

__device__ __forceinline__ XcdBarrier xcd_barrier_post(unsigned* bar, volatile LAS unsigned* st) {
    XcdBarrier b; b.bar = bar; b.x = xb_xcc_id(); b.st = st;
    if (threadIdx.x == 0) (void)xb_add(&bar[XB_XCNT(b.x)], 1u);
    return b;
}
__device__ __forceinline__ void xcd_barrier_complete(unsigned* bar, unsigned x, unsigned& nloc, unsigned& nx) {
    const unsigned G = gridDim.x * gridDim.y * gridDim.z;
    unsigned sum, cnt, mine, sp = 0u;
    for (;;) {
        sum = 0u; cnt = 0u; mine = 0u;
#pragma unroll
        for (unsigned j = 0; j < 16; ++j) { const unsigned c = xb_ld(&bar[XB_XCNT(j)]); sum += c; cnt += (c > 0u) ? 1u : 0u; mine = (j == x) ? c : mine; }
        if (sum == G) break;
        __builtin_amdgcn_s_sleep(1);
        if ((++sp & 255u) == 0u) { if (xb_ld(&bar[XB_TMO])) break; if (sp > XB_SPIN_CAP) { atomicAdd(&bar[XB_TMO], 1u); break; } }
    }
    nloc = mine > 0u ? mine : 1u; nx = cnt > 0u ? cnt : 1u;
}

__device__ __forceinline__ void xcd_barrier(const XcdBarrier& b) {
    asm volatile("s_waitcnt vmcnt(0)" ::: "memory");
    __syncthreads();
    if (threadIdx.x == 0) {
        unsigned* bar = b.bar;
        __builtin_amdgcn_s_waitcnt(0);
        unsigned nloc = b.st[0], nx = b.st[1];
        if (nloc == 0u) { xcd_barrier_complete(bar, b.x, nloc, nx); b.st[0] = nloc; b.st[1] = nx; }
        const unsigned old = xb_add(&bar[XB_XSUB(b.x)], 1u);
        const unsigned gen = old / nloc;
        if (old + 1u == (gen + 1u) * nloc) {
            __builtin_amdgcn_fence(__ATOMIC_RELEASE, "agent");
            asm volatile("s_waitcnt vmcnt(0)" ::: "memory");
            const unsigned og = xb_add(&bar[XB_TOP], 1u);
            const unsigned tg = og / nx;
            if (og + 1u == (tg + 1u) * nx) xb_add(&bar[XB_TOPGEN], 1u);
            else XB_SPIN(xb_ld(&bar[XB_TOPGEN]) == tg, bar);
            __builtin_amdgcn_fence(__ATOMIC_ACQUIRE, "agent");
            xb_add(&bar[XB_XGEN(b.x)], 1u);
            asm volatile("s_waitcnt vmcnt(0)" ::: "memory");
        } else {
            XB_SPIN(xb_ld(&bar[XB_XGEN(b.x)]) == gen, bar);
            __builtin_amdgcn_fence(__ATOMIC_ACQUIRE, "agent");
            asm volatile("s_waitcnt vmcnt(0)" ::: "memory");
        }
    }
    __syncthreads();
}

__device__ __forceinline__ int lane_id() { int l = (int)__builtin_amdgcn_mbcnt_hi(~0u, __builtin_amdgcn_mbcnt_lo(~0u, 0u)); asm volatile("" : "+v"(l)); return l; }
struct Args { const float* x; const float* norm_gain; const float* w_in; const float* pool_w; const float* pool_scale; const float* rel_bias; const float* w_out; const float* fgain; float* out; unsigned char* ws; };

constexpr int PROW = 272;
constexpr int WREG = 12800;
template <bool SCALE> __device__ __forceinline__ void epi_tile(LAS unsigned char* wl, const f32x16& v0, const f32x16& v1, float mul, const bf16* gbase, bf16* ybase, const float* scale, int lane) {
    LAS unsigned char* wp = wl + (lane & 31) * PROW + (lane >> 5) * 16;
#pragma unroll
    for (int i4 = 0; i4 < 4; ++i4) {
        *(LAS f32x4*)(wp + i4 * 32) = (f32x4){v0[4 * i4] * mul, v0[4 * i4 + 1] * mul, v0[4 * i4 + 2] * mul, v0[4 * i4 + 3] * mul};
        *(LAS f32x4*)(wp + 128 + i4 * 32) = (f32x4){v1[4 * i4] * mul, v1[4 * i4 + 1] * mul, v1[4 * i4 + 2] * mul, v1[4 * i4 + 3] * mul};
    }
    int lo_ = lane; asm volatile("" : "+v"(lo_));
    const int rr = lo_ >> 4, piece = lo_ & 15;
    const unsigned goff = (unsigned)(rr * NPROJ + 4 * piece), yoff = (unsigned)(rr * DM + 4 * piece);
    f32x4 s = (f32x4){1.f, 1.f, 1.f, 1.f};
    if (SCALE) s = *(const f32x4*)(scale + 4 * piece);
#pragma unroll
    for (int it = 0; it < 8; ++it) { const int row = 4 * it + rr;
        const f32x4 x = *(const LAS f32x4*)(wl + row * PROW + piece * 16);
        const u32x2 gw = *(const u32x2*)(gbase + (goff + (unsigned)(4 * it * NPROJ)));
        const float o0 = x[0] * s[0] * silu_f(bf_lo(gw.x)), o1 = x[1] * s[1] * silu_f(bf_hi(gw.x)), o2 = x[2] * s[2] * silu_f(bf_lo(gw.y)), o3 = x[3] * s[3] * silu_f(bf_hi(gw.y));
        u32x2 ow; ow.x = pkbf(o0, o1); ow.y = pkbf(o2, o3); *(u32x2*)(ybase + (yoff + (unsigned)(4 * it * DM))) = ow; }
}
template <int W> __device__ __forceinline__ void pool_unit(const bf16* proj, const bf16* pwf, const float* pool_scale, bf16* Y, LAS unsigned char* wl, int b, int c, int g, int th, int lane) {
    const int r32 = lane & 31, hi = lane >> 5;
    const int sb = c * CHUNK + th * 32, s = sb + r32; const size_t row = (size_t)b * SEQ + s;
#pragma unroll
    for (int i = 0; i < 12; ++i) { const int r0 = 4 * i + (lane >> 4), r = r0 < 46 ? r0 : 46, piece = lane & 15, u = sb - 15 + r, uc = u > 0 ? u : 0;
        u32x4 w = *(const u32x4*)(proj + ((size_t)b * SEQ + uc) * NPROJ + g * 128 + piece * 8);
        if (u < 0) w = (u32x4){0u, 0u, 0u, 0u};
        *(LAS u32x4*)(wl + r * PROW + piece * 16) = w; }
    const char* wt = (const char*)(pwf + (size_t)g * 128 * 128); const unsigned l16 = (unsigned)lane * 16u;
    const int cnt = (s + 1 < W) ? (s + 1) : W; const float inv = 1.f / (float)cnt;
    f32x16 acc[4];
#pragma unroll
    for (int db = 0; db < 4; ++db)
#pragma unroll
        for (int i = 0; i < 16; ++i) acc[db][i] = 0.f;
#pragma unroll 1
    for (int ks = 0; ks < 8; ++ks) {
        bf16x8 wf[4];
#pragma unroll
        for (int db = 0; db < 4; ++db) wf[db] = *(const bf16x8*)(wt + (ks * 4 + db) * 1024 + l16);
        float sum[8], own[8];
#pragma unroll
        for (int e = 0; e < 8; ++e) { sum[e] = 0.f; own[e] = 0.f; }
        const LAS unsigned char* rp = wl + (r32 + 15) * PROW + (2 * ks + hi) * 16;
#pragma unroll
        for (int i = 0; i < W; ++i) {
            const u32x4 w = *(const LAS u32x4*)(rp - i * PROW);
            const float f[8] = {bf_lo(w.x), bf_hi(w.x), bf_lo(w.y), bf_hi(w.y), bf_lo(w.z), bf_hi(w.z), bf_lo(w.w), bf_hi(w.w)};
#pragma unroll
            for (int e = 0; e < 8; ++e) { sum[e] += f[e]; if (i == 0) own[e] = f[e]; }
        }
        u32x4 o; o.x = pkbf(sum[0] * inv - own[0], sum[1] * inv - own[1]); o.y = pkbf(sum[2] * inv - own[2], sum[3] * inv - own[3]);
        o.z = pkbf(sum[4] * inv - own[4], sum[5] * inv - own[5]); o.w = pkbf(sum[6] * inv - own[6], sum[7] * inv - own[7]);
        const bf16x8 df = __builtin_bit_cast(bf16x8, o);
#pragma unroll
        for (int db = 0; db < 4; ++db) acc[db] = __builtin_amdgcn_mfma_f32_32x32x16_bf16(wf[db], df, acc[db], 0, 0, 0);
    }
    const size_t row0 = (size_t)b * SEQ + sb;
    epi_tile<true>(wl, acc[0], acc[1], 1.f, proj + row0 * NPROJ + (512 + g * 128), Y + row0 * DM + g * 128, pool_scale + g * 128, lane);
    epi_tile<true>(wl, acc[2], acc[3], 1.f, proj + row0 * NPROJ + (512 + g * 128 + 64), Y + row0 * DM + (g * 128 + 64), pool_scale + (g * 128 + 64), lane);
}
__device__ __forceinline__ void attn_unit(const bf16* proj, const bf16* KF, const bf16* VF, bf16* Y, const LAS float* tab, LAS unsigned char* wl, int b, int c, int h, int lane) {
    const int r32 = lane & 31, hi = lane >> 5;
    const int jstart = (c < 8) ? (8 - c) : 0;
    const char* kbase = (const char*)(KF + (size_t)(b * 8 + h) * 256 * 2048);
    const char* vbase = (const char*)(VF + (size_t)(b * 8 + h) * 256 * 2048);
    const unsigned l16 = (unsigned)lane * 16u;
#pragma unroll
    for (int qh = 0; qh < 2; ++qh) { const size_t rowq = (size_t)b * SEQ + c * CHUNK + qh * 32 + r32;
#pragma unroll
        for (int ds = 0; ds < 4; ++ds) { const bf16x8 q = *(const bf16x8*)(proj + rowq * NPROJ + 1024 + h * 64 + 16 * ds + 8 * hi); *(LAS bf16x8*)(wl + (qh * 4 + ds) * 1024 + l16) = q; } }
    bf16x8 kf[8];
    { const int kblk = (c - 8 + jstart) * 2;
#pragma unroll
        for (int t = 0; t < 8; ++t) kf[t] = *(const bf16x8*)(kbase + (size_t)kblk * 4096 + t * 1024 + l16); }
    float m[2] = {-1e30f, -1e30f}, l[2] = {0.f, 0.f}; f32x16 o[2][2];
#pragma unroll
    for (int qh = 0; qh < 2; ++qh)
#pragma unroll
        for (int db = 0; db < 2; ++db)
#pragma unroll
            for (int i = 0; i < 16; ++i) o[qh][db][i] = 0.f;
    for (int j = jstart; j <= 8; ++j) {
        const int kblk = (c - 8 + j) * 2;
        __builtin_amdgcn_sched_barrier(0);
        bf16x8 vf[8];
#pragma unroll
        for (int t = 0; t < 8; ++t) vf[t] = *(const bf16x8*)(vbase + (size_t)kblk * 4096 + t * 1024 + l16);
        __builtin_amdgcn_sched_barrier(0);
#pragma unroll
        for (int qh = 0; qh < 2; ++qh) {
            const int dq = 4 * hi - (qh * 32 + r32);
            f32x16 sc[2];
            { bf16x8 qf[4];
#pragma unroll
              for (int ds = 0; ds < 4; ++ds) qf[ds] = *(const LAS bf16x8*)(wl + (qh * 4 + ds) * 1024 + l16);
#pragma unroll
              for (int kb = 0; kb < 2; ++kb) {
#pragma unroll
                for (int i = 0; i < 16; ++i) sc[kb][i] = 0.f;
#pragma unroll
                for (int ds = 0; ds < 4; ++ds) sc[kb] = __builtin_amdgcn_mfma_f32_32x32x16_bf16(kf[kb * 4 + ds], qf[ds], sc[kb], 0, 0, 0);
              } }
            if (qh == 1) {
                __builtin_amdgcn_sched_barrier(0);
                if (j < 8) {
#pragma unroll
                    for (int t = 0; t < 8; ++t) kf[t] = *(const bf16x8*)(kbase + (size_t)(kblk + 2) * 4096 + t * 1024 + l16);
                }
                __builtin_amdgcn_sched_barrier(0);
            }
            if (j <= 6) { const float b0 = tab[0];
#pragma unroll
                for (int kb = 0; kb < 2; ++kb)
#pragma unroll
                    for (int i = 0; i < 16; ++i) sc[kb][i] = sc[kb][i] * SCL + b0;
            } else {
                const LAS float* tp = tab + ((j == 8) ? 64 : (129 + 63)) + dq;
#pragma unroll
                for (int kb = 0; kb < 2; ++kb)
#pragma unroll
                    for (int i = 0; i < 16; ++i) sc[kb][i] = sc[kb][i] * SCL + tp[32 * kb + (i & 3) + 8 * (i >> 2)];
            }
            float mt = sc[0][0];
#pragma unroll
            for (int kb = 0; kb < 2; ++kb)
#pragma unroll
                for (int i = 0; i < 16; ++i) mt = fmaxf(mt, sc[kb][i]);
            mt = xmax32(mt);
            const float mn = fmaxf(m[qh], mt); const float alpha = __builtin_amdgcn_exp2f(m[qh] - mn); m[qh] = mn;
            float ls = 0.f;
#pragma unroll
            for (int kb = 0; kb < 2; ++kb)
#pragma unroll
                for (int i = 0; i < 16; ++i) { const float p = __builtin_amdgcn_exp2f(sc[kb][i] - mn); sc[kb][i] = p; ls += p; }
            l[qh] = l[qh] * alpha + ls;
#pragma unroll
            for (int db = 0; db < 2; ++db)
#pragma unroll
                for (int i = 0; i < 16; ++i) o[qh][db][i] *= alpha;
#pragma unroll
            for (int kb = 0; kb < 2; ++kb)
#pragma unroll
                for (int s2 = 0; s2 < 2; ++s2) {
                    u32x4 pw; pw.x = pkbf(sc[kb][8 * s2 + 0], sc[kb][8 * s2 + 1]); pw.y = pkbf(sc[kb][8 * s2 + 2], sc[kb][8 * s2 + 3]);
                    pw.z = pkbf(sc[kb][8 * s2 + 4], sc[kb][8 * s2 + 5]); pw.w = pkbf(sc[kb][8 * s2 + 6], sc[kb][8 * s2 + 7]);
                    const bf16x8 pf = __builtin_bit_cast(bf16x8, pw);
#pragma unroll
                    for (int db = 0; db < 2; ++db) o[qh][db] = __builtin_amdgcn_mfma_f32_32x32x16_bf16(vf[(kb * 2 + s2) * 2 + db], pf, o[qh][db], 0, 0, 0);
                }
        }
    }
#pragma unroll
    for (int qh = 0; qh < 2; ++qh) {
        const float lt = xsum32(l[qh]); const float inv = 1.f / lt;
        const size_t row0 = (size_t)b * SEQ + c * CHUNK + qh * 32;
        epi_tile<false>(wl, o[qh][0], o[qh][1], inv, proj + row0 * NPROJ + (2560 + h * 64), Y + row0 * DM + (512 + h * 64), nullptr, lane);
    }
}

__global__ void __launch_bounds__(NWAVES * 64, 2) fwd_mega(Args a) {
    extern __shared__ __attribute__((aligned(16))) unsigned char lds[];
    cg::grid_group grid = cg::this_grid();
    const int wave = __builtin_amdgcn_readfirstlane((int)threadIdx.x >> 6);
    const int G = gridDim.x, bx = blockIdx.x; const int vcu = (G % 8 == 0) ? (bx % 8) * (G / 8) + bx / 8 : bx;
    unsigned char* ws = a.ws;
    bf16* WinT = (bf16*)(ws + WS_WINT); bf16* WoutT = (bf16*)(ws + WS_WOUTT); bf16* PoolWT = (bf16*)(ws + WS_POOLWT);
    float* part = (float*)(ws + WS_PART); bf16* XN = (bf16*)(ws + WS_XN); bf16* PROJ = (bf16*)(ws + WS_PROJ); bf16* VF = (bf16*)(ws + WS_VT); bf16* KF = (bf16*)(ws + WS_KF); bf16* Y = (bf16*)(ws + WS_Y);
    const int gw = vcu * NWAVES + wave, NGW = G * NWAVES;
    volatile LAS unsigned* xst = (volatile LAS unsigned*)((LAS unsigned char*)lds + 131072);
    if (threadIdx.x < 2) xst[threadIdx.x] = 0u;
    __syncthreads();
    const XcdBarrier xbar = xcd_barrier_post((unsigned*)ws, xst);

    {
        const int lane = lane_id();
        LAS float* scr = (LAS float*)((LAS unsigned char*)lds + wave * 16384);
        constexpr int I_IN = (DM / 64) * (NPROJ / 32), I_OUT = (DM / 64) * (DM / 32), I_PW = (128 / 64) * (128 / 32);
        constexpr int NITEMS = I_IN + I_OUT + 4 * I_PW;
        for (int it = gw; it < NITEMS; it += NGW) {
            int r = it;
            if (r < I_IN) { p0_transpose_item<false>(a.w_in, DM, NPROJ, WinT, scr, r, lane); continue; } r -= I_IN;
            if (r < I_OUT) { p0_transpose_item<false>(a.w_out, DM, DM, WoutT, scr, r, lane); continue; } r -= I_OUT;
            const int g = r / I_PW; r -= g * I_PW;
            p0_transpose_item<true>(a.pool_w + (size_t)g * 128 * 128, 128, 128, PoolWT + (size_t)g * 128 * 128, scr, r, lane);
        }
        f32x4 gv[4];
#pragma unroll
        for (int j = 0; j < 4; ++j) gv[j] = ((const f32x4*)a.norm_gain)[lane + 64 * j];
        for (int m0 = gw * 8; m0 < M; m0 += NGW * 8) {
            f32x4 v[8][4];
#pragma unroll
            for (int r = 0; r < 8; ++r) { const f32x4* xr = (const f32x4*)(a.x + (size_t)(m0 + r) * DM) + lane;
#pragma unroll
                for (int j = 0; j < 4; ++j) v[r][j] = __builtin_nontemporal_load(xr + 64 * j); }
#pragma unroll
            for (int r = 0; r < 8; ++r) { float ss = 0.f;
#pragma unroll
                for (int j = 0; j < 4; ++j) ss += (v[r][j][0] * v[r][j][0] + v[r][j][1] * v[r][j][1]) + (v[r][j][2] * v[r][j][2] + v[r][j][3] * v[r][j][3]);
                const float rstd = 1.0f / sqrtf(wave_sum(ss) * (1.f / DM) + EPS);
                unsigned long long* o8 = (unsigned long long*)(XN + (size_t)(m0 + r) * DM) + lane;
#pragma unroll
                for (int j = 0; j < 4; ++j) { const f32x4 t = v[r][j] * rstd * gv[j]; o8[64 * j] = (unsigned long long)pkbf(t[0], t[1]) | ((unsigned long long)pkbf(t[2], t[3]) << 32); } }
        }
    }
    if (a.ws == nullptr) grid.sync();
    xcd_barrier(xbar);

    {
        pg8::Gemm g{XN, WinT, M, NPROJ, DM}; pg8::StaticOrder S; S.init(M, NPROJ, G, bx);
        pg8::EpiProj E{PROJ, KF, VF};
        pg8::gemm_phase<pg8::EpiProj, pg8::StaticOrder, PG8_ALIGN, PG8_SP2>((PG8_LAS unsigned char*)lds, g, S, E, wave);
    }
    xcd_barrier(xbar);

    {
        LAS float* tab = (LAS float*)((LAS unsigned char*)lds + NWAVES * WREG);
        LAS unsigned char* wl = (LAS unsigned char*)lds + wave * WREG;
        const int lane = lane_id(), tid = wave * 64 + lane;
        for (int i = tid; i < 8 * 256; i += NWAVES * 64) { const int hh = i >> 8, e = i & 255;
            const int src_i = (e < 129) ? e : ((e - 129 - 63) > 0 ? (e - 129 - 63) : 0); tab[i] = a.rel_bias[hh * 129 + src_i] * LOG2E; }
        __syncthreads();
        for (int unit = vcu; unit < BATCH * NCHUNK; unit += G) {
            const int b = unit / NCHUNK, c = unit % NCHUNK;
            const int g = wave >> 1, th = wave & 1;
            int ln = lane; asm volatile("" : "+v"(ln));
            switch (g) {
                case 0: pool_unit<2>(PROJ, PoolWT, a.pool_scale, Y, wl, b, c, 0, th, ln); break;
                case 1: pool_unit<4>(PROJ, PoolWT, a.pool_scale, Y, wl, b, c, 1, th, ln); break;
                case 2: pool_unit<8>(PROJ, PoolWT, a.pool_scale, Y, wl, b, c, 2, th, ln); break;
                default: pool_unit<16>(PROJ, PoolWT, a.pool_scale, Y, wl, b, c, 3, th, ln); break;
            }
            asm volatile("" : "+v"(ln));
            attn_unit(PROJ, KF, VF, Y, tab + wave * 256, wl, b, c, wave, ln);
        }
    }
    xcd_barrier(xbar);

    {
        pg8::Gemm g{Y, WoutT, M, DM, DM}; pg8::StaticOrder S; S.init(M, DM, G, bx);
        pg8::EpiOut E{a.x, a.out, (unsigned*)part, (unsigned*)(ws + 65536), a.fgain};
        pg8::gemm_phase<pg8::EpiOut, pg8::StaticOrder, PG8_ALIGN, PG8_SP2>((PG8_LAS unsigned char*)lds, g, S, E, wave);
    }
}

extern "C" void kernel_launch(void* const* d_in, const int* in_sizes, int n_in, void* d_out, int out_size, void* d_ws, size_t ws_size, hipStream_t stream) {
    static int grid = 0;
    if (grid == 0) {
        if (n_in != 8 || in_sizes[0] != M * DM || out_size != M * DM || ws_size < WS_END) { fprintf(stderr, "kernel_launch: unexpected shapes (n_in %d, in0 %d, out %d, ws %zu); nothing launched\n", n_in, n_in > 0 ? in_sizes[0] : -1, out_size, ws_size); grid = -1; return; }
        int dev = 0, cus = 0, per_cu = 0;
        if (hipGetDevice(&dev) != hipSuccess || hipDeviceGetAttribute(&cus, hipDeviceAttributeMultiprocessorCount, dev) != hipSuccess) { fprintf(stderr, "kernel_launch: device query failed\n"); grid = -1; return; }
        if (hipFuncSetAttribute((const void*)fwd_mega, hipFuncAttributeMaxDynamicSharedMemorySize, LDS_BYTES) != hipSuccess) { fprintf(stderr, "kernel_launch: hipFuncSetAttribute failed\n"); grid = -1; return; }
        if (hipOccupancyMaxActiveBlocksPerMultiprocessor(&per_cu, (const void*)fwd_mega, NWAVES * 64, LDS_BYTES) != hipSuccess || per_cu < 1) { fprintf(stderr, "kernel_launch: occupancy query gave %d blocks per CU\n", per_cu); (void)hipGetLastError(); grid = -1; return; }
        grid = cus * per_cu;
    }
    if (grid < 0) return;
    if (hipMemsetAsync(d_ws, 0, 65536 + 65536, stream) != hipSuccess) { fprintf(stderr, "kernel_launch: hipMemsetAsync failed\n"); return; }
    Args a{};
    a.x = (const float*)d_in[0]; a.norm_gain = (const float*)d_in[1]; a.w_in = (const float*)d_in[2]; a.pool_w = (const float*)d_in[3]; a.pool_scale = (const float*)d_in[4];
    a.rel_bias = (const float*)d_in[5]; a.w_out = (const float*)d_in[6]; a.fgain = (const float*)d_in[7]; a.out = (float*)d_out; a.ws = (unsigned char*)d_ws;
    void* args[] = {&a};
    hipError_t e = hipLaunchCooperativeKernel((const void*)fwd_mega, dim3(grid), dim3(NWAVES * 64), args, LDS_BYTES, stream);
    if (e != hipSuccess) fprintf(stderr, "kernel_launch: cooperative launch failed: %s (grid %d)\n", hipGetErrorString(e), grid);
}
```

```cpp
#include <hip/hip_runtime.h>
#include <hip/hip_cooperative_groups.h>
#include <cstdio>
#include <cstdint>
__device__ __forceinline__ float xsum32(float v) { auto rr = __builtin_amdgcn_permlane32_swap(__builtin_bit_cast(unsigned, v), __builtin_bit_cast(unsigned, v), false, false); return __builtin_bit_cast(float, (unsigned)rr[0]) + __builtin_bit_cast(float, (unsigned)rr[1]); }
__device__ __forceinline__ float xmax32(float v) { auto rr = __builtin_amdgcn_permlane32_swap(__builtin_bit_cast(unsigned, v), __builtin_bit_cast(unsigned, v), false, false); return fmaxf(__builtin_bit_cast(float, (unsigned)rr[0]), __builtin_bit_cast(float, (unsigned)rr[1])); }
__device__ __forceinline__ float xsum16(float v) { auto rr = __builtin_amdgcn_permlane16_swap(__builtin_bit_cast(unsigned, v), __builtin_bit_cast(unsigned, v), false, false); return __builtin_bit_cast(float, (unsigned)rr[0]) + __builtin_bit_cast(float, (unsigned)rr[1]); }
namespace pg8 {
#define PG8_LAS __attribute__((address_space(3)))
typedef unsigned short bf16_t;
typedef short bf16x8 __attribute__((ext_vector_type(8)));
typedef float f32x4 __attribute__((ext_vector_type(4)));
typedef unsigned u32x4 __attribute__((ext_vector_type(4)));
constexpr int BM = 256, BK = 64, HALF = 128, HTB = HALF * BK * 2  , STAGE_BYTES = 8 * HTB, NXCD = 8, WGM = 8;

__host__ __device__ __forceinline__ int lds_byte(int r, int c) { const int st = (r >> 4) * 2 + (c >> 5), rr = r & 15, cc = c & 31, ob = rr * 64 + cc * 2; return st * 1024 + (ob ^ (((ob >> 9) & 1) << 5)); }
__host__ __device__ __forceinline__ void stage_rc(int b, int& R, int& C) { const int st = b / 1024, sb = b % 1024, swz = sb ^ (((sb >> 9) & 1) << 5); R = (st >> 1) * 16 + swz / 64; C = (st & 1) * 32 + (swz % 64) / 2; }
__host__ __device__ __forceinline__ int perm32(int rho) { const int n = rho >> 4, i = rho & 15; return 8 * (i >> 2) + 4 * n + (i & 3); }

struct Unit { int pm, pn; };
struct Gemm { const bf16_t* A; const bf16_t* Bt; int M, N, K; };

struct StaticOrder {
    int nM, nN, nwg, G, c;
    __host__ __device__ void init(int M, int N, int G_, int c_) { nM = M / BM; nN = N / BM; nwg = nM * nN; G = G_; c = c_; }
    __host__ __device__ bool next(int i, Unit& u) const {
        const long L = (long)i * G + c; if (L >= nwg) return false;
        int wgid = (int)L; { const int q = nwg / NXCD, r = nwg % NXCD, xcd = wgid % NXCD, off = wgid / NXCD; wgid = (xcd < r ? xcd * (q + 1) : r * (q + 1) + (xcd - r) * q) + off; }
        const int nig = WGM * nN, gid = wgid / nig, fm = gid * WGM, gsz = (nM - fm) < WGM ? (nM - fm) : WGM;
        u.pm = fm + ((wgid % nig) % gsz); u.pn = (wgid % nig) / gsz; return true;
    }
    __device__ __forceinline__ void a_ready(const Unit&) const {}
    __device__ __forceinline__ void done(const Unit&) const {}
};

__device__ __forceinline__ unsigned cvt_pk_bf16(float lo, float hi) { unsigned r; asm volatile("v_cvt_pk_bf16_f32 %0, %1, %2" : "=v"(r) : "v"(lo), "v"(hi)); return r; }
__device__ __forceinline__ unsigned short bf16_1(float v) { return (unsigned short)(cvt_pk_bf16(v, v) & 0xffffu); }
struct EpiProj {
    static constexpr bool PERM = true, AFTER_DRAIN = false;
    bf16_t* P; bf16_t* KF; bf16_t* VF;
    __device__ __forceinline__ void operator()(const f32x4 (&acc)[2][2][4][2], const Unit& u, int wr, int wc, int fr, int fq) const {
        const int row0 = u.pm * BM + wr * 64 + fr, col0 = u.pn * BM + wc * 32 + 8 * fq;
        if (u.pn == 6 || u.pn == 7) {
            const int b = row0 >> 13, s0 = row0 & 8191;
#pragma unroll
            for (int ai = 0; ai < 2; ++ai)
#pragma unroll
                for (int m = 0; m < 4; ++m) { const int s = s0 + ai * HALF + m * 16;
#pragma unroll
                    for (int bj = 0; bj < 2; ++bj) { const int ck = col0 - 1536 + bj * HALF, h = ck >> 6, d0 = ck & 63;
                        const size_t idx = ((((((size_t)(b * 8 + h) * 256 + (s >> 5)) * 4 + (d0 >> 4)) * 2 + ((d0 >> 3) & 1)) * 32 + (s & 31))) * 8;
                        const f32x4 v0 = acc[ai][bj][m][0], v1 = acc[ai][bj][m][1];
                        u32x4 w; w.x = cvt_pk_bf16(v0[0], v0[1]); w.y = cvt_pk_bf16(v0[2], v0[3]); w.z = cvt_pk_bf16(v1[0], v1[1]); w.w = cvt_pk_bf16(v1[2], v1[3]);
                        *(u32x4*)(KF + idx) = w; } }
        } else if (u.pn == 8 || u.pn == 9) {
            const int b = row0 >> 13, s0 = row0 & 8191;
#pragma unroll
            for (int ai = 0; ai < 2; ++ai)
#pragma unroll
                for (int m = 0; m < 4; ++m) { const int s = s0 + ai * HALF + m * 16;
                    const int sj = ((s >> 3) & 1) * 4 + (s & 3), shi = (s >> 2) & 1, ss2 = (s >> 4) & 1, sblk = s >> 5;
#pragma unroll
                    for (int bj = 0; bj < 2; ++bj) { const int cv = col0 - 2048 + bj * HALF, h = cv >> 6, d0 = cv & 63;
                        bf16_t* base = VF + (((((((size_t)(b * 8 + h) * 256 + sblk) * 2 + ss2) * 2 + (d0 >> 5)) * 2 + shi) * 32 + (d0 & 31))) * 8 + sj;
#pragma unroll
                        for (int n = 0; n < 2; ++n)
#pragma unroll
                            for (int e = 0; e < 4; ++e) base[(4 * n + e) * 8] = bf16_1(acc[ai][bj][m][n][e]); } }
        } else {
#pragma unroll
            for (int ai = 0; ai < 2; ++ai)
#pragma unroll
                for (int m = 0; m < 4; ++m) { bf16_t* rowp = P + (size_t)(row0 + ai * HALF + m * 16) * 3072 + col0;
#pragma unroll
                    for (int bj = 0; bj < 2; ++bj) { const f32x4 v0 = acc[ai][bj][m][0], v1 = acc[ai][bj][m][1];
                        u32x4 w; w.x = cvt_pk_bf16(v0[0], v0[1]); w.y = cvt_pk_bf16(v0[2], v0[3]); w.z = cvt_pk_bf16(v1[0], v1[1]); w.w = cvt_pk_bf16(v1[2], v1[3]);
                        *(u32x4*)(rowp + bj * HALF) = w; } }
        }
    }
};
struct EpiOut {
    static constexpr bool PERM = false, AFTER_DRAIN = false;
    const float* X; float* O; unsigned long long* rowacc; const float* gain;
    __device__ __forceinline__ void operator()(f32x4 (&acc)[2][2][4][2], const Unit& u, int wr, int wc, int fr, int fq) const {
        const int row0 = u.pm * BM + wr * 64 + fr, col0 = u.pn * BM + wc * 32 + 4 * fq;
#pragma unroll
        for (int ai = 0; ai < 2; ++ai)
#pragma unroll
            for (int m = 0; m < 4; ++m) { const int row = row0 + ai * HALF + m * 16; const size_t off = (size_t)row * 1024 + col0; float ss = 0.f;
#pragma unroll
                for (int bj = 0; bj < 2; ++bj)
#pragma unroll
                    for (int n = 0; n < 2; ++n) { const f32x4 xv = *(const f32x4*)(X + off + bj * HALF + n * 16); const f32x4 o = xv + acc[ai][bj][m][n];
                        acc[ai][bj][m][n] = o; ss += (o[0] * o[0] + o[1] * o[1]) + (o[2] * o[2] + o[3] * o[3]); }
                ss = xsum16(ss); ss = xsum32(ss);
                if (fq == 0) { const unsigned long long q = (unsigned long long)(ss * 1048576.0f + 0.5f);
                    (void)__hip_atomic_fetch_add(rowacc + row, (q << 8) | 1ull, __ATOMIC_RELAXED, __HIP_MEMORY_SCOPE_AGENT); } }
        f32x4 gv[2][2];
#pragma unroll
        for (int bj = 0; bj < 2; ++bj)
#pragma unroll
            for (int n = 0; n < 2; ++n) gv[bj][n] = *(const f32x4*)(gain + col0 + bj * HALF + n * 16);
        unsigned long long w[8];
        { unsigned sp = 0;
          for (;;) { bool ok = true;
#pragma unroll
              for (int t = 0; t < 8; ++t) { w[t] = __hip_atomic_load(rowacc + row0 + (t >> 2) * HALF + (t & 3) * 16, __ATOMIC_RELAXED, __HIP_MEMORY_SCOPE_AGENT); ok = ok && ((w[t] & 255ull) == 16ull); }
              if (__builtin_amdgcn_ballot_w64(!ok) == 0ull) break;
              __builtin_amdgcn_s_sleep(1); if (++sp > (1u << 20)) break; } }
#pragma unroll
        for (int ai = 0; ai < 2; ++ai)
#pragma unroll
            for (int m = 0; m < 4; ++m) { const int t = ai * 4 + m; const int row = row0 + ai * HALF + m * 16; const size_t off = (size_t)row * 1024 + col0;
                const float tot = (float)(w[t] >> 8) * (1.0f / 1048576.0f);
                const float rstd = 1.0f / sqrtf(tot * (1.f / 1024.f) + 1e-6f);
#pragma unroll
                for (int bj = 0; bj < 2; ++bj)
#pragma unroll
                    for (int n = 0; n < 2; ++n) __builtin_nontemporal_store(acc[ai][bj][m][n] * rstd * gv[bj][n], (f32x4*)(O + off + bj * HALF + n * 16)); }
    }
};
template <class Epi, class Sched, bool ALIGN_EPI = false, bool SP2 = false>
__device__ __forceinline__ void gemm_phase(PG8_LAS unsigned char* lds, const Gemm g, const Sched& S, const Epi& E, int wave_in) {
    int wv_ = wave_in; asm volatile("" : "+s"(wv_));
    int tid_ = (int)__builtin_amdgcn_mbcnt_hi(~0u, __builtin_amdgcn_mbcnt_lo(~0u, 0u)) + 64 * wv_; asm volatile("" : "+v"(tid_));
    const int tid = tid_, wid = __builtin_amdgcn_readfirstlane(tid >> 6), lane = tid & 63, wr = wid >> 2, wc = wid & 3, fr = lane & 15, fq = lane >> 4;
    const int K = g.K, nt = K / BK;
    unsigned voffA[2], voffB[2];
#pragma unroll
    for (int i = 0; i < 2; ++i) { int R, C; stage_rc(tid * 16 + i * 8192, R, C); const int Rb = Epi::PERM ? ((R & ~31) + perm32(R & 31)) : R;
        voffA[i] = (unsigned)(R * K + C) * 2u; voffB[i] = (unsigned)(Rb * K + C) * 2u; }
    const size_t kstep = (size_t)(BK * 2);
    const size_t hstep = (size_t)HALF * K * 2;
    const size_t tstep = 2 * hstep;
    const unsigned ldsw = (unsigned)wid * 1024u;
    const int aoff = lds_byte(wr * 64 + fr, fq * 8), boff = lds_byte(wc * 32 + fr, fq * 8);
#define PG8_SA(b, h) (((b) * 2 + (h)) * HTB)
#define PG8_SB(b, h) ((4 + (b) * 2 + (h)) * HTB)
#define PG8_STAGE(bufoff, gbase, voff) do { _Pragma("unroll") for (int _i = 0; _i < 2; ++_i) \
        __builtin_amdgcn_global_load_lds((const unsigned*)((const char*)(gbase) + (voff)[_i]), (PG8_LAS unsigned*)(lds + (bufoff) + ldsw + _i * 8192), 16, 0, 0); } while (0)
#define PG8_LDA(dst, b, h) do { _Pragma("unroll") for (int m = 0; m < 4; ++m) _Pragma("unroll") for (int k = 0; k < 2; ++k) dst[m][k] = *(const PG8_LAS bf16x8*)(lds + PG8_SA(b, h) + aoff + m * 2048 + k * 1024); } while (0)
#define PG8_LDB(dst, b, h) do { _Pragma("unroll") for (int n = 0; n < 2; ++n) _Pragma("unroll") for (int k = 0; k < 2; ++k) dst[n][k] = *(const PG8_LAS bf16x8*)(lds + PG8_SB(b, h) + boff + n * 2048 + k * 1024); } while (0)
#define PG8_MMA(ai, bj, At, Bt) do { __builtin_amdgcn_s_setprio(1); _Pragma("unroll") for (int m = 0; m < 4; ++m) _Pragma("unroll") for (int n = 0; n < 2; ++n) _Pragma("unroll") for (int k = 0; k < 2; ++k) \
        acc[ai][bj][m][n] = __builtin_amdgcn_mfma_f32_16x16x32_bf16(Bt[n][k], At[m][k], acc[ai][bj][m][n], 0, 0, 0); __builtin_amdgcn_s_setprio(0); } while (0)
#define PG8_WAIT_V(n) asm volatile("s_waitcnt vmcnt(" #n ")" ::: "memory")
#define PG8_WAIT_L(n) asm volatile("s_waitcnt lgkmcnt(" #n ")" ::: "memory")
#define PG8_BAR __builtin_amdgcn_s_barrier()
#define PG8_SCHED __builtin_amdgcn_sched_barrier(0)
    Unit cur, nxt; int ui = 0;
    if (!S.next(0, cur)) return;
    f32x4 acc[2][2][4][2];
#pragma unroll
    for (int a = 0; a < 2; ++a)
#pragma unroll
        for (int b = 0; b < 2; ++b)
#pragma unroll
            for (int m = 0; m < 4; ++m)
#pragma unroll
                for (int n = 0; n < 2; ++n) acc[a][b][m][n] = (f32x4){0.f, 0.f, 0.f, 0.f};
    bf16x8 At[4][2], B0[2][2], B1[2][2];
    const char* cA = (const char*)g.A + (size_t)cur.pm * tstep; const char* cB = (const char*)g.Bt + (size_t)cur.pn * tstep;
    S.a_ready(cur);
    if constexpr (SP2) {
        PG8_STAGE(PG8_SB(0, 0), cB, voffB); PG8_STAGE(PG8_SB(0, 1), cB + hstep, voffB); PG8_STAGE(PG8_SA(0, 0), cA, voffA); PG8_STAGE(PG8_SA(0, 1), cA + hstep, voffA);
        if (wr == 1) PG8_BAR;
        PG8_WAIT_V(2); PG8_BAR;
        PG8_STAGE(PG8_SB(1, 0), cB + kstep, voffB); PG8_STAGE(PG8_SA(1, 0), cA + kstep, voffA); PG8_STAGE(PG8_SB(1, 1), cB + hstep + kstep, voffB);
        PG8_WAIT_V(6); PG8_BAR;
    } else {
        PG8_STAGE(PG8_SB(0, 0), cB, voffB); PG8_STAGE(PG8_SA(0, 0), cA, voffA); PG8_STAGE(PG8_SB(0, 1), cB + hstep, voffB); PG8_STAGE(PG8_SA(0, 1), cA + hstep, voffA);
        if (wr == 1) PG8_BAR;
        PG8_WAIT_V(4); PG8_BAR;
        PG8_STAGE(PG8_SB(1, 0), cB + kstep, voffB); PG8_STAGE(PG8_SA(1, 0), cA + kstep, voffA); PG8_STAGE(PG8_SB(1, 1), cB + hstep + kstep, voffB);
        PG8_WAIT_V(6); PG8_BAR;
    }
    for (;;) {
        const bool has_next = S.next(ui + 1, nxt);
        const char* nA = has_next ? (const char*)g.A + (size_t)nxt.pm * tstep : cA; const char* nB = has_next ? (const char*)g.Bt + (size_t)nxt.pn * tstep : cB;
        for (int t = 0; t < nt; t += 2) {
            const bool last = (t == nt - 2);
            const char* a1 = cA + (size_t)(t + 1) * kstep;
            const char* a2 = last ? nA : cA + (size_t)(t + 2) * kstep; const char* b2 = last ? nB : cB + (size_t)(t + 2) * kstep;
            const char* a3 = a2 + kstep; const char* b3 = b2 + kstep;
            if (last && has_next) S.a_ready(nxt);
            if constexpr (SP2) {
            PG8_LDB(B0, 0, 0); PG8_LDB(B1, 0, 1); PG8_SCHED; PG8_LDA(At, 0, 0); PG8_STAGE(PG8_SA(1, 1), a1 + hstep, voffA);
            PG8_WAIT_V(8); PG8_WAIT_L(0); PG8_BAR; PG8_MMA(0, 0, At, B0); PG8_MMA(0, 1, At, B1); PG8_BAR; PG8_SCHED;
            PG8_LDA(At, 0, 1); PG8_STAGE(PG8_SB(0, 0), b2, voffB); PG8_STAGE(PG8_SB(0, 1), b2 + hstep, voffB); PG8_STAGE(PG8_SA(0, 0), a2, voffA);
            PG8_WAIT_V(8); PG8_WAIT_L(0); PG8_BAR; PG8_MMA(1, 0, At, B0); PG8_MMA(1, 1, At, B1); PG8_BAR; PG8_SCHED;
            PG8_LDB(B0, 1, 0); PG8_LDB(B1, 1, 1); PG8_SCHED; PG8_LDA(At, 1, 0); PG8_STAGE(PG8_SA(0, 1), a2 + hstep, voffA);
            PG8_WAIT_V(8); PG8_WAIT_L(0); PG8_BAR; PG8_MMA(0, 0, At, B0); PG8_MMA(0, 1, At, B1); PG8_BAR; PG8_SCHED;
            PG8_LDA(At, 1, 1); PG8_STAGE(PG8_SB(1, 0), b3, voffB); PG8_STAGE(PG8_SB(1, 1), b3 + hstep, voffB); PG8_STAGE(PG8_SA(1, 0), a3, voffA);
            PG8_WAIT_V(8); PG8_WAIT_L(0); PG8_BAR; PG8_MMA(1, 0, At, B0); PG8_MMA(1, 1, At, B1); PG8_BAR; PG8_SCHED;
            } else {
            PG8_LDB(B0, 0, 0); PG8_SCHED; PG8_LDA(At, 0, 0); PG8_STAGE(PG8_SA(1, 1), a1 + hstep, voffA);
            PG8_WAIT_L(8); PG8_BAR; PG8_WAIT_L(0); PG8_MMA(0, 0, At, B0); PG8_BAR; PG8_SCHED;
            PG8_LDB(B1, 0, 1); PG8_STAGE(PG8_SB(0, 0), b2, voffB);
            PG8_BAR; PG8_WAIT_L(0); PG8_MMA(0, 1, At, B1); PG8_BAR;
            PG8_LDA(At, 0, 1); PG8_STAGE(PG8_SA(0, 0), a2, voffA);
            PG8_BAR; PG8_WAIT_L(0); PG8_MMA(1, 0, At, B0); PG8_BAR; PG8_SCHED;
            PG8_STAGE(PG8_SB(0, 1), b2 + hstep, voffB);
            PG8_WAIT_V(6); PG8_BAR; PG8_MMA(1, 1, At, B1); PG8_BAR;
            PG8_LDB(B0, 1, 0); PG8_SCHED; PG8_LDA(At, 1, 0); PG8_STAGE(PG8_SA(0, 1), a2 + hstep, voffA);
            PG8_WAIT_L(8); PG8_BAR; PG8_WAIT_L(0); PG8_MMA(0, 0, At, B0); PG8_BAR; PG8_SCHED;
            PG8_LDB(B1, 1, 1); PG8_STAGE(PG8_SB(1, 0), b3, voffB);
            PG8_BAR; PG8_WAIT_L(0); PG8_MMA(0, 1, At, B1); PG8_BAR;
            PG8_LDA(At, 1, 1); PG8_STAGE(PG8_SA(1, 0), a3, voffA);
            PG8_BAR; PG8_WAIT_L(0); PG8_MMA(1, 0, At, B0); PG8_BAR; PG8_SCHED;
            PG8_STAGE(PG8_SB(1, 1), b3 + hstep, voffB);
            PG8_WAIT_V(6); PG8_BAR; PG8_MMA(1, 1, At, B1); PG8_BAR;
            }
        }
        if constexpr (ALIGN_EPI) { if (wr == 0) PG8_BAR; }
        if constexpr (!Epi::AFTER_DRAIN) { E(acc, cur, wr, wc, fr, fq); S.done(cur); }
        if (!has_next) break;
#pragma unroll
        for (int a = 0; a < 2; ++a)
#pragma unroll
            for (int b = 0; b < 2; ++b)
#pragma unroll
                for (int m = 0; m < 4; ++m)
#pragma unroll
                    for (int n = 0; n < 2; ++n) acc[a][b][m][n] = (f32x4){0.f, 0.f, 0.f, 0.f};
        cur = nxt; cA = nA; cB = nB; ++ui;
        if constexpr (ALIGN_EPI) { if (wr == 1) PG8_BAR; }
    }
    PG8_WAIT_V(0);
    if constexpr (!ALIGN_EPI) { if (wr == 0) PG8_BAR; }
    PG8_BAR;
    if constexpr (Epi::AFTER_DRAIN) { E.fused(acc, cur, wr, wc, fr, fq, lds, wid, lane); S.done(cur); }
#undef PG8_SA
#undef PG8_SB
#undef PG8_STAGE
#undef PG8_LDA
#undef PG8_LDB
#undef PG8_MMA
#undef PG8_WAIT_V
#undef PG8_WAIT_L
#undef PG8_BAR
#undef PG8_SCHED
}
}
#ifndef PG8_SP2
#define PG8_SP2 true
#endif
#ifndef PG8_ALIGN
#define PG8_ALIGN true
#endif
namespace cg = cooperative_groups;
#define LAS __attribute__((address_space(3)))
typedef unsigned short bf16;
typedef float f32x4 __attribute__((ext_vector_type(4)));
typedef float f32x16 __attribute__((ext_vector_type(16)));
typedef short bf16x8 __attribute__((ext_vector_type(8)));
typedef unsigned u32x4 __attribute__((ext_vector_type(4)));
typedef unsigned u32x2 __attribute__((ext_vector_type(2)));

constexpr int NWAVES = 8;
constexpr int BATCH = 8, SEQ = 8192, DM = 1024, M = BATCH * SEQ, NPROJ = 3072, CHUNK = 64, NCHUNK = SEQ / CHUNK;
constexpr float EPS = 1e-6f, LOG2E = 1.4426950408889634f, SCL = 0.125f * 1.4426950408889634f;
constexpr size_t MiB = 1u << 20;
constexpr size_t WS_WINT = 1 * MiB, WS_WOUTT = 8 * MiB, WS_POOLWT = 10 * MiB, WS_PART = 12 * MiB, WS_XN = 16 * MiB, WS_PROJ = 144 * MiB, WS_VT = 528 * MiB, WS_Y = 592 * MiB, WS_KF = 720 * MiB, WS_END = 784 * MiB;
constexpr int LDS_BYTES = 147456;

__device__ __forceinline__ unsigned f2bf(float f) { unsigned u = __builtin_bit_cast(unsigned, f); return (u + 0x7fffu + ((u >> 16) & 1u)) >> 16; }
__device__ __forceinline__ unsigned pk2(float lo, float hi) { return f2bf(lo) | (f2bf(hi) << 16); }
typedef float f32x2_t __attribute__((ext_vector_type(2))); typedef __bf16 bf16x2_t __attribute__((ext_vector_type(2)));
__device__ __forceinline__ unsigned pkbf(float lo, float hi) { f32x2_t v = {lo, hi}; bf16x2_t b = __builtin_convertvector(v, bf16x2_t); return __builtin_bit_cast(unsigned, b); }
__device__ __forceinline__ float bf_lo(unsigned w) { return __builtin_bit_cast(float, w << 16); }
__device__ __forceinline__ float bf_hi(unsigned w) { return __builtin_bit_cast(float, w & 0xffff0000u); }
__device__ __forceinline__ float silu_f(float x) { return x * __builtin_amdgcn_rcpf(1.f + __builtin_amdgcn_exp2f(-x * LOG2E)); }
__device__ __forceinline__ float wave_sum(float v) {
#pragma unroll
    for (int o = 1; o < 64; o <<= 1) v += __shfl_xor(v, o);
    return v;
}

template <bool POOLF> __device__ __forceinline__ void p0_transpose_item(const float* W, int K, int N, bf16* WT, LAS float* scr, int item, int lane) {
    const int nblk = N / 32, kb = item / nblk, nb = item % nblk, k0 = 64 * kb, n0 = 32 * nb;
#pragma unroll 8
    for (int i = 0; i < 32; ++i) { const int kk = 2 * i + (lane >> 5); scr[kk * 33 + (lane & 31)] = W[(size_t)(k0 + kk) * N + n0 + (lane & 31)]; }
    asm volatile("s_waitcnt lgkmcnt(0)" ::: "memory");
    const int c = lane & 7;
#pragma unroll
    for (int j = 0; j < 4; ++j) { const int n = (lane >> 3) + 8 * j; const LAS float* s = scr + (8 * c) * 33 + n;
        u32x4 o; o.x = pk2(s[0 * 33], s[1 * 33]); o.y = pk2(s[2 * 33], s[3 * 33]); o.z = pk2(s[4 * 33], s[5 * 33]); o.w = pk2(s[6 * 33], s[7 * 33]);
        if (POOLF) { const int k = k0 + 8 * c, nn = n0 + n; *(u32x4*)(WT + (size_t)(((((k >> 4) * 4 + (nn >> 5)) * 2 + ((k >> 3) & 1)) * 32 + (nn & 31)) * 8)) = o; }
        else *(u32x4*)(WT + (size_t)(n0 + n) * K + k0 + 8 * c) = o; }
    asm volatile("s_waitcnt lgkmcnt(0)" ::: "memory");
}

typedef unsigned v4u __attribute__((ext_vector_type(4)));
#define XB_TMO      128
#define XB_XCNT(j)  (256  + 64 * (j))
#define XB_XSUB(j)  (1280 + 64 * (j))
#define XB_XGEN(j)  (2304 + 64 * (j))
#define XB_TOP      3328
#define XB_TOPGEN   3392
#define XCD_BAR_WORDS 3456
#define XB_SPIN_CAP (1u << 18)

__device__ __forceinline__ unsigned xb_ld(unsigned* p)              { return __hip_atomic_load(p, __ATOMIC_RELAXED, __HIP_MEMORY_SCOPE_AGENT); }
__device__ __forceinline__ unsigned xb_add(unsigned* p, unsigned v) { return __hip_atomic_fetch_add(p, v, __ATOMIC_RELAXED, __HIP_MEMORY_SCOPE_AGENT); }
__device__ __forceinline__ unsigned xb_xcc_id() { return (unsigned)__builtin_amdgcn_s_getreg((3 << 11) | 20) & 0xFu; }
#define XB_SPIN(cond, bar) do { unsigned _sp = 0; while (cond) { __builtin_amdgcn_s_sleep(1); \
    if ((++_sp & 255u) == 0u) { if (xb_ld(&(bar)[XB_TMO])) break; if (_sp > XB_SPIN_CAP) { atomicAdd(&(bar)[XB_TMO], 1u); break; } } } } while (0)

struct XcdBarrier {
    unsigned* bar; unsigned x;
    volatile LAS unsigned* st;
};

__device__ __forceinline__ XcdBarrier xcd_barrier_post(unsigned* bar, volatile LAS unsigned* st) {
    XcdBarrier b; b.bar = bar; b.x = xb_xcc_id(); b.st = st;
    if (threadIdx.x == 0) (void)xb_add(&bar[XB_XCNT(b.x)], 1u);
    return b;
}
__device__ __forceinline__ void xcd_barrier_complete(unsigned* bar, unsigned x, unsigned& nloc, unsigned& nx) {
    const unsigned G = gridDim.x * gridDim.y * gridDim.z;
    unsigned sum, cnt, mine, sp = 0u;
    for (;;) {
        sum = 0u; cnt = 0u; mine = 0u;
#pragma unroll
        for (unsigned j = 0; j < 16; ++j) { const unsigned c = xb_ld(&bar[XB_XCNT(j)]); sum += c; cnt += (c > 0u) ? 1u : 0u; mine = (j == x) ? c : mine; }
        if (sum == G) break;
        __builtin_amdgcn_s_sleep(1);
        if ((++sp & 255u) == 0u) { if (xb_ld(&bar[XB_TMO])) break; if (sp > XB_SPIN_CAP) { atomicAdd(&bar[XB_TMO], 1u); break; } }
    }
    nloc = mine > 0u ? mine : 1u; nx = cnt > 0u ? cnt : 1u;
}

__device__ __forceinline__ void xcd_barrier(const XcdBarrier& b) {
    asm volatile("s_waitcnt vmcnt(0)" ::: "memory");
    __syncthreads();
    if (threadIdx.x == 0) {
        unsigned* bar = b.bar;
        __builtin_amdgcn_s_waitcnt(0);
        unsigned nloc = b.st[0], nx = b.st[1];
        if (nloc == 0u) { xcd_barrier_complete(bar, b.x, nloc, nx); b.st[0] = nloc; b.st[1] = nx; }
        const unsigned old = xb_add(&bar[XB_XSUB(b.x)], 1u);
        const unsigned gen = old / nloc;
        if (old + 1u == (gen + 1u) * nloc) {
            __builtin_amdgcn_fence(__ATOMIC_RELEASE, "agent");
            asm volatile("s_waitcnt vmcnt(0)" ::: "memory");
            const unsigned og = xb_add(&bar[XB_TOP], 1u);
            const unsigned tg = og / nx;
            if (og + 1u == (tg + 1u) * nx) xb_add(&bar[XB_TOPGEN], 1u);
            else XB_SPIN(xb_ld(&bar[XB_TOPGEN]) == tg, bar);
            __builtin_amdgcn_fence(__ATOMIC_ACQUIRE, "agent");
            xb_add(&bar[XB_XGEN(b.x)], 1u);
            asm volatile("s_waitcnt vmcnt(0)" ::: "memory");
        } else {
            XB_SPIN(xb_ld(&bar[XB_XGEN(b.x)]) == gen, bar);
            __builtin_amdgcn_fence(__ATOMIC_ACQUIRE, "agent");
            asm volatile("s_waitcnt vmcnt(0)" ::: "memory");
        }
    }
    __syncthreads();
}

__device__ __forceinline__ int lane_id() { int l = (int)__builtin_amdgcn_mbcnt_hi(~0u, __builtin_amdgcn_mbcnt_lo(~0u, 0u)); asm volatile("" : "+v"(l)); return l; }
struct Args { const float* x; const float* norm_gain; const float* w_in; const float* pool_w; const float* pool_scale; const float* rel_bias; const float* w_out; const float* fgain; float* out; unsigned char* ws; };

constexpr int PROW = 272;
constexpr int WREG = 12800;
template <bool SCALE> __device__ __forceinline__ void epi_tile(LAS unsigned char* wl, const f32x16& v0, const f32x16& v1, float mul, const bf16* gbase, bf16* ybase, const float* scale, int lane) {
    LAS unsigned char* wp = wl + (lane & 31) * PROW + (lane >> 5) * 16;
#pragma unroll
    for (int i4 = 0; i4 < 4; ++i4) {
        *(LAS f32x4*)(wp + i4 * 32) = (f32x4){v0[4 * i4] * mul, v0[4 * i4 + 1] * mul, v0[4 * i4 + 2] * mul, v0[4 * i4 + 3] * mul};
        *(LAS f32x4*)(wp + 128 + i4 * 32) = (f32x4){v1[4 * i4] * mul, v1[4 * i4 + 1] * mul, v1[4 * i4 + 2] * mul, v1[4 * i4 + 3] * mul};
    }
    int lo_ = lane; asm volatile("" : "+v"(lo_));
    const int rr = lo_ >> 4, piece = lo_ & 15;
    const unsigned goff = (unsigned)(rr * NPROJ + 4 * piece), yoff = (unsigned)(rr * DM + 4 * piece);
    f32x4 s = (f32x4){1.f, 1.f, 1.f, 1.f};
    if (SCALE) s = *(const f32x4*)(scale + 4 * piece);
#pragma unroll
    for (int it = 0; it < 8; ++it) { const int row = 4 * it + rr;
        const f32x4 x = *(const LAS f32x4*)(wl + row * PROW + piece * 16);
        const u32x2 gw = *(const u32x2*)(gbase + (goff + (unsigned)(4 * it * NPROJ)));
        const float o0 = x[0] * s[0] * silu_f(bf_lo(gw.x)), o1 = x[1] * s[1] * silu_f(bf_hi(gw.x)), o2 = x[2] * s[2] * silu_f(bf_lo(gw.y)), o3 = x[3] * s[3] * silu_f(bf_hi(gw.y));
        u32x2 ow; ow.x = pkbf(o0, o1); ow.y = pkbf(o2, o3); *(u32x2*)(ybase + (yoff + (unsigned)(4 * it * DM))) = ow; }
}
template <int W> __device__ __forceinline__ void pool_unit(const bf16* proj, const bf16* pwf, const float* pool_scale, bf16* Y, LAS unsigned char* wl, int b, int c, int g, int th, int lane) {
    const int r32 = lane & 31, hi = lane >> 5;
    const int sb = c * CHUNK + th * 32, s = sb + r32; const size_t row = (size_t)b * SEQ + s;
#pragma unroll
    for (int i = 0; i < 12; ++i) { const int r0 = 4 * i + (lane >> 4), r = r0 < 46 ? r0 : 46, piece = lane & 15, u = sb - 15 + r, uc = u > 0 ? u : 0;
        u32x4 w = *(const u32x4*)(proj + ((size_t)b * SEQ + uc) * NPROJ + g * 128 + piece * 8);
        if (u < 0) w = (u32x4){0u, 0u, 0u, 0u};
        *(LAS u32x4*)(wl + r * PROW + piece * 16) = w; }
    const char* wt = (const char*)(pwf + (size_t)g * 128 * 128); const unsigned l16 = (unsigned)lane * 16u;
    const int cnt = (s + 1 < W) ? (s + 1) : W; const float inv = 1.f / (float)cnt;
    f32x16 acc[4];
#pragma unroll
    for (int db = 0; db < 4; ++db)
#pragma unroll
        for (int i = 0; i < 16; ++i) acc[db][i] = 0.f;
#pragma unroll 1
    for (int ks = 0; ks < 8; ++ks) {
        bf16x8 wf[4];
#pragma unroll
        for (int db = 0; db < 4; ++db) wf[db] = *(const bf16x8*)(wt + (ks * 4 + db) * 1024 + l16);
        float sum[8], own[8];
#pragma unroll
        for (int e = 0; e < 8; ++e) { sum[e] = 0.f; own[e] = 0.f; }
        const LAS unsigned char* rp = wl + (r32 + 15) * PROW + (2 * ks + hi) * 16;
#pragma unroll
        for (int i = 0; i < W; ++i) {
            const u32x4 w = *(const LAS u32x4*)(rp - i * PROW);
            const float f[8] = {bf_lo(w.x), bf_hi(w.x), bf_lo(w.y), bf_hi(w.y), bf_lo(w.z), bf_hi(w.z), bf_lo(w.w), bf_hi(w.w)};
#pragma unroll
            for (int e = 0; e < 8; ++e) { sum[e] += f[e]; if (i == 0) own[e] = f[e]; }
        }
        u32x4 o; o.x = pkbf(sum[0] * inv - own[0], sum[1] * inv - own[1]); o.y = pkbf(sum[2] * inv - own[2], sum[3] * inv - own[3]);
        o.z = pkbf(sum[4] * inv - own[4], sum[5] * inv - own[5]); o.w = pkbf(sum[6] * inv - own[6], sum[7] * inv - own[7]);
        const bf16x8 df = __builtin_bit_cast(bf16x8, o);
#pragma unroll
        for (int db = 0; db < 4; ++db) acc[db] = __builtin_amdgcn_mfma_f32_32x32x16_bf16(wf[db], df, acc[db], 0, 0, 0);
    }
    const size_t row0 = (size_t)b * SEQ + sb;
    epi_tile<true>(wl, acc[0], acc[1], 1.f, proj + row0 * NPROJ + (512 + g * 128), Y + row0 * DM + g * 128, pool_scale + g * 128, lane);
    epi_tile<true>(wl, acc[2], acc[3], 1.f, proj + row0 * NPROJ + (512 + g * 128 + 64), Y + row0 * DM + (g * 128 + 64), pool_scale + (g * 128 + 64), lane);
}
__device__ __forceinline__ void attn_unit(const bf16* proj, const bf16* KF, const bf16* VF, bf16* Y, const LAS float* tab, LAS unsigned char* wl, int b, int c, int h, int lane) {
    const int r32 = lane & 31, hi = lane >> 5;
    const int jstart = (c < 8) ? (8 - c) : 0;
    const char* kbase = (const char*)(KF + (size_t)(b * 8 + h) * 256 * 2048);
    const char* vbase = (const char*)(VF + (size_t)(b * 8 + h) * 256 * 2048);
    const unsigned l16 = (unsigned)lane * 16u;
#pragma unroll
    for (int qh = 0; qh < 2; ++qh) { const size_t rowq = (size_t)b * SEQ + c * CHUNK + qh * 32 + r32;
#pragma unroll
        for (int ds = 0; ds < 4; ++ds) { const bf16x8 q = *(const bf16x8*)(proj + rowq * NPROJ + 1024 + h * 64 + 16 * ds + 8 * hi); *(LAS bf16x8*)(wl + (qh * 4 + ds) * 1024 + l16) = q; } }
    bf16x8 kf[8];
    { const int kblk = (c - 8 + jstart) * 2;
#pragma unroll
        for (int t = 0; t < 8; ++t) kf[t] = *(const bf16x8*)(kbase + (size_t)kblk * 4096 + t * 1024 + l16); }
    float m[2] = {-1e30f, -1e30f}, l[2] = {0.f, 0.f}; f32x16 o[2][2];
#pragma unroll
    for (int qh = 0; qh < 2; ++qh)
#pragma unroll
        for (int db = 0; db < 2; ++db)
#pragma unroll
            for (int i = 0; i < 16; ++i) o[qh][db][i] = 0.f;
    for (int j = jstart; j <= 8; ++j) {
        const int kblk = (c - 8 + j) * 2;
        __builtin_amdgcn_sched_barrier(0);
        bf16x8 vf[8];
#pragma unroll
        for (int t = 0; t < 8; ++t) vf[t] = *(const bf16x8*)(vbase + (size_t)kblk * 4096 + t * 1024 + l16);
        __builtin_amdgcn_sched_barrier(0);
#pragma unroll
        for (int qh = 0; qh < 2; ++qh) {
            const int dq = 4 * hi - (qh * 32 + r32);
            f32x16 sc[2];
            { bf16x8 qf[4];
#pragma unroll
              for (int ds = 0; ds < 4; ++ds) qf[ds] = *(const LAS bf16x8*)(wl + (qh * 4 + ds) * 1024 + l16);
#pragma unroll
              for (int kb = 0; kb < 2; ++kb) {
#pragma unroll
                for (int i = 0; i < 16; ++i) sc[kb][i] = 0.f;
#pragma unroll
                for (int ds = 0; ds < 4; ++ds) sc[kb] = __builtin_amdgcn_mfma_f32_32x32x16_bf16(kf[kb * 4 + ds], qf[ds], sc[kb], 0, 0, 0);
              } }
            if (qh == 1) {
                __builtin_amdgcn_sched_barrier(0);
                if (j < 8) {
#pragma unroll
                    for (int t = 0; t < 8; ++t) kf[t] = *(const bf16x8*)(kbase + (size_t)(kblk + 2) * 4096 + t * 1024 + l16);
                }
                __builtin_amdgcn_sched_barrier(0);
            }
            if (j <= 6) { const float b0 = tab[0];
#pragma unroll
                for (int kb = 0; kb < 2; ++kb)
#pragma unroll
                    for (int i = 0; i < 16; ++i) sc[kb][i] = sc[kb][i] * SCL + b0;
            } else {
                const LAS float* tp = tab + ((j == 8) ? 64 : (129 + 63)) + dq;
#pragma unroll
                for (int kb = 0; kb < 2; ++kb)
#pragma unroll
                    for (int i = 0; i < 16; ++i) sc[kb][i] = sc[kb][i] * SCL + tp[32 * kb + (i & 3) + 8 * (i >> 2)];
            }
            float mt = sc[0][0];
#pragma unroll
            for (int kb = 0; kb < 2; ++kb)
#pragma unroll
                for (int i = 0; i < 16; ++i) mt = fmaxf(mt, sc[kb][i]);
            mt = xmax32(mt);
            const float mn = fmaxf(m[qh], mt); const float alpha = __builtin_amdgcn_exp2f(m[qh] - mn); m[qh] = mn;
            float ls = 0.f;
#pragma unroll
            for (int kb = 0; kb < 2; ++kb)
#pragma unroll
                for (int i = 0; i < 16; ++i) { const float p = __builtin_amdgcn_exp2f(sc[kb][i] - mn); sc[kb][i] = p; ls += p; }
            l[qh] = l[qh] * alpha + ls;
#pragma unroll
            for (int db = 0; db < 2; ++db)
#pragma unroll
                for (int i = 0; i < 16; ++i) o[qh][db][i] *= alpha;
#pragma unroll
            for (int kb = 0; kb < 2; ++kb)
#pragma unroll
                for (int s2 = 0; s2 < 2; ++s2) {
                    u32x4 pw; pw.x = pkbf(sc[kb][8 * s2 + 0], sc[kb][8 * s2 + 1]); pw.y = pkbf(sc[kb][8 * s2 + 2], sc[kb][8 * s2 + 3]);
                    pw.z = pkbf(sc[kb][8 * s2 + 4], sc[kb][8 * s2 + 5]); pw.w = pkbf(sc[kb][8 * s2 + 6], sc[kb][8 * s2 + 7]);
                    const bf16x8 pf = __builtin_bit_cast(bf16x8, pw);
#pragma unroll
                    for (int db = 0; db < 2; ++db) o[qh][db] = __builtin_amdgcn_mfma_f32_32x32x16_bf16(vf[(kb * 2 + s2) * 2 + db], pf, o[qh][db], 0, 0, 0);
                }
        }
    }
#pragma unroll
    for (int qh = 0; qh < 2; ++qh) {
        const float lt = xsum32(l[qh]); const float inv = 1.f / lt;
        const size_t row0 = (size_t)b * SEQ + c * CHUNK + qh * 32;
        epi_tile<false>(wl, o[qh][0], o[qh][1], inv, proj + row0 * NPROJ + (2560 + h * 64), Y + row0 * DM + (512 + h * 64), nullptr, lane);
    }
}

__global__ void __launch_bounds__(NWAVES * 64, 2) fwd_mega(Args a) {
    extern __shared__ __attribute__((aligned(16))) unsigned char lds[];
    cg::grid_group grid = cg::this_grid();
    const int wave = __builtin_amdgcn_readfirstlane((int)threadIdx.x >> 6);
    const int G = gridDim.x, bx = blockIdx.x; const int vcu = (G % 8 == 0) ? (bx % 8) * (G / 8) + bx / 8 : bx;
    unsigned char* ws = a.ws;
    bf16* WinT = (bf16*)(ws + WS_WINT); bf16* WoutT = (bf16*)(ws + WS_WOUTT); bf16* PoolWT = (bf16*)(ws + WS_POOLWT);
    float* part = (float*)(ws + WS_PART); bf16* XN = (bf16*)(ws + WS_XN); bf16* PROJ = (bf16*)(ws + WS_PROJ); bf16* VF = (bf16*)(ws + WS_VT); bf16* KF = (bf16*)(ws + WS_KF); bf16* Y = (bf16*)(ws + WS_Y);
    const int gw = vcu * NWAVES + wave, NGW = G * NWAVES;
    volatile LAS unsigned* xst = (volatile LAS unsigned*)((LAS unsigned char*)lds + 131072);
    if (threadIdx.x < 2) xst[threadIdx.x] = 0u;
    __syncthreads();
    const XcdBarrier xbar = xcd_barrier_post((unsigned*)ws, xst);

    {
        const int lane = lane_id();
        LAS float* scr = (LAS float*)((LAS unsigned char*)lds + wave * 16384);
        constexpr int I_IN = (DM / 64) * (NPROJ / 32), I_OUT = (DM / 64) * (DM / 32), I_PW = (128 / 64) * (128 / 32);
        constexpr int NITEMS = I_IN + I_OUT + 4 * I_PW;
        for (int it = gw; it < NITEMS; it += NGW) {
            int r = it;
            if (r < I_IN) { p0_transpose_item<false>(a.w_in, DM, NPROJ, WinT, scr, r, lane); continue; } r -= I_IN;
            if (r < I_OUT) { p0_transpose_item<false>(a.w_out, DM, DM, WoutT, scr, r, lane); continue; } r -= I_OUT;
            const int g = r / I_PW; r -= g * I_PW;
            p0_transpose_item<true>(a.pool_w + (size_t)g * 128 * 128, 128, 128, PoolWT + (size_t)g * 128 * 128, scr, r, lane);
        }
        f32x4 gv[4];
#pragma unroll
        for (int j = 0; j < 4; ++j) gv[j] = ((const f32x4*)a.norm_gain)[lane + 64 * j];
        for (int m0 = gw * 8; m0 < M; m0 += NGW * 8) {
            f32x4 v[8][4];
#pragma unroll
            for (int r = 0; r < 8; ++r) { const f32x4* xr = (const f32x4*)(a.x + (size_t)(m0 + r) * DM) + lane;
#pragma unroll
                for (int j = 0; j < 4; ++j) v[r][j] = __builtin_nontemporal_load(xr + 64 * j); }
#pragma unroll
            for (int r = 0; r < 8; ++r) { float ss = 0.f;
#pragma unroll
                for (int j = 0; j < 4; ++j) ss += (v[r][j][0] * v[r][j][0] + v[r][j][1] * v[r][j][1]) + (v[r][j][2] * v[r][j][2] + v[r][j][3] * v[r][j][3]);
                const float rstd = 1.0f / sqrtf(wave_sum(ss) * (1.f / DM) + EPS);
                unsigned long long* o8 = (unsigned long long*)(XN + (size_t)(m0 + r) * DM) + lane;
#pragma unroll
                for (int j = 0; j < 4; ++j) { const f32x4 t = v[r][j] * rstd * gv[j]; o8[64 * j] = (unsigned long long)pkbf(t[0], t[1]) | ((unsigned long long)pkbf(t[2], t[3]) << 32); } }
        }
    }
    if (a.ws == nullptr) grid.sync();
    xcd_barrier(xbar);

    {
        pg8::Gemm g{XN, WinT, M, NPROJ, DM}; pg8::StaticOrder S; S.init(M, NPROJ, G, bx);
        pg8::EpiProj E{PROJ, KF, VF};
        pg8::gemm_phase<pg8::EpiProj, pg8::StaticOrder, PG8_ALIGN, PG8_SP2>((PG8_LAS unsigned char*)lds, g, S, E, wave);
    }
    xcd_barrier(xbar);

    {
        LAS float* tab = (LAS float*)((LAS unsigned char*)lds + NWAVES * WREG);
        LAS unsigned char* wl = (LAS unsigned char*)lds + wave * WREG;
        const int lane = lane_id(), tid = wave * 64 + lane;
        for (int i = tid; i < 8 * 256; i += NWAVES * 64) { const int hh = i >> 8, e = i & 255;
            const int src_i = (e < 129) ? e : ((e - 129 - 63) > 0 ? (e - 129 - 63) : 0); tab[i] = a.rel_bias[hh * 129 + src_i] * LOG2E; }
        __syncthreads();
        for (int unit = vcu; unit < BATCH * NCHUNK; unit += G) {
            const int b = unit / NCHUNK, c = unit % NCHUNK;
            const int g = ((wave >> 1) + (unit / G)) & 3, th = wave & 1;
            int ln = lane; asm volatile("" : "+v"(ln));
            switch (g) {
                case 0: pool_unit<2>(PROJ, PoolWT, a.pool_scale, Y, wl, b, c, 0, th, ln); break;
                case 1: pool_unit<4>(PROJ, PoolWT, a.pool_scale, Y, wl, b, c, 1, th, ln); break;
                case 2: pool_unit<8>(PROJ, PoolWT, a.pool_scale, Y, wl, b, c, 2, th, ln); break;
                default: pool_unit<16>(PROJ, PoolWT, a.pool_scale, Y, wl, b, c, 3, th, ln); break;
            }
            asm volatile("" : "+v"(ln));
            attn_unit(PROJ, KF, VF, Y, tab + wave * 256, wl, b, c, wave, ln);
        }
    }
    xcd_barrier(xbar);

    {
        pg8::Gemm g{Y, WoutT, M, DM, DM}; pg8::StaticOrder S; S.init(M, DM, G, bx);
        pg8::EpiOut E{a.x, a.out, (unsigned long long*)(ws + 131072), a.fgain};
        pg8::gemm_phase<pg8::EpiOut, pg8::StaticOrder, PG8_ALIGN, PG8_SP2>((PG8_LAS unsigned char*)lds, g, S, E, wave);
    }
}

extern "C" void kernel_launch(void* const* d_in, const int* in_sizes, int n_in, void* d_out, int out_size, void* d_ws, size_t ws_size, hipStream_t stream) {
    static int grid = 0;
    if (grid == 0) {
        if (n_in != 8 || in_sizes[0] != M * DM || out_size != M * DM || ws_size < WS_END) { fprintf(stderr, "kernel_launch: unexpected shapes (n_in %d, in0 %d, out %d, ws %zu); nothing launched\n", n_in, n_in > 0 ? in_sizes[0] : -1, out_size, ws_size); grid = -1; return; }
        int dev = 0, cus = 0, per_cu = 0;
        if (hipGetDevice(&dev) != hipSuccess || hipDeviceGetAttribute(&cus, hipDeviceAttributeMultiprocessorCount, dev) != hipSuccess) { fprintf(stderr, "kernel_launch: device query failed\n"); grid = -1; return; }
        if (hipFuncSetAttribute((const void*)fwd_mega, hipFuncAttributeMaxDynamicSharedMemorySize, LDS_BYTES) != hipSuccess) { fprintf(stderr, "kernel_launch: hipFuncSetAttribute failed\n"); grid = -1; return; }
        if (hipOccupancyMaxActiveBlocksPerMultiprocessor(&per_cu, (const void*)fwd_mega, NWAVES * 64, LDS_BYTES) != hipSuccess || per_cu < 1) { fprintf(stderr, "kernel_launch: occupancy query gave %d blocks per CU\n", per_cu); (void)hipGetLastError(); grid = -1; return; }
        grid = cus * per_cu;
    }
    if (grid < 0) return;
    if (hipMemsetAsync(d_ws, 0, 131072 + 524288, stream) != hipSuccess) { fprintf(stderr, "kernel_launch: hipMemsetAsync failed\n"); return; }
    Args a{};
    a.x = (const float*)d_in[0]; a.norm_gain = (const float*)d_in[1]; a.w_in = (const float*)d_in[2]; a.pool_w = (const float*)d_in[3]; a.pool_scale = (const float*)d_in[4];
    a.rel_bias = (const float*)d_in[5]; a.w_out = (const float*)d_in[6]; a.fgain = (const float*)d_in[7]; a.out = (float*)d_out; a.ws = (unsigned char*)d_ws;
    void* args[] = {&a};
    hipError_t e = hipLaunchCooperativeKernel((const void*)fwd_mega, dim3(grid), dim3(NWAVES * 64), args, LDS_BYTES, stream);
    if (e != hipSuccess) fprintf(stderr, "kernel_launch: cooperative launch failed: %s (grid %d)\n", hipGetErrorString(e), grid);
}
```

```cpp
#include <hip/hip_runtime.h>
#include <hip/hip_cooperative_groups.h>
#include <cstdio>
#include <cstdint>
__device__ __forceinline__ float xsum32(float v) { auto rr = __builtin_amdgcn_permlane32_swap(__builtin_bit_cast(unsigned, v), __builtin_bit_cast(unsigned, v), false, false); return __builtin_bit_cast(float, (unsigned)rr[0]) + __builtin_bit_cast(float, (unsigned)rr[1]); }
__device__ __forceinline__ float xmax32(float v) { auto rr = __builtin_amdgcn_permlane32_swap(__builtin_bit_cast(unsigned, v), __builtin_bit_cast(unsigned, v), false, false); return fmaxf(__builtin_bit_cast(float, (unsigned)rr[0]), __builtin_bit_cast(float, (unsigned)rr[1])); }
__device__ __forceinline__ float xsum16(float v) { auto rr = __builtin_amdgcn_permlane16_swap(__builtin_bit_cast(unsigned, v), __builtin_bit_cast(unsigned, v), false, false); return __builtin_bit_cast(float, (unsigned)rr[0]) + __builtin_bit_cast(float, (unsigned)rr[1]); }
namespace pg8 {
#define PG8_LAS __attribute__((address_space(3)))
typedef unsigned short bf16_t;
typedef short bf16x8 __attribute__((ext_vector_type(8)));
typedef float f32x4 __attribute__((ext_vector_type(4)));
typedef unsigned u32x4 __attribute__((ext_vector_type(4)));
constexpr int BM = 256, BK = 64, HALF = 128, HTB = HALF * BK * 2  , STAGE_BYTES = 8 * HTB, NXCD = 8, WGM = 8;

__host__ __device__ __forceinline__ int lds_byte(int r, int c) { const int st = (r >> 4) * 2 + (c >> 5), rr = r & 15, cc = c & 31, ob = rr * 64 + cc * 2; return st * 1024 + (ob ^ (((ob >> 9) & 1) << 5)); }
__host__ __device__ __forceinline__ void stage_rc(int b, int& R, int& C) { const int st = b / 1024, sb = b % 1024, swz = sb ^ (((sb >> 9) & 1) << 5); R = (st >> 1) * 16 + swz / 64; C = (st & 1) * 32 + (swz % 64) / 2; }
__host__ __device__ __forceinline__ int perm32(int rho) { const int n = rho >> 4, i = rho & 15; return 8 * (i >> 2) + 4 * n + (i & 3); }

struct Unit { int pm, pn; };
struct Gemm { const bf16_t* A; const bf16_t* Bt; int M, N, K; };

struct StaticOrder {
    int nM, nN, nwg, G, c;
    __host__ __device__ void init(int M, int N, int G_, int c_) { nM = M / BM; nN = N / BM; nwg = nM * nN; G = G_; c = c_; }
    __host__ __device__ bool next(int i, Unit& u) const {
        const long L = (long)i * G + c; if (L >= nwg) return false;
        int wgid = (int)L; { const int q = nwg / NXCD, r = nwg % NXCD, xcd = wgid % NXCD, off = wgid / NXCD; wgid = (xcd < r ? xcd * (q + 1) : r * (q + 1) + (xcd - r) * q) + off; }
        const int nig = WGM * nN, gid = wgid / nig, fm = gid * WGM, gsz = (nM - fm) < WGM ? (nM - fm) : WGM;
        u.pm = fm + ((wgid % nig) % gsz); u.pn = (wgid % nig) / gsz; return true;
    }
    __device__ __forceinline__ void a_ready(const Unit&) const {}
    __device__ __forceinline__ void done(const Unit&) const {}
};

__device__ __forceinline__ unsigned cvt_pk_bf16(float lo, float hi) { unsigned r; asm volatile("v_cvt_pk_bf16_f32 %0, %1, %2" : "=v"(r) : "v"(lo), "v"(hi)); return r; }
__device__ __forceinline__ unsigned short bf16_1(float v) { return (unsigned short)(cvt_pk_bf16(v, v) & 0xffffu); }
struct EpiProj {
    static constexpr bool PERM = true, AFTER_DRAIN = false;
    bf16_t* P; bf16_t* KF; bf16_t* VF;
    __device__ __forceinline__ void operator()(const f32x4 (&acc)[2][2][4][2], const Unit& u, int wr, int wc, int fr, int fq) const {
        const int row0 = u.pm * BM + wr * 64 + fr, col0 = u.pn * BM + wc * 32 + 8 * fq;
        if (u.pn == 6 || u.pn == 7) {
            const int b = row0 >> 13, s0 = row0 & 8191;
#pragma unroll
            for (int ai = 0; ai < 2; ++ai)
#pragma unroll
                for (int m = 0; m < 4; ++m) { const int s = s0 + ai * HALF + m * 16;
#pragma unroll
                    for (int bj = 0; bj < 2; ++bj) { const int ck = col0 - 1536 + bj * HALF, h = ck >> 6, d0 = ck & 63;
                        const size_t idx = ((((((size_t)(b * 8 + h) * 256 + (s >> 5)) * 4 + (d0 >> 4)) * 2 + ((d0 >> 3) & 1)) * 32 + (s & 31))) * 8;
                        const f32x4 v0 = acc[ai][bj][m][0], v1 = acc[ai][bj][m][1];
                        u32x4 w; w.x = cvt_pk_bf16(v0[0], v0[1]); w.y = cvt_pk_bf16(v0[2], v0[3]); w.z = cvt_pk_bf16(v1[0], v1[1]); w.w = cvt_pk_bf16(v1[2], v1[3]);
                        *(u32x4*)(KF + idx) = w; } }
        } else if (u.pn == 8 || u.pn == 9) {
            const int b = row0 >> 13, s0 = row0 & 8191;
#pragma unroll
            for (int ai = 0; ai < 2; ++ai)
#pragma unroll
                for (int m = 0; m < 4; ++m) { const int s = s0 + ai * HALF + m * 16;
                    const int sj = ((s >> 3) & 1) * 4 + (s & 3), shi = (s >> 2) & 1, ss2 = (s >> 4) & 1, sblk = s >> 5;
#pragma unroll
                    for (int bj = 0; bj < 2; ++bj) { const int cv = col0 - 2048 + bj * HALF, h = cv >> 6, d0 = cv & 63;
                        bf16_t* base = VF + (((((((size_t)(b * 8 + h) * 256 + sblk) * 2 + ss2) * 2 + (d0 >> 5)) * 2 + shi) * 32 + (d0 & 31))) * 8 + sj;
#pragma unroll
                        for (int n = 0; n < 2; ++n)
#pragma unroll
                            for (int e = 0; e < 4; ++e) base[(4 * n + e) * 8] = bf16_1(acc[ai][bj][m][n][e]); } }
        } else {
#pragma unroll
            for (int ai = 0; ai < 2; ++ai)
#pragma unroll
                for (int m = 0; m < 4; ++m) { bf16_t* rowp = P + (size_t)(row0 + ai * HALF + m * 16) * 3072 + col0;
#pragma unroll
                    for (int bj = 0; bj < 2; ++bj) { const f32x4 v0 = acc[ai][bj][m][0], v1 = acc[ai][bj][m][1];
                        u32x4 w; w.x = cvt_pk_bf16(v0[0], v0[1]); w.y = cvt_pk_bf16(v0[2], v0[3]); w.z = cvt_pk_bf16(v1[0], v1[1]); w.w = cvt_pk_bf16(v1[2], v1[3]);
                        *(u32x4*)(rowp + bj * HALF) = w; } }
        }
    }
};
struct EpiOut {
    static constexpr bool PERM = false, AFTER_DRAIN = false;
    const float* X; float* O; unsigned long long* rowacc; const float* gain;
    __device__ __forceinline__ void operator()(f32x4 (&acc)[2][2][4][2], const Unit& u, int wr, int wc, int fr, int fq) const {
        const int row0 = u.pm * BM + wr * 64 + fr, col0 = u.pn * BM + wc * 32 + 4 * fq;
#pragma unroll
        for (int ai = 0; ai < 2; ++ai)
#pragma unroll
            for (int m = 0; m < 4; ++m) { const int row = row0 + ai * HALF + m * 16; const size_t off = (size_t)row * 1024 + col0; float ss = 0.f;
#pragma unroll
                for (int bj = 0; bj < 2; ++bj)
#pragma unroll
                    for (int n = 0; n < 2; ++n) { const f32x4 xv = *(const f32x4*)(X + off + bj * HALF + n * 16); const f32x4 o = xv + acc[ai][bj][m][n];
                        acc[ai][bj][m][n] = o; ss += (o[0] * o[0] + o[1] * o[1]) + (o[2] * o[2] + o[3] * o[3]); }
                ss = xsum16(ss); ss = xsum32(ss);
                if (fq == 0) { const unsigned long long q = (unsigned long long)(ss * 1048576.0f + 0.5f);
                    (void)__hip_atomic_fetch_add(rowacc + row, (q << 8) | 1ull, __ATOMIC_RELAXED, __HIP_MEMORY_SCOPE_AGENT); } }
        f32x4 gv[2][2];
#pragma unroll
        for (int bj = 0; bj < 2; ++bj)
#pragma unroll
            for (int n = 0; n < 2; ++n) gv[bj][n] = *(const f32x4*)(gain + col0 + bj * HALF + n * 16);
        unsigned long long w[8];
        { unsigned sp = 0;
          for (;;) { bool ok = true;
#pragma unroll
              for (int t = 0; t < 8; ++t) { w[t] = __hip_atomic_load(rowacc + row0 + (t >> 2) * HALF + (t & 3) * 16, __ATOMIC_RELAXED, __HIP_MEMORY_SCOPE_AGENT); ok = ok && ((w[t] & 255ull) == 16ull); }
              if (__builtin_amdgcn_ballot_w64(!ok) == 0ull) break;
              __builtin_amdgcn_s_sleep(1); if (++sp > (1u << 20)) break; } }
#pragma unroll
        for (int ai = 0; ai < 2; ++ai)
#pragma unroll
            for (int m = 0; m < 4; ++m) { const int t = ai * 4 + m; const int row = row0 + ai * HALF + m * 16; const size_t off = (size_t)row * 1024 + col0;
                const float tot = (float)(w[t] >> 8) * (1.0f / 1048576.0f);
                const float rstd = 1.0f / sqrtf(tot * (1.f / 1024.f) + 1e-6f);
#pragma unroll
                for (int bj = 0; bj < 2; ++bj)
#pragma unroll
                    for (int n = 0; n < 2; ++n) __builtin_nontemporal_store(acc[ai][bj][m][n] * rstd * gv[bj][n], (f32x4*)(O + off + bj * HALF + n * 16)); }
    }
};
template <class Epi, class Sched, bool ALIGN_EPI = false, bool SP2 = false>
__device__ __forceinline__ void gemm_phase(PG8_LAS unsigned char* lds, const Gemm g, const Sched& S, const Epi& E, int wave_in) {
    int wv_ = wave_in; asm volatile("" : "+s"(wv_));
    int tid_ = (int)__builtin_amdgcn_mbcnt_hi(~0u, __builtin_amdgcn_mbcnt_lo(~0u, 0u)) + 64 * wv_; asm volatile("" : "+v"(tid_));
    const int tid = tid_, wid = __builtin_amdgcn_readfirstlane(tid >> 6), lane = tid & 63, wr = wid >> 2, wc = wid & 3, fr = lane & 15, fq = lane >> 4;
    const int K = g.K, nt = K / BK;
    unsigned voffA[2], voffB[2];
#pragma unroll
    for (int i = 0; i < 2; ++i) { int R, C; stage_rc(tid * 16 + i * 8192, R, C); const int Rb = Epi::PERM ? ((R & ~31) + perm32(R & 31)) : R;
        voffA[i] = (unsigned)(R * K + C) * 2u; voffB[i] = (unsigned)(Rb * K + C) * 2u; }
    const size_t kstep = (size_t)(BK * 2);
    const size_t hstep = (size_t)HALF * K * 2;
    const size_t tstep = 2 * hstep;
    const unsigned ldsw = (unsigned)wid * 1024u;
    const int aoff = lds_byte(wr * 64 + fr, fq * 8), boff = lds_byte(wc * 32 + fr, fq * 8);
#define PG8_SA(b, h) (((b) * 2 + (h)) * HTB)
#define PG8_SB(b, h) ((4 + (b) * 2 + (h)) * HTB)
#define PG8_STAGE(bufoff, gbase, voff) do { _Pragma("unroll") for (int _i = 0; _i < 2; ++_i) \
        __builtin_amdgcn_global_load_lds((const unsigned*)((const char*)(gbase) + (voff)[_i]), (PG8_LAS unsigned*)(lds + (bufoff) + ldsw + _i * 8192), 16, 0, 0); } while (0)
#define PG8_LDA(dst, b, h) do { _Pragma("unroll") for (int m = 0; m < 4; ++m) _Pragma("unroll") for (int k = 0; k < 2; ++k) dst[m][k] = *(const PG8_LAS bf16x8*)(lds + PG8_SA(b, h) + aoff + m * 2048 + k * 1024); } while (0)
#define PG8_LDB(dst, b, h) do { _Pragma("unroll") for (int n = 0; n < 2; ++n) _Pragma("unroll") for (int k = 0; k < 2; ++k) dst[n][k] = *(const PG8_LAS bf16x8*)(lds + PG8_SB(b, h) + boff + n * 2048 + k * 1024); } while (0)
#define PG8_MMA(ai, bj, At, Bt) do { __builtin_amdgcn_s_setprio(1); _Pragma("unroll") for (int m = 0; m < 4; ++m) _Pragma("unroll") for (int n = 0; n < 2; ++n) _Pragma("unroll") for (int k = 0; k < 2; ++k) \
        acc[ai][bj][m][n] = __builtin_amdgcn_mfma_f32_16x16x32_bf16(Bt[n][k], At[m][k], acc[ai][bj][m][n], 0, 0, 0); __builtin_amdgcn_s_setprio(0); } while (0)
#define PG8_WAIT_V(n) asm volatile("s_waitcnt vmcnt(" #n ")" ::: "memory")
#define PG8_WAIT_L(n) asm volatile("s_waitcnt lgkmcnt(" #n ")" ::: "memory")
#define PG8_BAR __builtin_amdgcn_s_barrier()
#define PG8_SCHED __builtin_amdgcn_sched_barrier(0)
    Unit cur, nxt; int ui = 0;
    if (!S.next(0, cur)) return;
    f32x4 acc[2][2][4][2];
#pragma unroll
    for (int a = 0; a < 2; ++a)
#pragma unroll
        for (int b = 0; b < 2; ++b)
#pragma unroll
            for (int m = 0; m < 4; ++m)
#pragma unroll
                for (int n = 0; n < 2; ++n) acc[a][b][m][n] = (f32x4){0.f, 0.f, 0.f, 0.f};
    bf16x8 At[4][2], B0[2][2], B1[2][2];
    const char* cA = (const char*)g.A + (size_t)cur.pm * tstep; const char* cB = (const char*)g.Bt + (size_t)cur.pn * tstep;
    S.a_ready(cur);
    if constexpr (SP2) {
        PG8_STAGE(PG8_SB(0, 0), cB, voffB); PG8_STAGE(PG8_SB(0, 1), cB + hstep, voffB); PG8_STAGE(PG8_SA(0, 0), cA, voffA); PG8_STAGE(PG8_SA(0, 1), cA + hstep, voffA);
        if (wr == 1) PG8_BAR;
        PG8_WAIT_V(2); PG8_BAR;
        PG8_STAGE(PG8_SB(1, 0), cB + kstep, voffB); PG8_STAGE(PG8_SA(1, 0), cA + kstep, voffA); PG8_STAGE(PG8_SB(1, 1), cB + hstep + kstep, voffB);
        PG8_WAIT_V(6); PG8_BAR;
    } else {
        PG8_STAGE(PG8_SB(0, 0), cB, voffB); PG8_STAGE(PG8_SA(0, 0), cA, voffA); PG8_STAGE(PG8_SB(0, 1), cB + hstep, voffB); PG8_STAGE(PG8_SA(0, 1), cA + hstep, voffA);
        if (wr == 1) PG8_BAR;
        PG8_WAIT_V(4); PG8_BAR;
        PG8_STAGE(PG8_SB(1, 0), cB + kstep, voffB); PG8_STAGE(PG8_SA(1, 0), cA + kstep, voffA); PG8_STAGE(PG8_SB(1, 1), cB + hstep + kstep, voffB);
        PG8_WAIT_V(6); PG8_BAR;
    }
    for (;;) {
        const bool has_next = S.next(ui + 1, nxt);
        const char* nA = has_next ? (const char*)g.A + (size_t)nxt.pm * tstep : cA; const char* nB = has_next ? (const char*)g.Bt + (size_t)nxt.pn * tstep : cB;
        for (int t = 0; t < nt; t += 2) {
            const bool last = (t == nt - 2);
            const char* a1 = cA + (size_t)(t + 1) * kstep;
            const char* a2 = last ? nA : cA + (size_t)(t + 2) * kstep; const char* b2 = last ? nB : cB + (size_t)(t + 2) * kstep;
            const char* a3 = a2 + kstep; const char* b3 = b2 + kstep;
            if (last && has_next) S.a_ready(nxt);
            if constexpr (SP2) {
            PG8_LDB(B0, 0, 0); PG8_LDB(B1, 0, 1); PG8_SCHED; PG8_LDA(At, 0, 0); PG8_STAGE(PG8_SA(1, 1), a1 + hstep, voffA);
            PG8_WAIT_V(8); PG8_WAIT_L(0); PG8_BAR; PG8_MMA(0, 0, At, B0); PG8_MMA(0, 1, At, B1); PG8_BAR; PG8_SCHED;
            PG8_LDA(At, 0, 1); PG8_STAGE(PG8_SB(0, 0), b2, voffB); PG8_STAGE(PG8_SB(0, 1), b2 + hstep, voffB); PG8_STAGE(PG8_SA(0, 0), a2, voffA);
            PG8_WAIT_V(8); PG8_WAIT_L(0); PG8_BAR; PG8_MMA(1, 0, At, B0); PG8_MMA(1, 1, At, B1); PG8_BAR; PG8_SCHED;
            PG8_LDB(B0, 1, 0); PG8_LDB(B1, 1, 1); PG8_SCHED; PG8_LDA(At, 1, 0); PG8_STAGE(PG8_SA(0, 1), a2 + hstep, voffA);
            PG8_WAIT_V(8); PG8_WAIT_L(0); PG8_BAR; PG8_MMA(0, 0, At, B0); PG8_MMA(0, 1, At, B1); PG8_BAR; PG8_SCHED;
            PG8_LDA(At, 1, 1); PG8_STAGE(PG8_SB(1, 0), b3, voffB); PG8_STAGE(PG8_SB(1, 1), b3 + hstep, voffB); PG8_STAGE(PG8_SA(1, 0), a3, voffA);
            PG8_WAIT_V(8); PG8_WAIT_L(0); PG8_BAR; PG8_MMA(1, 0, At, B0); PG8_MMA(1, 1, At, B1); PG8_BAR; PG8_SCHED;
            } else {
            PG8_LDB(B0, 0, 0); PG8_SCHED; PG8_LDA(At, 0, 0); PG8_STAGE(PG8_SA(1, 1), a1 + hstep, voffA);
            PG8_WAIT_L(8); PG8_BAR; PG8_WAIT_L(0); PG8_MMA(0, 0, At, B0); PG8_BAR; PG8_SCHED;
            PG8_LDB(B1, 0, 1); PG8_STAGE(PG8_SB(0, 0), b2, voffB);
            PG8_BAR; PG8_WAIT_L(0); PG8_MMA(0, 1, At, B1); PG8_BAR;
            PG8_LDA(At, 0, 1); PG8_STAGE(PG8_SA(0, 0), a2, voffA);
            PG8_BAR; PG8_WAIT_L(0); PG8_MMA(1, 0, At, B0); PG8_BAR; PG8_SCHED;
            PG8_STAGE(PG8_SB(0, 1), b2 + hstep, voffB);
            PG8_WAIT_V(6); PG8_BAR; PG8_MMA(1, 1, At, B1); PG8_BAR;
            PG8_LDB(B0, 1, 0); PG8_SCHED; PG8_LDA(At, 1, 0); PG8_STAGE(PG8_SA(0, 1), a2 + hstep, voffA);
            PG8_WAIT_L(8); PG8_BAR; PG8_WAIT_L(0); PG8_MMA(0, 0, At, B0); PG8_BAR; PG8_SCHED;
            PG8_LDB(B1, 1, 1); PG8_STAGE(PG8_SB(1, 0), b3, voffB);
            PG8_BAR; PG8_WAIT_L(0); PG8_MMA(0, 1, At, B1); PG8_BAR;
            PG8_LDA(At, 1, 1); PG8_STAGE(PG8_SA(1, 0), a3, voffA);
            PG8_BAR; PG8_WAIT_L(0); PG8_MMA(1, 0, At, B0); PG8_BAR; PG8_SCHED;
            PG8_STAGE(PG8_SB(1, 1), b3 + hstep, voffB);
            PG8_WAIT_V(6); PG8_BAR; PG8_MMA(1, 1, At, B1); PG8_BAR;
            }
        }
        if constexpr (ALIGN_EPI) { if (wr == 0) PG8_BAR; }
        if constexpr (!Epi::AFTER_DRAIN) { E(acc, cur, wr, wc, fr, fq); S.done(cur); }
        if (!has_next) break;
#pragma unroll
        for (int a = 0; a < 2; ++a)
#pragma unroll
            for (int b = 0; b < 2; ++b)
#pragma unroll
                for (int m = 0; m < 4; ++m)
#pragma unroll
                    for (int n = 0; n < 2; ++n) acc[a][b][m][n] = (f32x4){0.f, 0.f, 0.f, 0.f};
        cur = nxt; cA = nA; cB = nB; ++ui;
        if constexpr (ALIGN_EPI) { if (wr == 1) PG8_BAR; }
    }
    PG8_WAIT_V(0);
    if constexpr (!ALIGN_EPI) { if (wr == 0) PG8_BAR; }
    PG8_BAR;
    if constexpr (Epi::AFTER_DRAIN) { E.fused(acc, cur, wr, wc, fr, fq, lds, wid, lane); S.done(cur); }
#undef PG8_SA
#undef PG8_SB
#undef PG8_STAGE
#undef PG8_LDA
#undef PG8_LDB
#undef PG8_MMA
#undef PG8_WAIT_V
#undef PG8_WAIT_L
#undef PG8_BAR
#undef PG8_SCHED
}
}
#ifndef PG8_SP2
#define PG8_SP2 true
#endif
#ifndef PG8_ALIGN
#define PG8_ALIGN true
#endif
namespace cg = cooperative_groups;
#define LAS __attribute__((address_space(3)))
typedef unsigned short bf16;
typedef float f32x4 __attribute__((ext_vector_type(4)));
typedef float f32x16 __attribute__((ext_vector_type(16)));
typedef short bf16x8 __attribute__((ext_vector_type(8)));
typedef unsigned u32x4 __attribute__((ext_vector_type(4)));
typedef unsigned u32x2 __attribute__((ext_vector_type(2)));

constexpr int NWAVES = 8;
constexpr int BATCH = 8, SEQ = 8192, DM = 1024, M = BATCH * SEQ, NPROJ = 3072, CHUNK = 64, NCHUNK = SEQ / CHUNK;
constexpr float EPS = 1e-6f, LOG2E = 1.4426950408889634f, SCL = 0.125f * 1.4426950408889634f;
constexpr size_t MiB = 1u << 20;
constexpr size_t WS_WINT = 1 * MiB, WS_WOUTT = 8 * MiB, WS_POOLWT = 10 * MiB, WS_PART = 12 * MiB, WS_XN = 16 * MiB, WS_PROJ = 144 * MiB, WS_VT = 528 * MiB, WS_Y = 592 * MiB, WS_KF = 720 * MiB, WS_END = 784 * MiB;
constexpr int LDS_BYTES = 147456;

__device__ __forceinline__ unsigned f2bf(float f) { unsigned u = __builtin_bit_cast(unsigned, f); return (u + 0x7fffu + ((u >> 16) & 1u)) >> 16; }
__device__ __forceinline__ unsigned pk2(float lo, float hi) { return f2bf(lo) | (f2bf(hi) << 16); }
typedef float f32x2_t __attribute__((ext_vector_type(2))); typedef __bf16 bf16x2_t __attribute__((ext_vector_type(2)));
__device__ __forceinline__ unsigned pkbf(float lo, float hi) { f32x2_t v = {lo, hi}; bf16x2_t b = __builtin_convertvector(v, bf16x2_t); return __builtin_bit_cast(unsigned, b); }
__device__ __forceinline__ float bf_lo(unsigned w) { return __builtin_bit_cast(float, w << 16); }
__device__ __forceinline__ float bf_hi(unsigned w) { return __builtin_bit_cast(float, w & 0xffff0000u); }
__device__ __forceinline__ float silu_f(float x) { return x * __builtin_amdgcn_rcpf(1.f + __builtin_amdgcn_exp2f(-x * LOG2E)); }
__device__ __forceinline__ float wave_sum(float v) {
#pragma unroll
    for (int o = 1; o < 64; o <<= 1) v += __shfl_xor(v, o);
    return v;
}

template <bool POOLF> __device__ __forceinline__ void p0_transpose_item(const float* W, int K, int N, bf16* WT, LAS float* scr, int item, int lane) {
    const int nblk = N / 32, kb = item / nblk, nb = item % nblk, k0 = 64 * kb, n0 = 32 * nb;
#pragma unroll 8
    for (int i = 0; i < 32; ++i) { const int kk = 2 * i + (lane >> 5); scr[kk * 33 + (lane & 31)] = W[(size_t)(k0 + kk) * N + n0 + (lane & 31)]; }
    asm volatile("s_waitcnt lgkmcnt(0)" ::: "memory");
    const int c = lane & 7;
#pragma unroll
    for (int j = 0; j < 4; ++j) { const int n = (lane >> 3) + 8 * j; const LAS float* s = scr + (8 * c) * 33 + n;
        u32x4 o; o.x = pk2(s[0 * 33], s[1 * 33]); o.y = pk2(s[2 * 33], s[3 * 33]); o.z = pk2(s[4 * 33], s[5 * 33]); o.w = pk2(s[6 * 33], s[7 * 33]);
        if (POOLF) { const int k = k0 + 8 * c, nn = n0 + n; *(u32x4*)(WT + (size_t)(((((k >> 4) * 4 + (nn >> 5)) * 2 + ((k >> 3) & 1)) * 32 + (nn & 31)) * 8)) = o; }
        else *(u32x4*)(WT + (size_t)(n0 + n) * K + k0 + 8 * c) = o; }
    asm volatile("s_waitcnt lgkmcnt(0)" ::: "memory");
}

typedef unsigned v4u __attribute__((ext_vector_type(4)));
#define XB_TMO      128
#define XB_XCNT(j)  (256  + 64 * (j))
#define XB_XSUB(j)  (1280 + 64 * (j))
#define XB_XGEN(j)  (2304 + 64 * (j))
#define XB_TOP      3328
#define XB_TOPGEN   3392
#define XCD_BAR_WORDS 3456
#define XB_SPIN_CAP (1u << 18)

__device__ __forceinline__ unsigned xb_ld(unsigned* p)              { return __hip_atomic_load(p, __ATOMIC_RELAXED, __HIP_MEMORY_SCOPE_AGENT); }
__device__ __forceinline__ unsigned xb_add(unsigned* p, unsigned v) { return __hip_atomic_fetch_add(p, v, __ATOMIC_RELAXED, __HIP_MEMORY_SCOPE_AGENT); }
__device__ __forceinline__ unsigned xb_xcc_id() { return (unsigned)__builtin_amdgcn_s_getreg((3 << 11) | 20) & 0xFu; }
#define XB_SPIN(cond, bar) do { unsigned _sp = 0; while (cond) { __builtin_amdgcn_s_sleep(1); \
    if ((++_sp & 255u) == 0u) { if (xb_ld(&(bar)[XB_TMO])) break; if (_sp > XB_SPIN_CAP) { atomicAdd(&(bar)[XB_TMO], 1u); break; } } } } while (0)

struct XcdBarrier {
    unsigned* bar; unsigned x;
    volatile LAS unsigned* st;
};

__device__ __forceinline__ XcdBarrier xcd_barrier_post(unsigned* bar, volatile LAS unsigned* st) {
    XcdBarrier b; b.bar = bar; b.x = xb_xcc_id(); b.st = st;
    if (threadIdx.x == 0) (void)xb_add(&bar[XB_XCNT(b.x)], 1u);
    return b;
}
__device__ __forceinline__ void xcd_barrier_complete(unsigned* bar, unsigned x, unsigned& nloc, unsigned& nx) {
    const unsigned G = gridDim.x * gridDim.y * gridDim.z;
    unsigned sum, cnt, mine, sp = 0u;
    for (;;) {
        sum = 0u; cnt = 0u; mine = 0u;
#pragma unroll
        for (unsigned j = 0; j < 16; ++j) { const unsigned c = xb_ld(&bar[XB_XCNT(j)]); sum += c; cnt += (c > 0u) ? 1u : 0u; mine = (j == x) ? c : mine; }
        if (sum == G) break;
        __builtin_amdgcn_s_sleep(1);
        if ((++sp & 255u) == 0u) { if (xb_ld(&bar[XB_TMO])) break; if (sp > XB_SPIN_CAP) { atomicAdd(&bar[XB_TMO], 1u); break; } }
    }
    nloc = mine > 0u ? mine : 1u; nx = cnt > 0u ? cnt : 1u;
}

__device__ __forceinline__ void xcd_barrier(const XcdBarrier& b) {
    asm volatile("s_waitcnt vmcnt(0)" ::: "memory");
    __syncthreads();
    if (threadIdx.x == 0) {
        unsigned* bar = b.bar;
        __builtin_amdgcn_s_waitcnt(0);
        unsigned nloc = b.st[0], nx = b.st[1];
        if (nloc == 0u) { xcd_barrier_complete(bar, b.x, nloc, nx); b.st[0] = nloc; b.st[1] = nx; }
        const unsigned old = xb_add(&bar[XB_XSUB(b.x)], 1u);
        const unsigned gen = old / nloc;
        if (old + 1u == (gen + 1u) * nloc) {
            __builtin_amdgcn_fence(__ATOMIC_RELEASE, "agent");
            asm volatile("s_waitcnt vmcnt(0)" ::: "memory");
            const unsigned og = xb_add(&bar[XB_TOP], 1u);
            const unsigned tg = og / nx;
            if (og + 1u == (tg + 1u) * nx) xb_add(&bar[XB_TOPGEN], 1u);
            else XB_SPIN(xb_ld(&bar[XB_TOPGEN]) == tg, bar);
            __builtin_amdgcn_fence(__ATOMIC_ACQUIRE, "agent");
            xb_add(&bar[XB_XGEN(b.x)], 1u);
            asm volatile("s_waitcnt vmcnt(0)" ::: "memory");
        } else {
            XB_SPIN(xb_ld(&bar[XB_XGEN(b.x)]) == gen, bar);
            __builtin_amdgcn_fence(__ATOMIC_ACQUIRE, "agent");
            asm volatile("s_waitcnt vmcnt(0)" ::: "memory");
        }
    }
    __syncthreads();
}

__device__ __forceinline__ int lane_id() { int l = (int)__builtin_amdgcn_mbcnt_hi(~0u, __builtin_amdgcn_mbcnt_lo(~0u, 0u)); asm volatile("" : "+v"(l)); return l; }
struct Args { const float* x; const float* norm_gain; const float* w_in; const float* pool_w; const float* pool_scale; const float* rel_bias; const float* w_out; const float* fgain; float* out; unsigned char* ws; };

constexpr int PROW = 272;
constexpr int WREG = 12800;
struct Gates { u32x2 g[8]; };
__device__ __forceinline__ void gate_load(Gates& G, const bf16* gbase, int lane) {
    const unsigned goff = (unsigned)((lane >> 4) * NPROJ + 4 * (lane & 15));
#pragma unroll
    for (int it = 0; it < 8; ++it) G.g[it] = *(const u32x2*)(gbase + (goff + (unsigned)(4 * it * NPROJ)));
}
template <bool SCALE> __device__ __forceinline__ void epi_tile(LAS unsigned char* wl, const f32x16& v0, const f32x16& v1, float mul, const Gates& G, bf16* ybase, const float* scale, int lane) {
    LAS unsigned char* wp = wl + (lane & 31) * PROW + (lane >> 5) * 16;
#pragma unroll
    for (int i4 = 0; i4 < 4; ++i4) {
        *(LAS f32x4*)(wp + i4 * 32) = (f32x4){v0[4 * i4] * mul, v0[4 * i4 + 1] * mul, v0[4 * i4 + 2] * mul, v0[4 * i4 + 3] * mul};
        *(LAS f32x4*)(wp + 128 + i4 * 32) = (f32x4){v1[4 * i4] * mul, v1[4 * i4 + 1] * mul, v1[4 * i4 + 2] * mul, v1[4 * i4 + 3] * mul};
    }
    const int rr = lane >> 4, piece = lane & 15;
    const unsigned yoff = (unsigned)(rr * DM + 4 * piece);
    f32x4 s = (f32x4){1.f, 1.f, 1.f, 1.f};
    if (SCALE) s = *(const f32x4*)(scale + 4 * piece);
#pragma unroll
    for (int it = 0; it < 8; ++it) { const int row = 4 * it + rr;
        const f32x4 x = *(const LAS f32x4*)(wl + row * PROW + piece * 16);
        const u32x2 gw = G.g[it];
        const float o0 = x[0] * s[0] * silu_f(bf_lo(gw.x)), o1 = x[1] * s[1] * silu_f(bf_hi(gw.x)), o2 = x[2] * s[2] * silu_f(bf_lo(gw.y)), o3 = x[3] * s[3] * silu_f(bf_hi(gw.y));
        u32x2 ow; ow.x = pkbf(o0, o1); ow.y = pkbf(o2, o3); *(u32x2*)(ybase + (yoff + (unsigned)(4 * it * DM))) = ow; }
}
template <int W> __device__ __forceinline__ bf16x8 pool_window(const LAS unsigned char* rp, float inv) {
    float sum[8], own[8];
#pragma unroll
    for (int e = 0; e < 8; ++e) { sum[e] = 0.f; own[e] = 0.f; }
#pragma unroll
    for (int i = 0; i < W; ++i) {
        const u32x4 w = *(const LAS u32x4*)(rp - i * PROW);
        const float f[8] = {bf_lo(w.x), bf_hi(w.x), bf_lo(w.y), bf_hi(w.y), bf_lo(w.z), bf_hi(w.z), bf_lo(w.w), bf_hi(w.w)};
#pragma unroll
        for (int e = 0; e < 8; ++e) { sum[e] += f[e]; if (i == 0) own[e] = f[e]; }
        if ((i & 3) == 3) __builtin_amdgcn_sched_barrier(0);
    }
    u32x4 o; o.x = pkbf(sum[0] * inv - own[0], sum[1] * inv - own[1]); o.y = pkbf(sum[2] * inv - own[2], sum[3] * inv - own[3]);
    o.z = pkbf(sum[4] * inv - own[4], sum[5] * inv - own[5]); o.w = pkbf(sum[6] * inv - own[6], sum[7] * inv - own[7]);
    return __builtin_bit_cast(bf16x8, o);
}
template <int W> __device__ __forceinline__ void pool_unit(const bf16* proj, const bf16* pwf, const float* pool_scale, bf16* Y, LAS unsigned char* wl, int b, int c, int g, int th, int lane) {
    const int r32 = lane & 31, hi = lane >> 5;
    const int sb = c * CHUNK + th * 32, s = sb + r32;
    const char* wt = (const char*)(pwf + (size_t)g * 128 * 128); const unsigned l16 = (unsigned)lane * 16u;
    bf16x8 wfx[8], wfy[8];
#pragma unroll
    for (int t = 0; t < 8; ++t) wfx[t] = *(const bf16x8*)(wt + t * 1024 + l16);
#pragma unroll
    for (int t = 0; t < 8; ++t) wfy[t] = *(const bf16x8*)(wt + (8 + t) * 1024 + l16);
#pragma unroll
    for (int i = 0; i < 12; ++i) { const int r0 = 4 * i + (lane >> 4), r = r0 < 46 ? r0 : 46, piece = lane & 15, u = sb - 15 + r, uc = u > 0 ? u : 0;
        u32x4 w = *(const u32x4*)(proj + ((size_t)b * SEQ + uc) * NPROJ + g * 128 + piece * 8);
        if (u < 0) w = (u32x4){0u, 0u, 0u, 0u};
        *(LAS u32x4*)(wl + r * PROW + piece * 16) = w; }
    const int cnt = (s + 1 < W) ? (s + 1) : W; const float inv = 1.f / (float)cnt;
    const LAS unsigned char* rp0 = wl + (r32 + 15) * PROW + hi * 16;
    f32x16 acc[4];
#pragma unroll
    for (int db = 0; db < 4; ++db)
#pragma unroll
        for (int i = 0; i < 16; ++i) acc[db][i] = 0.f;
    const size_t row0 = (size_t)b * SEQ + sb;
    Gates g0, g1;
#pragma unroll
    for (int kp = 0; kp < 4; ++kp) {
#pragma unroll
        for (int k2 = 0; k2 < 2; ++k2) { const int ks = 2 * kp + k2;
            const bf16x8 df = pool_window<W>(rp0 + ks * 32, inv);
#pragma unroll
            for (int db = 0; db < 4; ++db) acc[db] = __builtin_amdgcn_mfma_f32_32x32x16_bf16((kp & 1) ? wfy[k2 * 4 + db] : wfx[k2 * 4 + db], df, acc[db], 0, 0, 0);
            __builtin_amdgcn_sched_barrier(0); }
        if (kp == 0) {
#pragma unroll
            for (int t = 0; t < 8; ++t) wfx[t] = *(const bf16x8*)(wt + (16 + t) * 1024 + l16);
        }
        if (kp == 1) {
#pragma unroll
            for (int t = 0; t < 8; ++t) wfy[t] = *(const bf16x8*)(wt + (24 + t) * 1024 + l16);
        }
        if (kp == 2) gate_load(g0, proj + row0 * NPROJ + (512 + g * 128), lane);
        __builtin_amdgcn_sched_barrier(0);
    }
    gate_load(g1, proj + row0 * NPROJ + (512 + g * 128 + 64), lane);
    epi_tile<true>(wl, acc[0], acc[1], 1.f, g0, Y + row0 * DM + g * 128, pool_scale + g * 128, lane);
    epi_tile<true>(wl, acc[2], acc[3], 1.f, g1, Y + row0 * DM + (g * 128 + 64), pool_scale + (g * 128 + 64), lane);
}
__device__ __forceinline__ void attn_unit(const bf16* proj, const bf16* KF, const bf16* VF, bf16* Y, const LAS float* tab, LAS unsigned char* wl, int b, int c, int h, int lane) {
    const int r32 = lane & 31, hi = lane >> 5;
    const int jstart = (c < 8) ? (8 - c) : 0;
    const char* kbase = (const char*)(KF + (size_t)(b * 8 + h) * 256 * 2048);
    const char* vbase = (const char*)(VF + (size_t)(b * 8 + h) * 256 * 2048);
    const unsigned l16 = (unsigned)lane * 16u;
#pragma unroll
    for (int qh = 0; qh < 2; ++qh) { const size_t rowq = (size_t)b * SEQ + c * CHUNK + qh * 32 + r32;
#pragma unroll
        for (int ds = 0; ds < 4; ++ds) { const bf16x8 q = *(const bf16x8*)(proj + rowq * NPROJ + 1024 + h * 64 + 16 * ds + 8 * hi); *(LAS bf16x8*)(wl + (qh * 4 + ds) * 1024 + l16) = q; } }
    bf16x8 kf[8];
    { const int kblk = (c - 8 + jstart) * 2;
#pragma unroll
        for (int t = 0; t < 8; ++t) kf[t] = *(const bf16x8*)(kbase + (size_t)kblk * 4096 + t * 1024 + l16); }
    float m[2] = {-1e30f, -1e30f}, l[2] = {0.f, 0.f}; f32x16 o[2][2];
#pragma unroll
    for (int qh = 0; qh < 2; ++qh)
#pragma unroll
        for (int db = 0; db < 2; ++db)
#pragma unroll
            for (int i = 0; i < 16; ++i) o[qh][db][i] = 0.f;
    for (int j = jstart; j <= 8; ++j) {
        const int kblk = (c - 8 + j) * 2;
        __builtin_amdgcn_sched_barrier(0);
        bf16x8 vf[8];
#pragma unroll
        for (int t = 0; t < 8; ++t) vf[t] = *(const bf16x8*)(vbase + (size_t)kblk * 4096 + t * 1024 + l16);
        __builtin_amdgcn_sched_barrier(0);
#pragma unroll
        for (int qh = 0; qh < 2; ++qh) {
            const int dq = 4 * hi - (qh * 32 + r32);
            f32x16 sc[2];
            { bf16x8 qf[4];
#pragma unroll
              for (int ds = 0; ds < 4; ++ds) qf[ds] = *(const LAS bf16x8*)(wl + (qh * 4 + ds) * 1024 + l16);
#pragma unroll
              for (int kb = 0; kb < 2; ++kb) {
#pragma unroll
                for (int i = 0; i < 16; ++i) sc[kb][i] = 0.f;
#pragma unroll
                for (int ds = 0; ds < 4; ++ds) sc[kb] = __builtin_amdgcn_mfma_f32_32x32x16_bf16(kf[kb * 4 + ds], qf[ds], sc[kb], 0, 0, 0);
              } }
            if (qh == 1) {
                __builtin_amdgcn_sched_barrier(0);
                if (j < 8) {
#pragma unroll
                    for (int t = 0; t < 8; ++t) kf[t] = *(const bf16x8*)(kbase + (size_t)(kblk + 2) * 4096 + t * 1024 + l16);
                }
                __builtin_amdgcn_sched_barrier(0);
            }
            const bool cb_tile = (j <= 6);
            if (!cb_tile) {
                const LAS float* tp = tab + ((j == 8) ? 64 : (129 + 63)) + dq;
#pragma unroll
                for (int kb = 0; kb < 2; ++kb)
#pragma unroll
                    for (int i = 0; i < 16; ++i) sc[kb][i] = sc[kb][i] * SCL + tp[32 * kb + (i & 3) + 8 * (i >> 2)];
            }
            float mt = sc[0][0];
#pragma unroll
            for (int kb = 0; kb < 2; ++kb)
#pragma unroll
                for (int i = 0; i < 16; ++i) mt = fmaxf(mt, sc[kb][i]);
            mt = xmax32(mt);
            const float b0 = tab[0];
            const float mts = cb_tile ? (mt * SCL + b0) : mt;
            if (__builtin_amdgcn_ballot_w64(mts > m[qh] + 8.0f) != 0ull) {
                const float mn = fmaxf(m[qh], mts); const float alpha = __builtin_amdgcn_exp2f(m[qh] - mn); m[qh] = mn; l[qh] *= alpha;
#pragma unroll
                for (int db = 0; db < 2; ++db)
#pragma unroll
                    for (int i = 0; i < 16; ++i) o[qh][db][i] *= alpha;
            }
            float ls = 0.f;
            if (cb_tile) { const float cb = b0 - m[qh];
#pragma unroll
                for (int kb = 0; kb < 2; ++kb)
#pragma unroll
                    for (int i = 0; i < 16; ++i) { const float p = __builtin_amdgcn_exp2f(sc[kb][i] * SCL + cb); sc[kb][i] = p; ls += p; }
            } else { const float mr = m[qh];
#pragma unroll
                for (int kb = 0; kb < 2; ++kb)
#pragma unroll
                    for (int i = 0; i < 16; ++i) { const float p = __builtin_amdgcn_exp2f(sc[kb][i] - mr); sc[kb][i] = p; ls += p; }
            }
            l[qh] += ls;
#pragma unroll
            for (int kb = 0; kb < 2; ++kb)
#pragma unroll
                for (int s2 = 0; s2 < 2; ++s2) {
                    u32x4 pw; pw.x = pkbf(sc[kb][8 * s2 + 0], sc[kb][8 * s2 + 1]); pw.y = pkbf(sc[kb][8 * s2 + 2], sc[kb][8 * s2 + 3]);
                    pw.z = pkbf(sc[kb][8 * s2 + 4], sc[kb][8 * s2 + 5]); pw.w = pkbf(sc[kb][8 * s2 + 6], sc[kb][8 * s2 + 7]);
                    const bf16x8 pf = __builtin_bit_cast(bf16x8, pw);
#pragma unroll
                    for (int db = 0; db < 2; ++db) o[qh][db] = __builtin_amdgcn_mfma_f32_32x32x16_bf16(vf[(kb * 2 + s2) * 2 + db], pf, o[qh][db], 0, 0, 0);
                }
        }
    }
    { const size_t row0 = (size_t)b * SEQ + c * CHUNK;
      Gates g0, g1;
      gate_load(g0, proj + row0 * NPROJ + (2560 + h * 64), lane);
      gate_load(g1, proj + (row0 + 32) * NPROJ + (2560 + h * 64), lane);
      const float inv0 = 1.f / xsum32(l[0]), inv1 = 1.f / xsum32(l[1]);
      epi_tile<false>(wl, o[0][0], o[0][1], inv0, g0, Y + row0 * DM + (512 + h * 64), nullptr, lane);
      epi_tile<false>(wl, o[1][0], o[1][1], inv1, g1, Y + (row0 + 32) * DM + (512 + h * 64), nullptr, lane); }
}

__global__ void __launch_bounds__(NWAVES * 64, 2) fwd_mega(Args a) {
    extern __shared__ __attribute__((aligned(16))) unsigned char lds[];
    cg::grid_group grid = cg::this_grid();
    const int wave = __builtin_amdgcn_readfirstlane((int)threadIdx.x >> 6);
    const int G = gridDim.x, bx = blockIdx.x; const int vcu = (G % 8 == 0) ? (bx % 8) * (G / 8) + bx / 8 : bx;
    unsigned char* ws = a.ws;
    bf16* WinT = (bf16*)(ws + WS_WINT); bf16* WoutT = (bf16*)(ws + WS_WOUTT); bf16* PoolWT = (bf16*)(ws + WS_POOLWT);
    float* part = (float*)(ws + WS_PART); bf16* XN = (bf16*)(ws + WS_XN); bf16* PROJ = (bf16*)(ws + WS_PROJ); bf16* VF = (bf16*)(ws + WS_VT); bf16* KF = (bf16*)(ws + WS_KF); bf16* Y = (bf16*)(ws + WS_Y);
    const int gw = vcu * NWAVES + wave, NGW = G * NWAVES;
    volatile LAS unsigned* xst = (volatile LAS unsigned*)((LAS unsigned char*)lds + 131072);
    if (threadIdx.x < 2) xst[threadIdx.x] = 0u;
    __syncthreads();
    const XcdBarrier xbar = xcd_barrier_post((unsigned*)ws, xst);

    {
        const int lane = lane_id();
        LAS float* scr = (LAS float*)((LAS unsigned char*)lds + wave * 16384);
        constexpr int I_IN = (DM / 64) * (NPROJ / 32), I_OUT = (DM / 64) * (DM / 32), I_PW = (128 / 64) * (128 / 32);
        constexpr int NITEMS = I_IN + I_OUT + 4 * I_PW;
        for (int it = gw; it < NITEMS; it += NGW) {
            int r = it;
            if (r < I_IN) { p0_transpose_item<false>(a.w_in, DM, NPROJ, WinT, scr, r, lane); continue; } r -= I_IN;
            if (r < I_OUT) { p0_transpose_item<false>(a.w_out, DM, DM, WoutT, scr, r, lane); continue; } r -= I_OUT;
            const int g = r / I_PW; r -= g * I_PW;
            p0_transpose_item<true>(a.pool_w + (size_t)g * 128 * 128, 128, 128, PoolWT + (size_t)g * 128 * 128, scr, r, lane);
        }
        f32x4 gv[4];
#pragma unroll
        for (int j = 0; j < 4; ++j) gv[j] = ((const f32x4*)a.norm_gain)[lane + 64 * j];
        for (int m0 = gw * 8; m0 < M; m0 += NGW * 8) {
            f32x4 v[8][4];
#pragma unroll
            for (int r = 0; r < 8; ++r) { const f32x4* xr = (const f32x4*)(a.x + (size_t)(m0 + r) * DM) + lane;
#pragma unroll
                for (int j = 0; j < 4; ++j) v[r][j] = __builtin_nontemporal_load(xr + 64 * j); }
#pragma unroll
            for (int r = 0; r < 8; ++r) { float ss = 0.f;
#pragma unroll
                for (int j = 0; j < 4; ++j) ss += (v[r][j][0] * v[r][j][0] + v[r][j][1] * v[r][j][1]) + (v[r][j][2] * v[r][j][2] + v[r][j][3] * v[r][j][3]);
                const float rstd = 1.0f / sqrtf(wave_sum(ss) * (1.f / DM) + EPS);
                unsigned long long* o8 = (unsigned long long*)(XN + (size_t)(m0 + r) * DM) + lane;
#pragma unroll
                for (int j = 0; j < 4; ++j) { const f32x4 t = v[r][j] * rstd * gv[j]; o8[64 * j] = (unsigned long long)pkbf(t[0], t[1]) | ((unsigned long long)pkbf(t[2], t[3]) << 32); } }
        }
    }
    if (a.ws == nullptr) grid.sync();
    xcd_barrier(xbar);

    {
        pg8::Gemm g{XN, WinT, M, NPROJ, DM}; pg8::StaticOrder S; S.init(M, NPROJ, G, bx);
        pg8::EpiProj E{PROJ, KF, VF};
        pg8::gemm_phase<pg8::EpiProj, pg8::StaticOrder, PG8_ALIGN, PG8_SP2>((PG8_LAS unsigned char*)lds, g, S, E, wave);
    }
    xcd_barrier(xbar);

    {
        LAS float* tab = (LAS float*)((LAS unsigned char*)lds + NWAVES * WREG);
        LAS unsigned char* wl = (LAS unsigned char*)lds + wave * WREG;
        const int lane = lane_id(), tid = wave * 64 + lane;
        for (int i = tid; i < 8 * 256; i += NWAVES * 64) { const int hh = i >> 8, e = i & 255;
            const int src_i = (e < 129) ? e : ((e - 129 - 63) > 0 ? (e - 129 - 63) : 0); tab[i] = a.rel_bias[hh * 129 + src_i] * LOG2E; }
        __syncthreads();
        for (int unit = vcu; unit < BATCH * NCHUNK; unit += G) {
            const int b = unit / NCHUNK, c = unit % NCHUNK;
            const int g = ((wave >> 1) + (unit / G)) & 3, th = wave & 1;
            int ln = lane; asm volatile("" : "+v"(ln));
            switch (g) {
                case 0: pool_unit<2>(PROJ, PoolWT, a.pool_scale, Y, wl, b, c, 0, th, ln); break;
                case 1: pool_unit<4>(PROJ, PoolWT, a.pool_scale, Y, wl, b, c, 1, th, ln); break;
                case 2: pool_unit<8>(PROJ, PoolWT, a.pool_scale, Y, wl, b, c, 2, th, ln); break;
                default: pool_unit<16>(PROJ, PoolWT, a.pool_scale, Y, wl, b, c, 3, th, ln); break;
            }
            asm volatile("" : "+v"(ln));
            attn_unit(PROJ, KF, VF, Y, tab + wave * 256, wl, b, c, wave, ln);
        }
    }
    xcd_barrier(xbar);

    {
        pg8::Gemm g{Y, WoutT, M, DM, DM}; pg8::StaticOrder S; S.init(M, DM, G, bx);
        pg8::EpiOut E{a.x, a.out, (unsigned long long*)(ws + 131072), a.fgain};
        pg8::gemm_phase<pg8::EpiOut, pg8::StaticOrder, PG8_ALIGN, PG8_SP2>((PG8_LAS unsigned char*)lds, g, S, E, wave);
    }
}

extern "C" void kernel_launch(void* const* d_in, const int* in_sizes, int n_in, void* d_out, int out_size, void* d_ws, size_t ws_size, hipStream_t stream) {
    static int grid = 0;
    if (grid == 0) {
        if (n_in != 8 || in_sizes[0] != M * DM || out_size != M * DM || ws_size < WS_END) { fprintf(stderr, "kernel_launch: unexpected shapes (n_in %d, in0 %d, out %d, ws %zu); nothing launched\n", n_in, n_in > 0 ? in_sizes[0] : -1, out_size, ws_size); grid = -1; return; }
        int dev = 0, cus = 0, per_cu = 0;
        if (hipGetDevice(&dev) != hipSuccess || hipDeviceGetAttribute(&cus, hipDeviceAttributeMultiprocessorCount, dev) != hipSuccess) { fprintf(stderr, "kernel_launch: device query failed\n"); grid = -1; return; }
        if (hipFuncSetAttribute((const void*)fwd_mega, hipFuncAttributeMaxDynamicSharedMemorySize, LDS_BYTES) != hipSuccess) { fprintf(stderr, "kernel_launch: hipFuncSetAttribute failed\n"); grid = -1; return; }
        if (hipOccupancyMaxActiveBlocksPerMultiprocessor(&per_cu, (const void*)fwd_mega, NWAVES * 64, LDS_BYTES) != hipSuccess || per_cu < 1) { fprintf(stderr, "kernel_launch: occupancy query gave %d blocks per CU\n", per_cu); (void)hipGetLastError(); grid = -1; return; }
        grid = cus * per_cu;
    }
    if (grid < 0) return;
    if (hipMemsetAsync(d_ws, 0, 131072 + 524288, stream) != hipSuccess) { fprintf(stderr, "kernel_launch: hipMemsetAsync failed\n"); return; }
    Args a{};
    a.x = (const float*)d_in[0]; a.norm_gain = (const float*)d_in[1]; a.w_in = (const float*)d_in[2]; a.pool_w = (const float*)d_in[3]; a.pool_scale = (const float*)d_in[4];
    a.rel_bias = (const float*)d_in[5]; a.w_out = (const float*)d_in[6]; a.fgain = (const float*)d_in[7]; a.out = (float*)d_out; a.ws = (unsigned char*)d_ws;
    void* args[] = {&a};
    hipError_t e = hipLaunchCooperativeKernel((const void*)fwd_mega, dim3(grid), dim3(NWAVES * 64), args, LDS_BYTES, stream);
    if (e != hipSuccess) fprintf(stderr, "kernel_launch: cooperative launch failed: %s (grid %d)\n", hipGetErrorString(e), grid);
}
```

```cpp
#include <hip/hip_runtime.h>
#include <hip/hip_cooperative_groups.h>
#include <cstdio>
#include <cstdint>
__device__ __forceinline__ float xsum32(float v) { auto rr = __builtin_amdgcn_permlane32_swap(__builtin_bit_cast(unsigned, v), __builtin_bit_cast(unsigned, v), false, false); return __builtin_bit_cast(float, (unsigned)rr[0]) + __builtin_bit_cast(float, (unsigned)rr[1]); }
__device__ __forceinline__ float xmax32(float v) { auto rr = __builtin_amdgcn_permlane32_swap(__builtin_bit_cast(unsigned, v), __builtin_bit_cast(unsigned, v), false, false); return fmaxf(__builtin_bit_cast(float, (unsigned)rr[0]), __builtin_bit_cast(float, (unsigned)rr[1])); }
__device__ __forceinline__ float xsum16(float v) { auto rr = __builtin_amdgcn_permlane16_swap(__builtin_bit_cast(unsigned, v), __builtin_bit_cast(unsigned, v), false, false); return __builtin_bit_cast(float, (unsigned)rr[0]) + __builtin_bit_cast(float, (unsigned)rr[1]); }
__device__ __forceinline__ unsigned lane_now() { unsigned z = 0u; asm volatile("" : "+s"(z)); return __builtin_amdgcn_mbcnt_hi(~0u, __builtin_amdgcn_mbcnt_lo(~0u, z)); }
namespace pg8 {
#define PG8_LAS __attribute__((address_space(3)))
typedef unsigned short bf16_t;
typedef short bf16x8 __attribute__((ext_vector_type(8)));
typedef float f32x4 __attribute__((ext_vector_type(4)));
typedef unsigned u32x4 __attribute__((ext_vector_type(4)));
constexpr int BM = 256, BK = 64, HALF = 128, HTB = HALF * BK * 2  , STAGE_BYTES = 8 * HTB, NXCD = 8, WGM = 8;

__host__ __device__ __forceinline__ int lds_byte(int r, int c) { const int st = (r >> 4) * 2 + (c >> 5), rr = r & 15, cc = c & 31, ob = rr * 64 + cc * 2; return st * 1024 + (ob ^ (((ob >> 9) & 1) << 5)); }
__host__ __device__ __forceinline__ void stage_rc(int b, int& R, int& C) { const int st = b / 1024, sb = b % 1024, swz = sb ^ (((sb >> 9) & 1) << 5); R = (st >> 1) * 16 + swz / 64; C = (st & 1) * 32 + (swz % 64) / 2; }
__host__ __device__ __forceinline__ int perm32(int rho) { const int n = rho >> 4, i = rho & 15; return 8 * (i >> 2) + 4 * n + (i & 3); }

struct Unit { int pm, pn; };
struct Gemm { const bf16_t* A; const bf16_t* Bt; int M, N, K; };

struct StaticOrder {
    int nM, nN, nwg, G, c;
    __host__ __device__ void init(int M, int N, int G_, int c_) { nM = M / BM; nN = N / BM; nwg = nM * nN; G = G_; c = c_; }
    __host__ __device__ bool next(int i, Unit& u) const {
        const long L = (long)i * G + c; if (L >= nwg) return false;
        int wgid = (int)L; { const int q = nwg / NXCD, r = nwg % NXCD, xcd = wgid % NXCD, off = wgid / NXCD; wgid = (xcd < r ? xcd * (q + 1) : r * (q + 1) + (xcd - r) * q) + off; }
        const int nig = WGM * nN, gid = wgid / nig, fm = gid * WGM, gsz = (nM - fm) < WGM ? (nM - fm) : WGM;
        u.pm = fm + ((wgid % nig) % gsz); u.pn = (wgid % nig) / gsz; return true;
    }
    __device__ __forceinline__ void a_ready(const Unit&) const {}
    __device__ __forceinline__ void done(const Unit&) const {}
};

__device__ __forceinline__ unsigned cvt_pk_bf16(float lo, float hi) { unsigned r; asm volatile("v_cvt_pk_bf16_f32 %0, %1, %2" : "=v"(r) : "v"(lo), "v"(hi)); return r; }
__device__ __forceinline__ unsigned short bf16_1(float v) { return (unsigned short)(cvt_pk_bf16(v, v) & 0xffffu); }
struct EpiProj {
    static constexpr bool PERM = true, AFTER_DRAIN = false;
    bf16_t* P; bf16_t* KF; bf16_t* VF;
    __device__ __forceinline__ void operator()(const f32x4 (&acc)[2][2][4][2], const Unit& u, int wr, int wc, int fr, int fq) const {
        const int row0 = u.pm * BM + wr * 64 + fr, col0 = u.pn * BM + wc * 32 + 8 * fq;
        if (u.pn == 6 || u.pn == 7) {
            const int b = row0 >> 13, s0 = row0 & 8191;
#pragma unroll
            for (int ai = 0; ai < 2; ++ai)
#pragma unroll
                for (int m = 0; m < 4; ++m) { const int s = s0 + ai * HALF + m * 16;
#pragma unroll
                    for (int bj = 0; bj < 2; ++bj) { const int ck = col0 - 1536 + bj * HALF, h = ck >> 6, d0 = ck & 63;
                        const size_t idx = ((((((size_t)(b * 8 + h) * 256 + (s >> 5)) * 4 + (d0 >> 4)) * 2 + ((d0 >> 3) & 1)) * 32 + (s & 31))) * 8;
                        const f32x4 v0 = acc[ai][bj][m][0], v1 = acc[ai][bj][m][1];
                        u32x4 w; w.x = cvt_pk_bf16(v0[0], v0[1]); w.y = cvt_pk_bf16(v0[2], v0[3]); w.z = cvt_pk_bf16(v1[0], v1[1]); w.w = cvt_pk_bf16(v1[2], v1[3]);
                        *(u32x4*)(KF + idx) = w; } }
        } else if (u.pn == 8 || u.pn == 9) {
            const int b = row0 >> 13, s0 = row0 & 8191;
#pragma unroll
            for (int ai = 0; ai < 2; ++ai)
#pragma unroll
                for (int m = 0; m < 4; ++m) { const int s = s0 + ai * HALF + m * 16;
                    const int sj = ((s >> 3) & 1) * 4 + (s & 3), shi = (s >> 2) & 1, ss2 = (s >> 4) & 1, sblk = s >> 5;
#pragma unroll
                    for (int bj = 0; bj < 2; ++bj) { const int cv = col0 - 2048 + bj * HALF, h = cv >> 6, d0 = cv & 63;
                        bf16_t* base = VF + (((((((size_t)(b * 8 + h) * 256 + sblk) * 2 + ss2) * 2 + (d0 >> 5)) * 2 + shi) * 32 + (d0 & 31))) * 8 + sj;
#pragma unroll
                        for (int n = 0; n < 2; ++n)
#pragma unroll
                            for (int e = 0; e < 4; ++e) base[(4 * n + e) * 8] = bf16_1(acc[ai][bj][m][n][e]); } }
        } else {
#pragma unroll
            for (int ai = 0; ai < 2; ++ai)
#pragma unroll
                for (int m = 0; m < 4; ++m) { bf16_t* rowp = P + (size_t)(row0 + ai * HALF + m * 16) * 3072 + col0;
#pragma unroll
                    for (int bj = 0; bj < 2; ++bj) { const f32x4 v0 = acc[ai][bj][m][0], v1 = acc[ai][bj][m][1];
                        u32x4 w; w.x = cvt_pk_bf16(v0[0], v0[1]); w.y = cvt_pk_bf16(v0[2], v0[3]); w.z = cvt_pk_bf16(v1[0], v1[1]); w.w = cvt_pk_bf16(v1[2], v1[3]);
                        *(u32x4*)(rowp + bj * HALF) = w; } }
        }
    }
};
struct EpiOut {
    static constexpr bool PERM = false, AFTER_DRAIN = false;
    const float* X; float* O; unsigned long long* rowacc; const float* gain;
    __device__ __forceinline__ void operator()(f32x4 (&acc)[2][2][4][2], const Unit& u, int wr, int wc, int fr, int fq) const {
        const int row0 = u.pm * BM + wr * 64 + fr, col0 = u.pn * BM + wc * 32 + 4 * fq;
#pragma unroll
        for (int ai = 0; ai < 2; ++ai)
#pragma unroll
            for (int m = 0; m < 4; ++m) { const int row = row0 + ai * HALF + m * 16; const size_t off = (size_t)row * 1024 + col0; float ss = 0.f;
#pragma unroll
                for (int bj = 0; bj < 2; ++bj)
#pragma unroll
                    for (int n = 0; n < 2; ++n) { const f32x4 xv = __builtin_nontemporal_load((const f32x4*)(X + off + bj * HALF + n * 16)); const f32x4 o = xv + acc[ai][bj][m][n];
                        acc[ai][bj][m][n] = o; ss += (o[0] * o[0] + o[1] * o[1]) + (o[2] * o[2] + o[3] * o[3]); }
                ss = xsum16(ss); ss = xsum32(ss);
                if (fq == 0) { const unsigned long long q = (unsigned long long)(ss * 1048576.0f + 0.5f);
                    (void)__hip_atomic_fetch_add(rowacc + row, (q << 8) | 1ull, __ATOMIC_RELAXED, __HIP_MEMORY_SCOPE_AGENT); } }
        f32x4 gv[2][2];
#pragma unroll
        for (int bj = 0; bj < 2; ++bj)
#pragma unroll
            for (int n = 0; n < 2; ++n) gv[bj][n] = *(const f32x4*)(gain + col0 + bj * HALF + n * 16);
        unsigned long long w[8];
        { unsigned sp = 0;
          for (;;) { bool ok = true;
#pragma unroll
              for (int t = 0; t < 8; ++t) { w[t] = __hip_atomic_load(rowacc + row0 + (t >> 2) * HALF + (t & 3) * 16, __ATOMIC_RELAXED, __HIP_MEMORY_SCOPE_AGENT); ok = ok && ((w[t] & 255ull) == 16ull); }
              if (__builtin_amdgcn_ballot_w64(!ok) == 0ull) break;
              __builtin_amdgcn_s_sleep(1); if (++sp > (1u << 20)) break; } }
#pragma unroll
        for (int ai = 0; ai < 2; ++ai)
#pragma unroll
            for (int m = 0; m < 4; ++m) { const int t = ai * 4 + m; const int row = row0 + ai * HALF + m * 16; const size_t off = (size_t)row * 1024 + col0;
                const float tot = (float)(w[t] >> 8) * (1.0f / 1048576.0f);
                const float rstd = 1.0f / sqrtf(tot * (1.f / 1024.f) + 1e-6f);
#pragma unroll
                for (int bj = 0; bj < 2; ++bj)
#pragma unroll
                    for (int n = 0; n < 2; ++n) *(f32x4*)(O + off + bj * HALF + n * 16) = acc[ai][bj][m][n] * rstd * gv[bj][n]; }
    }
};
template <class Epi, class Sched, bool ALIGN_EPI = false, bool SP2 = false>
__device__ __forceinline__ void gemm_phase(PG8_LAS unsigned char* lds, const Gemm g, const Sched& S, const Epi& E, int wave_in) {
    int wv_ = wave_in; asm volatile("" : "+s"(wv_));
    int tid_ = (int)lane_now() + 64 * wv_; asm volatile("" : "+v"(tid_));
    const int tid = tid_, wid = __builtin_amdgcn_readfirstlane(tid >> 6), lane = tid & 63, wr = wid >> 2, wc = wid & 3, fr = lane & 15, fq = lane >> 4;
    const int K = g.K, nt = K / BK;
    unsigned voffA[2], voffB[2];
#pragma unroll
    for (int i = 0; i < 2; ++i) { int R, C; stage_rc(tid * 16 + i * 8192, R, C); const int Rb = Epi::PERM ? ((R & ~31) + perm32(R & 31)) : R;
        voffA[i] = (unsigned)(R * K + C) * 2u; voffB[i] = (unsigned)(Rb * K + C) * 2u; }
    const size_t kstep = (size_t)(BK * 2);
    const size_t hstep = (size_t)HALF * K * 2;
    const size_t tstep = 2 * hstep;
    const unsigned ldsw = (unsigned)wid * 1024u;
    const int aoff = lds_byte(wr * 64 + fr, fq * 8), boff = lds_byte(wc * 32 + fr, fq * 8);
#define PG8_SA(b, h) (((b) * 2 + (h)) * HTB)
#define PG8_SB(b, h) ((4 + (b) * 2 + (h)) * HTB)
#define PG8_STAGE(bufoff, gbase, voff) do { _Pragma("unroll") for (int _i = 0; _i < 2; ++_i) \
        __builtin_amdgcn_global_load_lds((const unsigned*)((const char*)(gbase) + (voff)[_i]), (PG8_LAS unsigned*)(lds + (bufoff) + ldsw + _i * 8192), 16, 0, 0); } while (0)
#define PG8_LDA(dst, b, h) do { _Pragma("unroll") for (int m = 0; m < 4; ++m) _Pragma("unroll") for (int k = 0; k < 2; ++k) dst[m][k] = *(const PG8_LAS bf16x8*)(lds + PG8_SA(b, h) + aoff + m * 2048 + k * 1024); } while (0)
#define PG8_LDB(dst, b, h) do { _Pragma("unroll") for (int n = 0; n < 2; ++n) _Pragma("unroll") for (int k = 0; k < 2; ++k) dst[n][k] = *(const PG8_LAS bf16x8*)(lds + PG8_SB(b, h) + boff + n * 2048 + k * 1024); } while (0)
#define PG8_MMA(ai, bj, At, Bt) do { __builtin_amdgcn_s_setprio(1); _Pragma("unroll") for (int m = 0; m < 4; ++m) _Pragma("unroll") for (int n = 0; n < 2; ++n) _Pragma("unroll") for (int k = 0; k < 2; ++k) \
        acc[ai][bj][m][n] = __builtin_amdgcn_mfma_f32_16x16x32_bf16(Bt[n][k], At[m][k], acc[ai][bj][m][n], 0, 0, 0); __builtin_amdgcn_s_setprio(0); } while (0)
#define PG8_WAIT_V(n) asm volatile("s_waitcnt vmcnt(" #n ")" ::: "memory")
#define PG8_WAIT_L(n) asm volatile("s_waitcnt lgkmcnt(" #n ")" ::: "memory")
#define PG8_BAR __builtin_amdgcn_s_barrier()
#define PG8_SCHED __builtin_amdgcn_sched_barrier(0)
    Unit cur, nxt; int ui = 0;
    if (!S.next(0, cur)) return;
    f32x4 acc[2][2][4][2];
#pragma unroll
    for (int a = 0; a < 2; ++a)
#pragma unroll
        for (int b = 0; b < 2; ++b)
#pragma unroll
            for (int m = 0; m < 4; ++m)
#pragma unroll
                for (int n = 0; n < 2; ++n) acc[a][b][m][n] = (f32x4){0.f, 0.f, 0.f, 0.f};
    bf16x8 At[4][2], B0[2][2], B1[2][2];
    const char* cA = (const char*)g.A + (size_t)cur.pm * tstep; const char* cB = (const char*)g.Bt + (size_t)cur.pn * tstep;
    S.a_ready(cur);
    if constexpr (SP2) {
        PG8_STAGE(PG8_SB(0, 0), cB, voffB); PG8_STAGE(PG8_SB(0, 1), cB + hstep, voffB); PG8_STAGE(PG8_SA(0, 0), cA, voffA); PG8_STAGE(PG8_SA(0, 1), cA + hstep, voffA);
        if (wr == 1) PG8_BAR;
        PG8_WAIT_V(2); PG8_BAR;
        PG8_STAGE(PG8_SB(1, 0), cB + kstep, voffB); PG8_STAGE(PG8_SA(1, 0), cA + kstep, voffA); PG8_STAGE(PG8_SB(1, 1), cB + hstep + kstep, voffB);
        PG8_WAIT_V(6); PG8_BAR;
    } else {
        PG8_STAGE(PG8_SB(0, 0), cB, voffB); PG8_STAGE(PG8_SA(0, 0), cA, voffA); PG8_STAGE(PG8_SB(0, 1), cB + hstep, voffB); PG8_STAGE(PG8_SA(0, 1), cA + hstep, voffA);
        if (wr == 1) PG8_BAR;
        PG8_WAIT_V(4); PG8_BAR;
        PG8_STAGE(PG8_SB(1, 0), cB + kstep, voffB); PG8_STAGE(PG8_SA(1, 0), cA + kstep, voffA); PG8_STAGE(PG8_SB(1, 1), cB + hstep + kstep, voffB);
        PG8_WAIT_V(6); PG8_BAR;
    }
    for (;;) {
        const bool has_next = S.next(ui + 1, nxt);
        const char* nA = has_next ? (const char*)g.A + (size_t)nxt.pm * tstep : cA; const char* nB = has_next ? (const char*)g.Bt + (size_t)nxt.pn * tstep : cB;
        for (int t = 0; t < nt; t += 2) {
            const bool last = (t == nt - 2);
            const char* a1 = cA + (size_t)(t + 1) * kstep;
            const char* a2 = last ? nA : cA + (size_t)(t + 2) * kstep; const char* b2 = last ? nB : cB + (size_t)(t + 2) * kstep;
            const char* a3 = a2 + kstep; const char* b3 = b2 + kstep;
            if (last && has_next) S.a_ready(nxt);
            if constexpr (SP2) {
            PG8_LDB(B0, 0, 0); PG8_LDB(B1, 0, 1); PG8_SCHED; PG8_LDA(At, 0, 0); PG8_STAGE(PG8_SA(1, 1), a1 + hstep, voffA);
            PG8_WAIT_V(8); PG8_WAIT_L(0); PG8_BAR; PG8_MMA(0, 0, At, B0); PG8_MMA(0, 1, At, B1); PG8_BAR; PG8_SCHED;
            PG8_LDA(At, 0, 1); PG8_STAGE(PG8_SB(0, 0), b2, voffB); PG8_STAGE(PG8_SB(0, 1), b2 + hstep, voffB); PG8_STAGE(PG8_SA(0, 0), a2, voffA);
            PG8_WAIT_V(8); PG8_WAIT_L(0); PG8_BAR; PG8_MMA(1, 0, At, B0); PG8_MMA(1, 1, At, B1); PG8_BAR; PG8_SCHED;
            PG8_LDB(B0, 1, 0); PG8_LDB(B1, 1, 1); PG8_SCHED; PG8_LDA(At, 1, 0); PG8_STAGE(PG8_SA(0, 1), a2 + hstep, voffA);
            PG8_WAIT_V(8); PG8_WAIT_L(0); PG8_BAR; PG8_MMA(0, 0, At, B0); PG8_MMA(0, 1, At, B1); PG8_BAR; PG8_SCHED;
            PG8_LDA(At, 1, 1); PG8_STAGE(PG8_SB(1, 0), b3, voffB); PG8_STAGE(PG8_SB(1, 1), b3 + hstep, voffB); PG8_STAGE(PG8_SA(1, 0), a3, voffA);
            PG8_WAIT_V(8); PG8_WAIT_L(0); PG8_BAR; PG8_MMA(1, 0, At, B0); PG8_MMA(1, 1, At, B1); PG8_BAR; PG8_SCHED;
            } else {
            PG8_LDB(B0, 0, 0); PG8_SCHED; PG8_LDA(At, 0, 0); PG8_STAGE(PG8_SA(1, 1), a1 + hstep, voffA);
            PG8_WAIT_L(8); PG8_BAR; PG8_WAIT_L(0); PG8_MMA(0, 0, At, B0); PG8_BAR; PG8_SCHED;
            PG8_LDB(B1, 0, 1); PG8_STAGE(PG8_SB(0, 0), b2, voffB);
            PG8_BAR; PG8_WAIT_L(0); PG8_MMA(0, 1, At, B1); PG8_BAR;
            PG8_LDA(At, 0, 1); PG8_STAGE(PG8_SA(0, 0), a2, voffA);
            PG8_BAR; PG8_WAIT_L(0); PG8_MMA(1, 0, At, B0); PG8_BAR; PG8_SCHED;
            PG8_STAGE(PG8_SB(0, 1), b2 + hstep, voffB);
            PG8_WAIT_V(6); PG8_BAR; PG8_MMA(1, 1, At, B1); PG8_BAR;
            PG8_LDB(B0, 1, 0); PG8_SCHED; PG8_LDA(At, 1, 0); PG8_STAGE(PG8_SA(0, 1), a2 + hstep, voffA);
            PG8_WAIT_L(8); PG8_BAR; PG8_WAIT_L(0); PG8_MMA(0, 0, At, B0); PG8_BAR; PG8_SCHED;
            PG8_LDB(B1, 1, 1); PG8_STAGE(PG8_SB(1, 0), b3, voffB);
            PG8_BAR; PG8_WAIT_L(0); PG8_MMA(0, 1, At, B1); PG8_BAR;
            PG8_LDA(At, 1, 1); PG8_STAGE(PG8_SA(1, 0), a3, voffA);
            PG8_BAR; PG8_WAIT_L(0); PG8_MMA(1, 0, At, B0); PG8_BAR; PG8_SCHED;
            PG8_STAGE(PG8_SB(1, 1), b3 + hstep, voffB);
            PG8_WAIT_V(6); PG8_BAR; PG8_MMA(1, 1, At, B1); PG8_BAR;
            }
        }
        if constexpr (ALIGN_EPI) { if (wr == 0) PG8_BAR; }
        if constexpr (!Epi::AFTER_DRAIN) { E(acc, cur, wr, wc, fr, fq); S.done(cur); }
        if (!has_next) break;
#pragma unroll
        for (int a = 0; a < 2; ++a)
#pragma unroll
            for (int b = 0; b < 2; ++b)
#pragma unroll
                for (int m = 0; m < 4; ++m)
#pragma unroll
                    for (int n = 0; n < 2; ++n) acc[a][b][m][n] = (f32x4){0.f, 0.f, 0.f, 0.f};
        cur = nxt; cA = nA; cB = nB; ++ui;
        if constexpr (ALIGN_EPI) { if (wr == 1) PG8_BAR; }
    }
    PG8_WAIT_V(0);
    if constexpr (!ALIGN_EPI) { if (wr == 0) PG8_BAR; }
    PG8_BAR;
    if constexpr (Epi::AFTER_DRAIN) { E.fused(acc, cur, wr, wc, fr, fq, lds, wid, lane); S.done(cur); }
#undef PG8_SA
#undef PG8_SB
#undef PG8_STAGE
#undef PG8_LDA
#undef PG8_LDB
#undef PG8_MMA
#undef PG8_WAIT_V
#undef PG8_WAIT_L
#undef PG8_BAR
#undef PG8_SCHED
}
}
#ifndef PG8_SP2
#define PG8_SP2 true
#endif
#ifndef PG8_ALIGN
#define PG8_ALIGN true
#endif
namespace cg = cooperative_groups;
#define LAS __attribute__((address_space(3)))
typedef unsigned short bf16;
typedef float f32x4 __attribute__((ext_vector_type(4)));
typedef float f32x16 __attribute__((ext_vector_type(16)));
typedef short bf16x8 __attribute__((ext_vector_type(8)));
typedef unsigned u32x4 __attribute__((ext_vector_type(4)));
typedef unsigned u32x2 __attribute__((ext_vector_type(2)));

constexpr int NWAVES = 8;
constexpr int BATCH = 8, SEQ = 8192, DM = 1024, M = BATCH * SEQ, NPROJ = 3072, CHUNK = 64, NCHUNK = SEQ / CHUNK;
constexpr float EPS = 1e-6f, LOG2E = 1.4426950408889634f, SCL = 0.125f * 1.4426950408889634f;
constexpr size_t MiB = 1u << 20;
constexpr size_t WS_WINT = 1 * MiB, WS_WOUTT = 8 * MiB, WS_POOLWT = 10 * MiB, WS_PART = 12 * MiB, WS_XN = 16 * MiB, WS_PROJ = 144 * MiB, WS_VT = 528 * MiB, WS_Y = 592 * MiB, WS_KF = 720 * MiB, WS_END = 784 * MiB;
constexpr int LDS_BYTES = 147456;

__device__ __forceinline__ unsigned f2bf(float f) { unsigned u = __builtin_bit_cast(unsigned, f); return (u + 0x7fffu + ((u >> 16) & 1u)) >> 16; }
__device__ __forceinline__ unsigned pk2(float lo, float hi) { return f2bf(lo) | (f2bf(hi) << 16); }
typedef float f32x2_t __attribute__((ext_vector_type(2))); typedef __bf16 bf16x2_t __attribute__((ext_vector_type(2)));
__device__ __forceinline__ unsigned pkbf(float lo, float hi) { f32x2_t v = {lo, hi}; bf16x2_t b = __builtin_convertvector(v, bf16x2_t); return __builtin_bit_cast(unsigned, b); }
__device__ __forceinline__ float bf_lo(unsigned w) { return __builtin_bit_cast(float, w << 16); }
__device__ __forceinline__ float bf_hi(unsigned w) { return __builtin_bit_cast(float, w & 0xffff0000u); }
__device__ __forceinline__ float silu_f(float x) { return x * __builtin_amdgcn_rcpf(1.f + __builtin_amdgcn_exp2f(-x * LOG2E)); }
__device__ __forceinline__ float wave_sum(float v) {
#pragma unroll
    for (int o = 1; o < 64; o <<= 1) v += __shfl_xor(v, o);
    return v;
}

template <bool POOLF> __device__ __forceinline__ void p0_transpose_item(const float* W, int K, int N, bf16* WT, LAS float* scr, int item, int lane) {
    const int nblk = N / 32, kb = item / nblk, nb = item % nblk, k0 = 64 * kb, n0 = 32 * nb;
#pragma unroll 8
    for (int i = 0; i < 32; ++i) { const int kk = 2 * i + (lane >> 5); scr[kk * 33 + (lane & 31)] = W[(size_t)(k0 + kk) * N + n0 + (lane & 31)]; }
    asm volatile("s_waitcnt lgkmcnt(0)" ::: "memory");
    const int c = lane & 7;
#pragma unroll
    for (int j = 0; j < 4; ++j) { const int n = (lane >> 3) + 8 * j; const LAS float* s = scr + (8 * c) * 33 + n;
        u32x4 o; o.x = pk2(s[0 * 33], s[1 * 33]); o.y = pk2(s[2 * 33], s[3 * 33]); o.z = pk2(s[4 * 33], s[5 * 33]); o.w = pk2(s[6 * 33], s[7 * 33]);
        if (POOLF) { const int k = k0 + 8 * c, nn = n0 + n; *(u32x4*)(WT + (size_t)(((((k >> 4) * 4 + (nn >> 5)) * 2 + ((k >> 3) & 1)) * 32 + (nn & 31)) * 8)) = o; }
        else *(u32x4*)(WT + (size_t)(n0 + n) * K + k0 + 8 * c) = o; }
    asm volatile("s_waitcnt lgkmcnt(0)" ::: "memory");
}

typedef unsigned v4u __attribute__((ext_vector_type(4)));
#define XB_TMO      128
#define XB_XCNT(j)  (256  + 64 * (j))
#define XB_XSUB(j)  (1280 + 64 * (j))
#define XB_XGEN(j)  (2304 + 64 * (j))
#define XB_TOP      3328
#define XB_TOPGEN   3392
#define XCD_BAR_WORDS 3456
#define XB_SPIN_CAP (1u << 18)

__device__ __forceinline__ unsigned xb_ld(unsigned* p)              { return __hip_atomic_load(p, __ATOMIC_RELAXED, __HIP_MEMORY_SCOPE_AGENT); }
__device__ __forceinline__ unsigned xb_add(unsigned* p, unsigned v) { return __hip_atomic_fetch_add(p, v, __ATOMIC_RELAXED, __HIP_MEMORY_SCOPE_AGENT); }
__device__ __forceinline__ unsigned xb_xcc_id() { return (unsigned)__builtin_amdgcn_s_getreg((3 << 11) | 20) & 0xFu; }
#define XB_SPIN(cond, bar) do { unsigned _sp = 0; while (cond) { __builtin_amdgcn_s_sleep(1); \
    if ((++_sp & 255u) == 0u) { if (xb_ld(&(bar)[XB_TMO])) break; if (_sp > XB_SPIN_CAP) { atomicAdd(&(bar)[XB_TMO], 1u); break; } } } } while (0)

struct XcdBarrier {
    unsigned* bar; unsigned x;
    volatile LAS unsigned* st;
};

__device__ __forceinline__ XcdBarrier xcd_barrier_post(unsigned* bar, volatile LAS unsigned* st) {
    XcdBarrier b; b.bar = bar; b.x = xb_xcc_id(); b.st = st;
    if (threadIdx.x == 0) (void)xb_add(&bar[XB_XCNT(b.x)], 1u);
    return b;
}
__device__ __forceinline__ void xcd_barrier_complete(unsigned* bar, unsigned x, unsigned& nloc, unsigned& nx) {
    const unsigned G = gridDim.x * gridDim.y * gridDim.z;
    unsigned sum, cnt, mine, sp = 0u;
    for (;;) {
        sum = 0u; cnt = 0u; mine = 0u;
#pragma unroll
        for (unsigned j = 0; j < 16; ++j) { const unsigned c = xb_ld(&bar[XB_XCNT(j)]); sum += c; cnt += (c > 0u) ? 1u : 0u; mine = (j == x) ? c : mine; }
        if (sum == G) break;
        __builtin_amdgcn_s_sleep(1);
        if ((++sp & 255u) == 0u) { if (xb_ld(&bar[XB_TMO])) break; if (sp > XB_SPIN_CAP) { atomicAdd(&bar[XB_TMO], 1u); break; } }
    }
    nloc = mine > 0u ? mine : 1u; nx = cnt > 0u ? cnt : 1u;
}

__device__ __forceinline__ void xcd_barrier(const XcdBarrier& b) {
    asm volatile("s_waitcnt vmcnt(0)" ::: "memory");
    __syncthreads();
    if (threadIdx.x == 0) {
        unsigned* bar = b.bar;
        __builtin_amdgcn_s_waitcnt(0);
        unsigned nloc = b.st[0], nx = b.st[1];
        if (nloc == 0u) { xcd_barrier_complete(bar, b.x, nloc, nx); b.st[0] = nloc; b.st[1] = nx; }
        const unsigned old = xb_add(&bar[XB_XSUB(b.x)], 1u);
        const unsigned gen = old / nloc;
        if (old + 1u == (gen + 1u) * nloc) {
            __builtin_amdgcn_fence(__ATOMIC_RELEASE, "agent");
            asm volatile("s_waitcnt vmcnt(0)" ::: "memory");
            const unsigned og = xb_add(&bar[XB_TOP], 1u);
            const unsigned tg = og / nx;
            if (og + 1u == (tg + 1u) * nx) xb_add(&bar[XB_TOPGEN], 1u);
            else XB_SPIN(xb_ld(&bar[XB_TOPGEN]) == tg, bar);
            __builtin_amdgcn_fence(__ATOMIC_ACQUIRE, "agent");
            xb_add(&bar[XB_XGEN(b.x)], 1u);
            asm volatile("s_waitcnt vmcnt(0)" ::: "memory");
        } else {
            XB_SPIN(xb_ld(&bar[XB_XGEN(b.x)]) == gen, bar);
            __builtin_amdgcn_fence(__ATOMIC_ACQUIRE, "agent");
            asm volatile("s_waitcnt vmcnt(0)" ::: "memory");
        }
    }
    __syncthreads();
}

__device__ __forceinline__ int lane_id() { int l = (int)lane_now(); asm volatile("" : "+v"(l)); return l; }
struct Args { const float* x; const float* norm_gain; const float* w_in; const float* pool_w; const float* pool_scale; const float* rel_bias; const float* w_out; const float* fgain; float* out; unsigned char* ws; };

constexpr int PROW = 272;
constexpr int WREG = 12800;
__device__ __forceinline__ float max3f(float a, float b, float c) { float r; asm("v_max3_f32 %0, %1, %2, %3" : "=v"(r) : "v"(a), "v"(b), "v"(c)); return r; }
struct Gates { u32x2 g[8]; };
__device__ __forceinline__ void gate_load(Gates& G, const bf16* gbase, int lane) {
    int lo_ = lane; asm volatile("" : "+v"(lo_));
    const unsigned goff = (unsigned)((lo_ >> 4) * NPROJ + 4 * (lo_ & 15));
#pragma unroll
    for (int it = 0; it < 8; ++it) G.g[it] = *(const u32x2*)(gbase + (goff + (unsigned)(4 * it * NPROJ)));
}
template <bool SCALE> __device__ __forceinline__ void epi_tile(LAS unsigned char* wl, const f32x16& v0, const f32x16& v1, float mul, const Gates& G, bf16* ybase, const float* scale, int lane) {
    LAS unsigned char* wp = wl + (lane & 31) * PROW + (lane >> 5) * 16;
#pragma unroll
    for (int i4 = 0; i4 < 4; ++i4) {
        *(LAS f32x4*)(wp + i4 * 32) = (f32x4){v0[4 * i4] * mul, v0[4 * i4 + 1] * mul, v0[4 * i4 + 2] * mul, v0[4 * i4 + 3] * mul};
        *(LAS f32x4*)(wp + 128 + i4 * 32) = (f32x4){v1[4 * i4] * mul, v1[4 * i4 + 1] * mul, v1[4 * i4 + 2] * mul, v1[4 * i4 + 3] * mul};
    }
    int lo_ = lane; asm volatile("" : "+v"(lo_));
    const int rr = lo_ >> 4, piece = lo_ & 15;
    const unsigned yoff = (unsigned)(rr * DM + 4 * piece);
    f32x4 s = (f32x4){1.f, 1.f, 1.f, 1.f};
    if (SCALE) s = *(const f32x4*)(scale + 4 * piece);
#pragma unroll
    for (int it = 0; it < 8; ++it) { const int row = 4 * it + rr;
        const f32x4 x = *(const LAS f32x4*)(wl + row * PROW + piece * 16);
        const u32x2 gw = G.g[it];
        const float o0 = x[0] * s[0] * silu_f(bf_lo(gw.x)), o1 = x[1] * s[1] * silu_f(bf_hi(gw.x)), o2 = x[2] * s[2] * silu_f(bf_lo(gw.y)), o3 = x[3] * s[3] * silu_f(bf_hi(gw.y));
        u32x2 ow; ow.x = pkbf(o0, o1); ow.y = pkbf(o2, o3); *(u32x2*)(ybase + (yoff + (unsigned)(4 * it * DM))) = ow; }
}
template <int W> __device__ __forceinline__ bf16x8 pool_window(const LAS unsigned char* rp, float inv) {
    float sum[8], own[8];
#pragma unroll
    for (int e = 0; e < 8; ++e) { sum[e] = 0.f; own[e] = 0.f; }
#pragma unroll
    for (int i = 0; i < W; ++i) {
        const u32x4 w = *(const LAS u32x4*)(rp - i * PROW);
        const float f[8] = {bf_lo(w.x), bf_hi(w.x), bf_lo(w.y), bf_hi(w.y), bf_lo(w.z), bf_hi(w.z), bf_lo(w.w), bf_hi(w.w)};
#pragma unroll
        for (int e = 0; e < 8; ++e) { sum[e] += f[e]; if (i == 0) own[e] = f[e]; }
        if ((i & 3) == 3) __builtin_amdgcn_sched_barrier(0);
    }
    u32x4 o; o.x = pkbf(sum[0] * inv - own[0], sum[1] * inv - own[1]); o.y = pkbf(sum[2] * inv - own[2], sum[3] * inv - own[3]);
    o.z = pkbf(sum[4] * inv - own[4], sum[5] * inv - own[5]); o.w = pkbf(sum[6] * inv - own[6], sum[7] * inv - own[7]);
    return __builtin_bit_cast(bf16x8, o);
}
template <int W> __device__ __forceinline__ void pool_unit(const bf16* proj, const bf16* pwf, const float* pool_scale, bf16* Y, LAS unsigned char* wl, int b, int c, int g, int th, int lane, bf16x8 (&qpre)[8], int h) {
    const int r32 = lane & 31, hi = lane >> 5;
    const int sb = c * CHUNK + th * 32, s = sb + r32;
    const char* wt = (const char*)(pwf + (size_t)g * 128 * 128); const unsigned l16 = (unsigned)lane * 16u;
    bf16x8 wfx[8], wfy[8];
#pragma unroll
    for (int t = 0; t < 8; ++t) wfx[t] = *(const bf16x8*)(wt + t * 1024 + l16);
#pragma unroll
    for (int t = 0; t < 8; ++t) wfy[t] = *(const bf16x8*)(wt + (8 + t) * 1024 + l16);
#pragma unroll
    for (int i = 0; i < 12; ++i) { const int r0 = 4 * i + (lane >> 4), r = r0 < 46 ? r0 : 46, piece = lane & 15, u = sb - 15 + r, uc = u > 0 ? u : 0;
        u32x4 w = *(const u32x4*)(proj + ((size_t)b * SEQ + uc) * NPROJ + g * 128 + piece * 8);
        if (u < 0) w = (u32x4){0u, 0u, 0u, 0u};
        *(LAS u32x4*)(wl + r * PROW + piece * 16) = w; }
    const int cnt = (s + 1 < W) ? (s + 1) : W; const float inv = 1.f / (float)cnt;
    const LAS unsigned char* rp0 = wl + (r32 + 15) * PROW + hi * 16;
    f32x16 acc[4];
#pragma unroll
    for (int db = 0; db < 4; ++db)
#pragma unroll
        for (int i = 0; i < 16; ++i) acc[db][i] = 0.f;
    const size_t row0 = (size_t)b * SEQ + sb;
    Gates g0, g1;
#pragma unroll
    for (int kp = 0; kp < 4; ++kp) {
#pragma unroll
        for (int k2 = 0; k2 < 2; ++k2) { const int ks = 2 * kp + k2;
            const bf16x8 df = pool_window<W>(rp0 + ks * 32, inv);
#pragma unroll
            for (int db = 0; db < 4; ++db) acc[db] = __builtin_amdgcn_mfma_f32_32x32x16_bf16((kp & 1) ? wfy[k2 * 4 + db] : wfx[k2 * 4 + db], df, acc[db], 0, 0, 0);
            __builtin_amdgcn_sched_barrier(0); }
        if (kp == 0) {
#pragma unroll
            for (int t = 0; t < 8; ++t) wfx[t] = *(const bf16x8*)(wt + (16 + t) * 1024 + l16);
        }
        if (kp == 1) {
#pragma unroll
            for (int t = 0; t < 8; ++t) wfy[t] = *(const bf16x8*)(wt + (24 + t) * 1024 + l16);
        }
        if (kp == 2) { gate_load(g0, proj + row0 * NPROJ + (512 + g * 128), lane);
            int lq = lane; asm volatile("" : "+v"(lq));
            const bf16* qp = proj + ((size_t)b * SEQ + c * CHUNK + (lq & 31)) * NPROJ + (1024 + h * 64 + 8 * (lq >> 5));
#pragma unroll
            for (int t = 0; t < 8; ++t) qpre[t] = *(const bf16x8*)(qp + (unsigned)((t >> 2) * 32 * NPROJ + 16 * (t & 3))); }
        __builtin_amdgcn_sched_barrier(0);
    }
    gate_load(g1, proj + row0 * NPROJ + (512 + g * 128 + 64), lane);
    epi_tile<true>(wl, acc[0], acc[1], 1.f, g0, Y + row0 * DM + g * 128, pool_scale + g * 128, lane);
    epi_tile<true>(wl, acc[2], acc[3], 1.f, g1, Y + row0 * DM + (g * 128 + 64), pool_scale + (g * 128 + 64), lane);
}
__device__ __forceinline__ void attn_unit(const bf16* proj, const bf16* KF, const bf16* VF, bf16* Y, const LAS float* tab, LAS unsigned char* wl, int b, int c, int h, int lane, const bf16x8 (&qpre)[8]) {
    const int r32 = lane & 31, hi = lane >> 5;
    const int jstart = (c < 8) ? (8 - c) : 0;
    const char* kbase = (const char*)(KF + (size_t)(b * 8 + h) * 256 * 2048);
    const char* vbase = (const char*)(VF + (size_t)(b * 8 + h) * 256 * 2048);
    const unsigned l16 = (unsigned)lane * 16u;
#pragma unroll
    for (int t = 0; t < 8; ++t) *(LAS bf16x8*)(wl + t * 1024 + l16) = qpre[t];
    bf16x8 kf[8];
    { const int kblk = (c - 8 + jstart) * 2;
#pragma unroll
        for (int t = 0; t < 8; ++t) kf[t] = *(const bf16x8*)(kbase + (size_t)kblk * 4096 + t * 1024 + l16); }
    float m[2] = {-1e30f, -1e30f}, l[2] = {0.f, 0.f}; f32x16 o[2][2];
#pragma unroll
    for (int qh = 0; qh < 2; ++qh)
#pragma unroll
        for (int db = 0; db < 2; ++db)
#pragma unroll
            for (int i = 0; i < 16; ++i) o[qh][db][i] = 0.f;
    for (int j = jstart; j <= 8; ++j) {
        const int kblk = (c - 8 + j) * 2;
        __builtin_amdgcn_sched_barrier(0);
        bf16x8 vf[8];
#pragma unroll
        for (int t = 0; t < 8; ++t) vf[t] = *(const bf16x8*)(vbase + (size_t)kblk * 4096 + t * 1024 + l16);
        __builtin_amdgcn_sched_barrier(0);
#pragma unroll
        for (int qh = 0; qh < 2; ++qh) {
            const int dq = 4 * hi - (qh * 32 + r32);
            f32x16 sc[2];
            { bf16x8 qf[4];
#pragma unroll
              for (int ds = 0; ds < 4; ++ds) qf[ds] = *(const LAS bf16x8*)(wl + (qh * 4 + ds) * 1024 + l16);
#pragma unroll
              for (int kb = 0; kb < 2; ++kb) {
#pragma unroll
                for (int i = 0; i < 16; ++i) sc[kb][i] = 0.f;
#pragma unroll
                for (int ds = 0; ds < 4; ++ds) sc[kb] = __builtin_amdgcn_mfma_f32_32x32x16_bf16(kf[kb * 4 + ds], qf[ds], sc[kb], 0, 0, 0);
              }
              asm volatile("s_nop 15\n\ts_nop 7" : "+v"(sc[0]), "+v"(sc[1])); }
            if (qh == 1) {
                __builtin_amdgcn_sched_barrier(0);
                if (j < 8) {
#pragma unroll
                    for (int t = 0; t < 8; ++t) kf[t] = *(const bf16x8*)(kbase + (size_t)(kblk + 2) * 4096 + t * 1024 + l16);
                } else {
                    int lo_ = lane; asm volatile("" : "+v"(lo_));
                    const bf16* gb = proj + ((size_t)b * SEQ + c * CHUNK) * NPROJ + (2560 + h * 64) + (unsigned)((lo_ >> 4) * NPROJ + 4 * (lo_ & 15));
#pragma unroll
                    for (int t = 0; t < 8; ++t) {
                        const u32x2 ga = *(const u32x2*)(gb + (unsigned)((8 * t) * NPROJ)), gc = *(const u32x2*)(gb + (unsigned)((8 * t + 4) * NPROJ));
                        u32x4 w; w.x = ga.x; w.y = ga.y; w.z = gc.x; w.w = gc.y; kf[t] = __builtin_bit_cast(bf16x8, w); }
                }
                __builtin_amdgcn_sched_barrier(0);
            }
            const bool cb_tile = (j <= 6);
            if (!cb_tile) {
                const LAS float* tp = tab + ((j == 8) ? 64 : (129 + 63)) + dq;
#pragma unroll
                for (int kb = 0; kb < 2; ++kb)
#pragma unroll
                    for (int i = 0; i < 16; ++i) sc[kb][i] = sc[kb][i] * SCL + tp[32 * kb + (i & 3) + 8 * (i >> 2)];
            }
            float mt;
            { float ma = max3f(sc[0][0], sc[0][1], sc[0][2]), mb = max3f(sc[1][0], sc[1][1], sc[1][2]);
#pragma unroll
              for (int i = 3; i < 15; i += 2) { ma = max3f(ma, sc[0][i], sc[0][i + 1]); mb = max3f(mb, sc[1][i], sc[1][i + 1]); }
              mt = max3f(ma, mb, sc[0][15]); mt = max3f(mt, sc[1][15], sc[1][15]); }
            mt = xmax32(mt);
            const float b0 = tab[0];
            const float mts = cb_tile ? (mt * SCL + b0) : mt;
            if (__builtin_amdgcn_ballot_w64(mts > m[qh] + 8.0f) != 0ull) {
                const float mn = fmaxf(m[qh], mts); const float alpha = __builtin_amdgcn_exp2f(m[qh] - mn); m[qh] = mn; l[qh] *= alpha;
#pragma unroll
                for (int db = 0; db < 2; ++db)
#pragma unroll
                    for (int i = 0; i < 16; ++i) o[qh][db][i] *= alpha;
            }
            float ls = 0.f;
            if (cb_tile) { const float cb = b0 - m[qh];
#pragma unroll
                for (int kb = 0; kb < 2; ++kb)
#pragma unroll
                    for (int i = 0; i < 16; ++i) { const float p = __builtin_amdgcn_exp2f(sc[kb][i] * SCL + cb); sc[kb][i] = p; ls += p; }
            } else { const float mr = m[qh];
#pragma unroll
                for (int kb = 0; kb < 2; ++kb)
#pragma unroll
                    for (int i = 0; i < 16; ++i) { const float p = __builtin_amdgcn_exp2f(sc[kb][i] - mr); sc[kb][i] = p; ls += p; }
            }
            l[qh] += ls;
#pragma unroll
            for (int kb = 0; kb < 2; ++kb)
#pragma unroll
                for (int s2 = 0; s2 < 2; ++s2) {
                    u32x4 pw; pw.x = pkbf(sc[kb][8 * s2 + 0], sc[kb][8 * s2 + 1]); pw.y = pkbf(sc[kb][8 * s2 + 2], sc[kb][8 * s2 + 3]);
                    pw.z = pkbf(sc[kb][8 * s2 + 4], sc[kb][8 * s2 + 5]); pw.w = pkbf(sc[kb][8 * s2 + 6], sc[kb][8 * s2 + 7]);
                    const bf16x8 pf = __builtin_bit_cast(bf16x8, pw);
#pragma unroll
                    for (int db = 0; db < 2; ++db) o[qh][db] = __builtin_amdgcn_mfma_f32_32x32x16_bf16(vf[(kb * 2 + s2) * 2 + db], pf, o[qh][db], 0, 0, 0);
                }
        }
    }
    { const size_t row0 = (size_t)b * SEQ + c * CHUNK;
      Gates g0, g1;
#pragma unroll
      for (int t = 0; t < 4; ++t) { const u32x4 w0 = __builtin_bit_cast(u32x4, kf[t]), w1 = __builtin_bit_cast(u32x4, kf[4 + t]);
          g0.g[2 * t] = (u32x2){w0.x, w0.y}; g0.g[2 * t + 1] = (u32x2){w0.z, w0.w}; g1.g[2 * t] = (u32x2){w1.x, w1.y}; g1.g[2 * t + 1] = (u32x2){w1.z, w1.w}; }
      const float inv0 = 1.f / xsum32(l[0]), inv1 = 1.f / xsum32(l[1]);
      epi_tile<false>(wl, o[0][0], o[0][1], inv0, g0, Y + row0 * DM + (512 + h * 64), nullptr, lane);
      epi_tile<false>(wl, o[1][0], o[1][1], inv1, g1, Y + (row0 + 32) * DM + (512 + h * 64), nullptr, lane); }
}

__global__ void __launch_bounds__(NWAVES * 64, 2) fwd_mega(Args a) {
    extern __shared__ __attribute__((aligned(16))) unsigned char lds[];
    cg::grid_group grid = cg::this_grid();
    const int wave = __builtin_amdgcn_readfirstlane((int)threadIdx.x >> 6);
    const int G = gridDim.x, bx = blockIdx.x; const int vcu = (G % 8 == 0) ? (bx % 8) * (G / 8) + bx / 8 : bx;
    unsigned char* ws = a.ws;
    bf16* WinT = (bf16*)(ws + WS_WINT); bf16* WoutT = (bf16*)(ws + WS_WOUTT); bf16* PoolWT = (bf16*)(ws + WS_POOLWT);
    float* part = (float*)(ws + WS_PART); bf16* XN = (bf16*)(ws + WS_XN); bf16* PROJ = (bf16*)(ws + WS_PROJ); bf16* VF = (bf16*)(ws + WS_VT); bf16* KF = (bf16*)(ws + WS_KF); bf16* Y = (bf16*)(ws + WS_Y);
    const int gw = vcu * NWAVES + wave, NGW = G * NWAVES;
    volatile LAS unsigned* xst = (volatile LAS unsigned*)((LAS unsigned char*)lds + 131072);
    if (threadIdx.x < 2) xst[threadIdx.x] = 0u;
    __syncthreads();
    const XcdBarrier xbar = xcd_barrier_post((unsigned*)ws, xst);

    {
        const int lane = lane_id();
        LAS float* scr = (LAS float*)((LAS unsigned char*)lds + wave * 16384);
        constexpr int I_IN = (DM / 64) * (NPROJ / 32), I_OUT = (DM / 64) * (DM / 32), I_PW = (128 / 64) * (128 / 32);
        constexpr int NITEMS = I_IN + I_OUT + 4 * I_PW;
        for (int it = gw; it < NITEMS; it += NGW) {
            int r = it;
            if (r < I_IN) { p0_transpose_item<false>(a.w_in, DM, NPROJ, WinT, scr, r, lane); continue; } r -= I_IN;
            if (r < I_OUT) { p0_transpose_item<false>(a.w_out, DM, DM, WoutT, scr, r, lane); continue; } r -= I_OUT;
            const int g = r / I_PW; r -= g * I_PW;
            p0_transpose_item<true>(a.pool_w + (size_t)g * 128 * 128, 128, 128, PoolWT + (size_t)g * 128 * 128, scr, r, lane);
        }
        f32x4 gv[4];
#pragma unroll
        for (int j = 0; j < 4; ++j) gv[j] = ((const f32x4*)a.norm_gain)[lane + 64 * j];
        for (int m0 = gw * 8; m0 < M; m0 += NGW * 8) {
            f32x4 v[8][4];
#pragma unroll
            for (int r = 0; r < 8; ++r) { const f32x4* xr = (const f32x4*)(a.x + (size_t)(m0 + r) * DM) + lane;
#pragma unroll
                for (int j = 0; j < 4; ++j) v[r][j] = __builtin_nontemporal_load(xr + 64 * j); }
#pragma unroll
            for (int r = 0; r < 8; ++r) { float ss = 0.f;
#pragma unroll
                for (int j = 0; j < 4; ++j) ss += (v[r][j][0] * v[r][j][0] + v[r][j][1] * v[r][j][1]) + (v[r][j][2] * v[r][j][2] + v[r][j][3] * v[r][j][3]);
                const float rstd = 1.0f / sqrtf(wave_sum(ss) * (1.f / DM) + EPS);
                unsigned long long* o8 = (unsigned long long*)(XN + (size_t)(m0 + r) * DM) + lane;
#pragma unroll
                for (int j = 0; j < 4; ++j) { const f32x4 t = v[r][j] * rstd * gv[j]; o8[64 * j] = (unsigned long long)pkbf(t[0], t[1]) | ((unsigned long long)pkbf(t[2], t[3]) << 32); } }
        }
    }
    if (a.ws == nullptr) grid.sync();
    xcd_barrier(xbar);

    {
        pg8::Gemm g{XN, WinT, M, NPROJ, DM}; pg8::StaticOrder S; S.init(M, NPROJ, G, bx);
        pg8::EpiProj E{PROJ, KF, VF};
        pg8::gemm_phase<pg8::EpiProj, pg8::StaticOrder, PG8_ALIGN, PG8_SP2>((PG8_LAS unsigned char*)lds, g, S, E, wave);
    }
    xcd_barrier(xbar);

    {
        LAS float* tab = (LAS float*)((LAS unsigned char*)lds + NWAVES * WREG);
        LAS unsigned char* wl = (LAS unsigned char*)lds + wave * WREG;
        const int lane = lane_id(), tid = wave * 64 + lane;
        for (int i = tid; i < 8 * 256; i += NWAVES * 64) { const int hh = i >> 8, e = i & 255;
            const int src_i = (e < 129) ? e : ((e - 129 - 63) > 0 ? (e - 129 - 63) : 0); tab[i] = a.rel_bias[hh * 129 + src_i] * LOG2E; }
        __syncthreads();
        for (int unit = vcu; unit < BATCH * NCHUNK; unit += G) {
            const int b = unit / NCHUNK, c = unit % NCHUNK;
            const int g = ((wave >> 1) + (unit / G)) & 3, th = wave & 1;
            int ln = lane; asm volatile("" : "+v"(ln));
            bf16x8 qpre[8];
            switch (g) {
                case 0: pool_unit<2>(PROJ, PoolWT, a.pool_scale, Y, wl, b, c, 0, th, ln, qpre, wave); break;
                case 1: pool_unit<4>(PROJ, PoolWT, a.pool_scale, Y, wl, b, c, 1, th, ln, qpre, wave); break;
                case 2: pool_unit<8>(PROJ, PoolWT, a.pool_scale, Y, wl, b, c, 2, th, ln, qpre, wave); break;
                default: pool_unit<16>(PROJ, PoolWT, a.pool_scale, Y, wl, b, c, 3, th, ln, qpre, wave); break;
            }
            asm volatile("" : "+v"(ln));
            attn_unit(PROJ, KF, VF, Y, tab + wave * 256, wl, b, c, wave, ln, qpre);
        }
    }
    xcd_barrier(xbar);

    {
        pg8::Gemm g{Y, WoutT, M, DM, DM}; pg8::StaticOrder S; S.init(M, DM, G, bx);
        pg8::EpiOut E{a.x, a.out, (unsigned long long*)(ws + 131072), a.fgain};
        pg8::gemm_phase<pg8::EpiOut, pg8::StaticOrder, PG8_ALIGN, PG8_SP2>((PG8_LAS unsigned char*)lds, g, S, E, wave);
    }
}

extern "C" void kernel_launch(void* const* d_in, const int* in_sizes, int n_in, void* d_out, int out_size, void* d_ws, size_t ws_size, hipStream_t stream) {
    static int grid = 0;
    if (grid == 0) {
        if (n_in != 8 || in_sizes[0] != M * DM || out_size != M * DM || ws_size < WS_END) { fprintf(stderr, "kernel_launch: unexpected shapes (n_in %d, in0 %d, out %d, ws %zu); nothing launched\n", n_in, n_in > 0 ? in_sizes[0] : -1, out_size, ws_size); grid = -1; return; }
        int dev = 0, cus = 0, per_cu = 0;
        if (hipGetDevice(&dev) != hipSuccess || hipDeviceGetAttribute(&cus, hipDeviceAttributeMultiprocessorCount, dev) != hipSuccess) { fprintf(stderr, "kernel_launch: device query failed\n"); grid = -1; return; }
        if (hipFuncSetAttribute((const void*)fwd_mega, hipFuncAttributeMaxDynamicSharedMemorySize, LDS_BYTES) != hipSuccess) { fprintf(stderr, "kernel_launch: hipFuncSetAttribute failed\n"); grid = -1; return; }
        if (hipOccupancyMaxActiveBlocksPerMultiprocessor(&per_cu, (const void*)fwd_mega, NWAVES * 64, LDS_BYTES) != hipSuccess || per_cu < 1) { fprintf(stderr, "kernel_launch: occupancy query gave %d blocks per CU\n", per_cu); (void)hipGetLastError(); grid = -1; return; }
        grid = cus * per_cu;
    }
    if (grid < 0) return;
    if (hipMemsetAsync(d_ws, 0, 131072 + 524288, stream) != hipSuccess) { fprintf(stderr, "kernel_launch: hipMemsetAsync failed\n"); return; }
    Args a{};
    a.x = (const float*)d_in[0]; a.norm_gain = (const float*)d_in[1]; a.w_in = (const float*)d_in[2]; a.pool_w = (const float*)d_in[3]; a.pool_scale = (const float*)d_in[4];
    a.rel_bias = (const float*)d_in[5]; a.w_out = (const float*)d_in[6]; a.fgain = (const float*)d_in[7]; a.out = (float*)d_out; a.ws = (unsigned char*)d_ws;
    void* args[] = {&a};
    hipError_t e = hipLaunchCooperativeKernel((const void*)fwd_mega, dim3(grid), dim3(NWAVES * 64), args, LDS_BYTES, stream);
    if (e != hipSuccess) fprintf(stderr, "kernel_launch: cooperative launch failed: %s (grid %d)\n", hipGetErrorString(e), grid);
}
```

```cpp
#include <hip/hip_runtime.h>
#include <hip/hip_cooperative_groups.h>
#include <cstdio>
#include <cstdint>
__device__ __forceinline__ float xsum32(float v) { auto rr = __builtin_amdgcn_permlane32_swap(__builtin_bit_cast(unsigned, v), __builtin_bit_cast(unsigned, v), false, false); return __builtin_bit_cast(float, (unsigned)rr[0]) + __builtin_bit_cast(float, (unsigned)rr[1]); }
__device__ __forceinline__ float xmax32(float v) { auto rr = __builtin_amdgcn_permlane32_swap(__builtin_bit_cast(unsigned, v), __builtin_bit_cast(unsigned, v), false, false); return fmaxf(__builtin_bit_cast(float, (unsigned)rr[0]), __builtin_bit_cast(float, (unsigned)rr[1])); }
__device__ __forceinline__ float xsum16(float v) { auto rr = __builtin_amdgcn_permlane16_swap(__builtin_bit_cast(unsigned, v), __builtin_bit_cast(unsigned, v), false, false); return __builtin_bit_cast(float, (unsigned)rr[0]) + __builtin_bit_cast(float, (unsigned)rr[1]); }
__device__ __forceinline__ unsigned lane_now() { unsigned z = 0u; asm volatile("" : "+s"(z)); return __builtin_amdgcn_mbcnt_hi(~0u, __builtin_amdgcn_mbcnt_lo(~0u, z)); }
namespace pg8 {
#define PG8_LAS __attribute__((address_space(3)))
typedef unsigned short bf16_t;
typedef short bf16x8 __attribute__((ext_vector_type(8)));
typedef float f32x4 __attribute__((ext_vector_type(4)));
typedef unsigned u32x4 __attribute__((ext_vector_type(4)));
constexpr int BM = 256, BK = 64, HALF = 128, HTB = HALF * BK * 2  , STAGE_BYTES = 8 * HTB, NXCD = 8, WGM = 8;

__host__ __device__ __forceinline__ int lds_byte(int r, int c) { const int st = (r >> 4) * 2 + (c >> 5), rr = r & 15, cc = c & 31, ob = rr * 64 + cc * 2; return st * 1024 + (ob ^ (((ob >> 9) & 1) << 5)); }
__host__ __device__ __forceinline__ void stage_rc(int b, int& R, int& C) { const int st = b / 1024, sb = b % 1024, swz = sb ^ (((sb >> 9) & 1) << 5); R = (st >> 1) * 16 + swz / 64; C = (st & 1) * 32 + (swz % 64) / 2; }
__host__ __device__ __forceinline__ int perm32(int rho) { const int n = rho >> 4, i = rho & 15; return 8 * (i >> 2) + 4 * n + (i & 3); }

struct Unit { int pm, pn; };
struct Gemm { const bf16_t* A; const bf16_t* Bt; int M, N, K; };

struct StaticOrder {
    int nM, nN, nwg, G, c;
    __host__ __device__ void init(int M, int N, int G_, int c_) { nM = M / BM; nN = N / BM; nwg = nM * nN; G = G_; c = c_; }
    __host__ __device__ bool next(int i, Unit& u) const {
        const long L = (long)i * G + c; if (L >= nwg) return false;
        int wgid = (int)L; { const int q = nwg / NXCD, r = nwg % NXCD, xcd = wgid % NXCD, off = wgid / NXCD; wgid = (xcd < r ? xcd * (q + 1) : r * (q + 1) + (xcd - r) * q) + off; }
        const int nig = WGM * nN, gid = wgid / nig, fm = gid * WGM, gsz = (nM - fm) < WGM ? (nM - fm) : WGM;
        u.pm = fm + ((wgid % nig) % gsz); u.pn = (wgid % nig) / gsz; return true;
    }
    __device__ __forceinline__ void a_ready(const Unit&) const {}
    __device__ __forceinline__ void done(const Unit&) const {}
};

__device__ __forceinline__ unsigned cvt_pk_bf16(float lo, float hi) { unsigned r; asm volatile("v_cvt_pk_bf16_f32 %0, %1, %2" : "=v"(r) : "v"(lo), "v"(hi)); return r; }
__device__ __forceinline__ unsigned short bf16_1(float v) { return (unsigned short)(cvt_pk_bf16(v, v) & 0xffffu); }
struct EpiProj {
    static constexpr bool PERM = true, AFTER_DRAIN = false;
    bf16_t* P; bf16_t* KF; bf16_t* VF;
    __device__ __forceinline__ void operator()(const f32x4 (&acc)[2][2][4][2], const Unit& u, int wr, int wc, int fr, int fq) const {
        const int row0 = u.pm * BM + wr * 64 + fr, col0 = u.pn * BM + wc * 32 + 8 * fq;
        if (u.pn == 6 || u.pn == 7) {
            const int b = row0 >> 13, s0 = row0 & 8191;
#pragma unroll
            for (int ai = 0; ai < 2; ++ai)
#pragma unroll
                for (int m = 0; m < 4; ++m) { const int s = s0 + ai * HALF + m * 16;
#pragma unroll
                    for (int bj = 0; bj < 2; ++bj) { const int ck = col0 - 1536 + bj * HALF, h = ck >> 6, d0 = ck & 63;
                        const size_t idx = ((((((size_t)(b * 8 + h) * 256 + (s >> 5)) * 4 + (d0 >> 4)) * 2 + ((d0 >> 3) & 1)) * 32 + (s & 31))) * 8;
                        const f32x4 v0 = acc[ai][bj][m][0], v1 = acc[ai][bj][m][1];
                        u32x4 w; w.x = cvt_pk_bf16(v0[0], v0[1]); w.y = cvt_pk_bf16(v0[2], v0[3]); w.z = cvt_pk_bf16(v1[0], v1[1]); w.w = cvt_pk_bf16(v1[2], v1[3]);
                        *(u32x4*)(KF + idx) = w; } }
        } else if (u.pn == 8 || u.pn == 9) {
            const int b = row0 >> 13, s0 = row0 & 8191;
#pragma unroll
            for (int ai = 0; ai < 2; ++ai)
#pragma unroll
                for (int m = 0; m < 4; ++m) { const int s = s0 + ai * HALF + m * 16;
                    const int sj = ((s >> 3) & 1) * 4 + (s & 3), shi = (s >> 2) & 1, ss2 = (s >> 4) & 1, sblk = s >> 5;
#pragma unroll
                    for (int bj = 0; bj < 2; ++bj) { const int cv = col0 - 2048 + bj * HALF, h = cv >> 6, d0 = cv & 63;
                        bf16_t* base = VF + (((((((size_t)(b * 8 + h) * 256 + sblk) * 2 + ss2) * 2 + (d0 >> 5)) * 2 + shi) * 32 + (d0 & 31))) * 8 + sj;
#pragma unroll
                        for (int n = 0; n < 2; ++n)
#pragma unroll
                            for (int e = 0; e < 4; ++e) base[(4 * n + e) * 8] = bf16_1(acc[ai][bj][m][n][e]); } }
        } else {
#pragma unroll
            for (int ai = 0; ai < 2; ++ai)
#pragma unroll
                for (int m = 0; m < 4; ++m) { bf16_t* rowp = P + (size_t)(row0 + ai * HALF + m * 16) * 3072 + col0;
#pragma unroll
                    for (int bj = 0; bj < 2; ++bj) { const f32x4 v0 = acc[ai][bj][m][0], v1 = acc[ai][bj][m][1];
                        u32x4 w; w.x = cvt_pk_bf16(v0[0], v0[1]); w.y = cvt_pk_bf16(v0[2], v0[3]); w.z = cvt_pk_bf16(v1[0], v1[1]); w.w = cvt_pk_bf16(v1[2], v1[3]);
                        *(u32x4*)(rowp + bj * HALF) = w; } }
        }
    }
};
struct EpiOut {
    static constexpr bool PERM = false, AFTER_DRAIN = false;
    const float* X; float* O; unsigned long long* rowacc; const float* gain;
    __device__ __forceinline__ void operator()(f32x4 (&acc)[2][2][4][2], const Unit& u, int wr, int wc, int fr, int fq) const {
        const int row0 = u.pm * BM + wr * 64 + fr, col0 = u.pn * BM + wc * 32 + 4 * fq;
#pragma unroll
        for (int ai = 0; ai < 2; ++ai)
#pragma unroll
            for (int m = 0; m < 4; ++m) { const int row = row0 + ai * HALF + m * 16; const size_t off = (size_t)row * 1024 + col0; float ss = 0.f;
#pragma unroll
                for (int bj = 0; bj < 2; ++bj)
#pragma unroll
                    for (int n = 0; n < 2; ++n) { const f32x4 xv = __builtin_nontemporal_load((const f32x4*)(X + off + bj * HALF + n * 16)); const f32x4 o = xv + acc[ai][bj][m][n];
                        acc[ai][bj][m][n] = o; ss += (o[0] * o[0] + o[1] * o[1]) + (o[2] * o[2] + o[3] * o[3]); }
                ss = xsum16(ss); ss = xsum32(ss);
                if (fq == 0) { const unsigned long long q = (unsigned long long)(ss * 1048576.0f + 0.5f);
                    (void)__hip_atomic_fetch_add(rowacc + row, (q << 8) | 1ull, __ATOMIC_RELAXED, __HIP_MEMORY_SCOPE_AGENT); } }
        f32x4 gv[2][2];
#pragma unroll
        for (int bj = 0; bj < 2; ++bj)
#pragma unroll
            for (int n = 0; n < 2; ++n) gv[bj][n] = *(const f32x4*)(gain + col0 + bj * HALF + n * 16);
        unsigned long long w[8];
        { unsigned sp = 0;
          for (;;) { bool ok = true;
#pragma unroll
              for (int t = 0; t < 8; ++t) { w[t] = __hip_atomic_load(rowacc + row0 + (t >> 2) * HALF + (t & 3) * 16, __ATOMIC_RELAXED, __HIP_MEMORY_SCOPE_AGENT); ok = ok && ((w[t] & 255ull) == 16ull); }
              if (__builtin_amdgcn_ballot_w64(!ok) == 0ull) break;
              __builtin_amdgcn_s_sleep(1); if (++sp > (1u << 20)) break; } }
#pragma unroll
        for (int ai = 0; ai < 2; ++ai)
#pragma unroll
            for (int m = 0; m < 4; ++m) { const int t = ai * 4 + m; const int row = row0 + ai * HALF + m * 16; const size_t off = (size_t)row * 1024 + col0;
                const float tot = (float)(w[t] >> 8) * (1.0f / 1048576.0f);
                const float rstd = 1.0f / sqrtf(tot * (1.f / 1024.f) + 1e-6f);
#pragma unroll
                for (int bj = 0; bj < 2; ++bj)
#pragma unroll
                    for (int n = 0; n < 2; ++n) *(f32x4*)(O + off + bj * HALF + n * 16) = acc[ai][bj][m][n] * rstd * gv[bj][n]; }
    }
};
template <class Epi, class Sched, bool ALIGN_EPI = false, bool SP2 = false>
__device__ __forceinline__ void gemm_phase(PG8_LAS unsigned char* lds, const Gemm g, const Sched& S, const Epi& E, int wave_in) {
    int wv_ = wave_in; asm volatile("" : "+s"(wv_));
    int tid_ = (int)lane_now() + 64 * wv_; asm volatile("" : "+v"(tid_));
    const int tid = tid_, wid = __builtin_amdgcn_readfirstlane(tid >> 6), lane = tid & 63, wr = wid >> 2, wc = wid & 3, fr = lane & 15, fq = lane >> 4;
    const int K = g.K, nt = K / BK;
    unsigned voffA[2], voffB[2];
#pragma unroll
    for (int i = 0; i < 2; ++i) { int R, C; stage_rc(tid * 16 + i * 8192, R, C); const int Rb = Epi::PERM ? ((R & ~31) + perm32(R & 31)) : R;
        voffA[i] = (unsigned)(R * K + C) * 2u; voffB[i] = (unsigned)(Rb * K + C) * 2u; }
    const size_t kstep = (size_t)(BK * 2);
    const size_t hstep = (size_t)HALF * K * 2;
    const size_t tstep = 2 * hstep;
    const unsigned ldsw = (unsigned)wid * 1024u;
    const int aoff = lds_byte(wr * 64 + fr, fq * 8), boff = lds_byte(wc * 32 + fr, fq * 8);
#define PG8_SA(b, h) (((b) * 2 + (h)) * HTB)
#define PG8_SB(b, h) ((4 + (b) * 2 + (h)) * HTB)
#define PG8_STAGE(bufoff, gbase, voff) do { _Pragma("unroll") for (int _i = 0; _i < 2; ++_i) \
        __builtin_amdgcn_global_load_lds((const unsigned*)((const char*)(gbase) + (voff)[_i]), (PG8_LAS unsigned*)(lds + (bufoff) + ldsw + _i * 8192), 16, 0, 0); } while (0)
#define PG8_LDA(dst, b, h) do { _Pragma("unroll") for (int m = 0; m < 4; ++m) _Pragma("unroll") for (int k = 0; k < 2; ++k) dst[m][k] = *(const PG8_LAS bf16x8*)(lds + PG8_SA(b, h) + aoff + m * 2048 + k * 1024); } while (0)
#define PG8_LDB(dst, b, h) do { _Pragma("unroll") for (int n = 0; n < 2; ++n) _Pragma("unroll") for (int k = 0; k < 2; ++k) dst[n][k] = *(const PG8_LAS bf16x8*)(lds + PG8_SB(b, h) + boff + n * 2048 + k * 1024); } while (0)
#define PG8_MMA(ai, bj, At, Bt) do { __builtin_amdgcn_s_setprio(1); _Pragma("unroll") for (int m = 0; m < 4; ++m) _Pragma("unroll") for (int n = 0; n < 2; ++n) _Pragma("unroll") for (int k = 0; k < 2; ++k) \
        acc[ai][bj][m][n] = __builtin_amdgcn_mfma_f32_16x16x32_bf16(Bt[n][k], At[m][k], acc[ai][bj][m][n], 0, 0, 0); __builtin_amdgcn_s_setprio(0); } while (0)
#define PG8_WAIT_V(n) asm volatile("s_waitcnt vmcnt(" #n ")" ::: "memory")
#define PG8_WAIT_L(n) asm volatile("s_waitcnt lgkmcnt(" #n ")" ::: "memory")
#define PG8_BAR __builtin_amdgcn_s_barrier()
#define PG8_SCHED __builtin_amdgcn_sched_barrier(0)
    Unit cur, nxt; int ui = 0;
    if (!S.next(0, cur)) return;
    f32x4 acc[2][2][4][2];
#pragma unroll
    for (int a = 0; a < 2; ++a)
#pragma unroll
        for (int b = 0; b < 2; ++b)
#pragma unroll
            for (int m = 0; m < 4; ++m)
#pragma unroll
                for (int n = 0; n < 2; ++n) acc[a][b][m][n] = (f32x4){0.f, 0.f, 0.f, 0.f};
    bf16x8 At[4][2], B0[2][2], B1[2][2];
    const char* cA = (const char*)g.A + (size_t)cur.pm * tstep; const char* cB = (const char*)g.Bt + (size_t)cur.pn * tstep;
    S.a_ready(cur);
    if constexpr (SP2) {
        PG8_STAGE(PG8_SB(0, 0), cB, voffB); PG8_STAGE(PG8_SB(0, 1), cB + hstep, voffB); PG8_STAGE(PG8_SA(0, 0), cA, voffA); PG8_STAGE(PG8_SA(0, 1), cA + hstep, voffA);
        if (wr == 1) PG8_BAR;
        PG8_WAIT_V(2); PG8_BAR;
        PG8_STAGE(PG8_SB(1, 0), cB + kstep, voffB); PG8_STAGE(PG8_SA(1, 0), cA + kstep, voffA); PG8_STAGE(PG8_SB(1, 1), cB + hstep + kstep, voffB);
        PG8_WAIT_V(6); PG8_BAR;
    } else {
        PG8_STAGE(PG8_SB(0, 0), cB, voffB); PG8_STAGE(PG8_SA(0, 0), cA, voffA); PG8_STAGE(PG8_SB(0, 1), cB + hstep, voffB); PG8_STAGE(PG8_SA(0, 1), cA + hstep, voffA);
        if (wr == 1) PG8_BAR;
        PG8_WAIT_V(4); PG8_BAR;
        PG8_STAGE(PG8_SB(1, 0), cB + kstep, voffB); PG8_STAGE(PG8_SA(1, 0), cA + kstep, voffA); PG8_STAGE(PG8_SB(1, 1), cB + hstep + kstep, voffB);
        PG8_WAIT_V(6); PG8_BAR;
    }
    for (;;) {
        const bool has_next = S.next(ui + 1, nxt);
        const char* nA = has_next ? (const char*)g.A + (size_t)nxt.pm * tstep : cA; const char* nB = has_next ? (const char*)g.Bt + (size_t)nxt.pn * tstep : cB;
        for (int t = 0; t < nt; t += 2) {
            const bool last = (t == nt - 2);
            const char* a1 = cA + (size_t)(t + 1) * kstep;
            const char* a2 = last ? nA : cA + (size_t)(t + 2) * kstep; const char* b2 = last ? nB : cB + (size_t)(t + 2) * kstep;
            const char* a3 = a2 + kstep; const char* b3 = b2 + kstep;
            if (last && has_next) S.a_ready(nxt);
            if constexpr (SP2) {
            PG8_LDB(B0, 0, 0); PG8_LDB(B1, 0, 1); PG8_SCHED; PG8_LDA(At, 0, 0); PG8_STAGE(PG8_SA(1, 1), a1 + hstep, voffA);
            PG8_WAIT_V(8); PG8_WAIT_L(0); PG8_BAR; PG8_MMA(0, 0, At, B0); PG8_MMA(0, 1, At, B1); PG8_BAR; PG8_SCHED;
            PG8_LDA(At, 0, 1); PG8_STAGE(PG8_SB(0, 0), b2, voffB); PG8_STAGE(PG8_SB(0, 1), b2 + hstep, voffB); PG8_STAGE(PG8_SA(0, 0), a2, voffA);
            PG8_WAIT_V(8); PG8_WAIT_L(0); PG8_BAR; PG8_MMA(1, 0, At, B0); PG8_MMA(1, 1, At, B1); PG8_BAR; PG8_SCHED;
            PG8_LDB(B0, 1, 0); PG8_LDB(B1, 1, 1); PG8_SCHED; PG8_LDA(At, 1, 0); PG8_STAGE(PG8_SA(0, 1), a2 + hstep, voffA);
            PG8_WAIT_V(8); PG8_WAIT_L(0); PG8_BAR; PG8_MMA(0, 0, At, B0); PG8_MMA(0, 1, At, B1); PG8_BAR; PG8_SCHED;
            PG8_LDA(At, 1, 1); PG8_STAGE(PG8_SB(1, 0), b3, voffB); PG8_STAGE(PG8_SB(1, 1), b3 + hstep, voffB); PG8_STAGE(PG8_SA(1, 0), a3, voffA);
            PG8_WAIT_V(8); PG8_WAIT_L(0); PG8_BAR; PG8_MMA(1, 0, At, B0); PG8_MMA(1, 1, At, B1); PG8_BAR; PG8_SCHED;
            } else {
            PG8_LDB(B0, 0, 0); PG8_SCHED; PG8_LDA(At, 0, 0); PG8_STAGE(PG8_SA(1, 1), a1 + hstep, voffA);
            PG8_WAIT_L(8); PG8_BAR; PG8_WAIT_L(0); PG8_MMA(0, 0, At, B0); PG8_BAR; PG8_SCHED;
            PG8_LDB(B1, 0, 1); PG8_STAGE(PG8_SB(0, 0), b2, voffB);
            PG8_BAR; PG8_WAIT_L(0); PG8_MMA(0, 1, At, B1); PG8_BAR;
            PG8_LDA(At, 0, 1); PG8_STAGE(PG8_SA(0, 0), a2, voffA);
            PG8_BAR; PG8_WAIT_L(0); PG8_MMA(1, 0, At, B0); PG8_BAR; PG8_SCHED;
            PG8_STAGE(PG8_SB(0, 1), b2 + hstep, voffB);
            PG8_WAIT_V(6); PG8_BAR; PG8_MMA(1, 1, At, B1); PG8_BAR;
            PG8_LDB(B0, 1, 0); PG8_SCHED; PG8_LDA(At, 1, 0); PG8_STAGE(PG8_SA(0, 1), a2 + hstep, voffA);
            PG8_WAIT_L(8); PG8_BAR; PG8_WAIT_L(0); PG8_MMA(0, 0, At, B0); PG8_BAR; PG8_SCHED;
            PG8_LDB(B1, 1, 1); PG8_STAGE(PG8_SB(1, 0), b3, voffB);
            PG8_BAR; PG8_WAIT_L(0); PG8_MMA(0, 1, At, B1); PG8_BAR;
            PG8_LDA(At, 1, 1); PG8_STAGE(PG8_SA(1, 0), a3, voffA);
            PG8_BAR; PG8_WAIT_L(0); PG8_MMA(1, 0, At, B0); PG8_BAR; PG8_SCHED;
            PG8_STAGE(PG8_SB(1, 1), b3 + hstep, voffB);
            PG8_WAIT_V(6); PG8_BAR; PG8_MMA(1, 1, At, B1); PG8_BAR;
            }
        }
        if constexpr (ALIGN_EPI) { if (wr == 0) PG8_BAR; }
        if constexpr (!Epi::AFTER_DRAIN) { E(acc, cur, wr, wc, fr, fq); S.done(cur); }
        if (!has_next) break;
#pragma unroll
        for (int a = 0; a < 2; ++a)
#pragma unroll
            for (int b = 0; b < 2; ++b)
#pragma unroll
                for (int m = 0; m < 4; ++m)
#pragma unroll
                    for (int n = 0; n < 2; ++n) acc[a][b][m][n] = (f32x4){0.f, 0.f, 0.f, 0.f};
        cur = nxt; cA = nA; cB = nB; ++ui;
        if constexpr (ALIGN_EPI) { if (wr == 1) PG8_BAR; }
    }
    PG8_WAIT_V(0);
    if constexpr (!ALIGN_EPI) { if (wr == 0) PG8_BAR; }
    PG8_BAR;
    if constexpr (Epi::AFTER_DRAIN) { E.fused(acc, cur, wr, wc, fr, fq, lds, wid, lane); S.done(cur); }
#undef PG8_SA
#undef PG8_SB
#undef PG8_STAGE
#undef PG8_LDA
#undef PG8_LDB
#undef PG8_MMA
#undef PG8_WAIT_V
#undef PG8_WAIT_L
#undef PG8_BAR
#undef PG8_SCHED
}
}
#ifndef PG8_SP2
#define PG8_SP2 true
#endif
#ifndef PG8_ALIGN
#define PG8_ALIGN true
#endif
namespace cg = cooperative_groups;
#define LAS __attribute__((address_space(3)))
typedef unsigned short bf16;
typedef float f32x4 __attribute__((ext_vector_type(4)));
typedef float f32x16 __attribute__((ext_vector_type(16)));
typedef short bf16x8 __attribute__((ext_vector_type(8)));
typedef unsigned u32x4 __attribute__((ext_vector_type(4)));
typedef unsigned u32x2 __attribute__((ext_vector_type(2)));

constexpr int NWAVES = 8;
constexpr int BATCH = 8, SEQ = 8192, DM = 1024, M = BATCH * SEQ, NPROJ = 3072, CHUNK = 64, NCHUNK = SEQ / CHUNK;
constexpr float EPS = 1e-6f, LOG2E = 1.4426950408889634f, SCL = 0.125f * 1.4426950408889634f;
constexpr size_t MiB = 1u << 20;
constexpr size_t WS_WINT = 1 * MiB, WS_WOUTT = 8 * MiB, WS_POOLWT = 10 * MiB, WS_PART = 12 * MiB, WS_XN = 16 * MiB, WS_PROJ = 144 * MiB, WS_VT = 528 * MiB, WS_Y = 592 * MiB, WS_KF = 720 * MiB, WS_END = 784 * MiB;
constexpr int LDS_BYTES = 147456;

__device__ __forceinline__ unsigned f2bf(float f) { unsigned u = __builtin_bit_cast(unsigned, f); return (u + 0x7fffu + ((u >> 16) & 1u)) >> 16; }
__device__ __forceinline__ unsigned pk2(float lo, float hi) { return f2bf(lo) | (f2bf(hi) << 16); }
typedef float f32x2_t __attribute__((ext_vector_type(2))); typedef __bf16 bf16x2_t __attribute__((ext_vector_type(2)));
__device__ __forceinline__ unsigned pkbf(float lo, float hi) { f32x2_t v = {lo, hi}; bf16x2_t b = __builtin_convertvector(v, bf16x2_t); return __builtin_bit_cast(unsigned, b); }
__device__ __forceinline__ float bf_lo(unsigned w) { return __builtin_bit_cast(float, w << 16); }
__device__ __forceinline__ float bf_hi(unsigned w) { return __builtin_bit_cast(float, w & 0xffff0000u); }
__device__ __forceinline__ float silu_f(float x) { return x * __builtin_amdgcn_rcpf(1.f + __builtin_amdgcn_exp2f(-x * LOG2E)); }
__device__ __forceinline__ float wave_sum(float v) {
#pragma unroll
    for (int o = 1; o < 64; o <<= 1) v += __shfl_xor(v, o);
    return v;
}

template <bool POOLF> __device__ __forceinline__ void p0_transpose_item(const float* W, int K, int N, bf16* WT, LAS float* scr, int item, int lane) {
    const int nblk = N / 32, kb = item / nblk, nb = item % nblk, k0 = 64 * kb, n0 = 32 * nb;
#pragma unroll 8
    for (int i = 0; i < 32; ++i) { const int kk = 2 * i + (lane >> 5); scr[kk * 33 + (lane & 31)] = W[(size_t)(k0 + kk) * N + n0 + (lane & 31)]; }
    asm volatile("s_waitcnt lgkmcnt(0)" ::: "memory");
    const int c = lane & 7;
#pragma unroll
    for (int j = 0; j < 4; ++j) { const int n = (lane >> 3) + 8 * j; const LAS float* s = scr + (8 * c) * 33 + n;
        u32x4 o; o.x = pk2(s[0 * 33], s[1 * 33]); o.y = pk2(s[2 * 33], s[3 * 33]); o.z = pk2(s[4 * 33], s[5 * 33]); o.w = pk2(s[6 * 33], s[7 * 33]);
        if (POOLF) { const int k = k0 + 8 * c, nn = n0 + n; *(u32x4*)(WT + (size_t)(((((k >> 4) * 4 + (nn >> 5)) * 2 + ((k >> 3) & 1)) * 32 + (nn & 31)) * 8)) = o; }
        else *(u32x4*)(WT + (size_t)(n0 + n) * K + k0 + 8 * c) = o; }
    asm volatile("s_waitcnt lgkmcnt(0)" ::: "memory");
}

typedef unsigned v4u __attribute__((ext_vector_type(4)));
#define XB_TMO      128
#define XB_XCNT(j)  (256  + 64 * (j))
#define XB_XSUB(j)  (1280 + 64 * (j))
#define XB_XGEN(j)  (2304 + 64 * (j))
#define XB_TOP      3328
#define XB_TOPGEN   3392
#define XCD_BAR_WORDS 3456
#define XB_SPIN_CAP (1u << 18)

__device__ __forceinline__ unsigned xb_ld(unsigned* p)              { return __hip_atomic_load(p, __ATOMIC_RELAXED, __HIP_MEMORY_SCOPE_AGENT); }
__device__ __forceinline__ unsigned xb_add(unsigned* p, unsigned v) { return __hip_atomic_fetch_add(p, v, __ATOMIC_RELAXED, __HIP_MEMORY_SCOPE_AGENT); }
__device__ __forceinline__ unsigned xb_xcc_id() { return (unsigned)__builtin_amdgcn_s_getreg((3 << 11) | 20) & 0xFu; }
#define XB_SPIN(cond, bar) do { unsigned _sp = 0; while (cond) { __builtin_amdgcn_s_sleep(1); \
    if ((++_sp & 255u) == 0u) { if (xb_ld(&(bar)[XB_TMO])) break; if (_sp > XB_SPIN_CAP) { atomicAdd(&(bar)[XB_TMO], 1u); break; } } } } while (0)

struct XcdBarrier {
    unsigned* bar; unsigned x;
    volatile LAS unsigned* st;
};

__device__ __forceinline__ XcdBarrier xcd_barrier_post(unsigned* bar, volatile LAS unsigned* st) {
    XcdBarrier b; b.bar = bar; b.x = xb_xcc_id(); b.st = st;
    if (threadIdx.x == 0) (void)xb_add(&bar[XB_XCNT(b.x)], 1u);
    return b;
}
__device__ __forceinline__ void xcd_barrier_complete(unsigned* bar, unsigned x, unsigned& nloc, unsigned& nx) {
    const unsigned G = gridDim.x * gridDim.y * gridDim.z;
    unsigned sum, cnt, mine, sp = 0u;
    for (;;) {
        sum = 0u; cnt = 0u; mine = 0u;
#pragma unroll
        for (unsigned j = 0; j < 16; ++j) { const unsigned c = xb_ld(&bar[XB_XCNT(j)]); sum += c; cnt += (c > 0u) ? 1u : 0u; mine = (j == x) ? c : mine; }
        if (sum == G) break;
        __builtin_amdgcn_s_sleep(1);
        if ((++sp & 255u) == 0u) { if (xb_ld(&bar[XB_TMO])) break; if (sp > XB_SPIN_CAP) { atomicAdd(&bar[XB_TMO], 1u); break; } }
    }
    nloc = mine > 0u ? mine : 1u; nx = cnt > 0u ? cnt : 1u;
}

__device__ __forceinline__ void xcd_barrier(const XcdBarrier& b) {
    asm volatile("s_waitcnt vmcnt(0)" ::: "memory");
    __syncthreads();
    if (threadIdx.x == 0) {
        unsigned* bar = b.bar;
        __builtin_amdgcn_s_waitcnt(0);
        unsigned nloc = b.st[0], nx = b.st[1];
        if (nloc == 0u) { xcd_barrier_complete(bar, b.x, nloc, nx); b.st[0] = nloc; b.st[1] = nx; }
        const unsigned old = xb_add(&bar[XB_XSUB(b.x)], 1u);
        const unsigned gen = old / nloc;
        if (old + 1u == (gen + 1u) * nloc) {
            __builtin_amdgcn_fence(__ATOMIC_RELEASE, "agent");
            asm volatile("s_waitcnt vmcnt(0)" ::: "memory");
            const unsigned og = xb_add(&bar[XB_TOP], 1u);
            const unsigned tg = og / nx;
            if (og + 1u == (tg + 1u) * nx) xb_add(&bar[XB_TOPGEN], 1u);
            else XB_SPIN(xb_ld(&bar[XB_TOPGEN]) == tg, bar);
            __builtin_amdgcn_fence(__ATOMIC_ACQUIRE, "agent");
            xb_add(&bar[XB_XGEN(b.x)], 1u);
            asm volatile("s_waitcnt vmcnt(0)" ::: "memory");
        } else {
            XB_SPIN(xb_ld(&bar[XB_XGEN(b.x)]) == gen, bar);
            __builtin_amdgcn_fence(__ATOMIC_ACQUIRE, "agent");
            asm volatile("s_waitcnt vmcnt(0)" ::: "memory");
        }
    }
    __syncthreads();
}

__device__ __forceinline__ int lane_id() { int l = (int)lane_now(); asm volatile("" : "+v"(l)); return l; }
struct Args { const float* x; const float* norm_gain; const float* w_in; const float* pool_w; const float* pool_scale; const float* rel_bias; const float* w_out; const float* fgain; float* out; unsigned char* ws; };

constexpr int PROW = 272;
constexpr int WREG = 12800;
__device__ __forceinline__ float max3f(float a, float b, float c) { float r; asm("v_max3_f32 %0, %1, %2, %3" : "=v"(r) : "v"(a), "v"(b), "v"(c)); return r; }
struct Gates { u32x2 g[8]; };
__device__ __forceinline__ void gate_load(Gates& G, const bf16* gbase, int lane) {
    int lo_ = lane; asm volatile("" : "+v"(lo_));
    const unsigned goff = (unsigned)((lo_ >> 4) * NPROJ + 4 * (lo_ & 15));
#pragma unroll
    for (int it = 0; it < 8; ++it) G.g[it] = *(const u32x2*)(gbase + (goff + (unsigned)(4 * it * NPROJ)));
}
template <bool SCALE> __device__ __forceinline__ void epi_tile(LAS unsigned char* wl, const f32x16& v0, const f32x16& v1, float mul, const Gates& G, bf16* ybase, const float* scale, int lane) {
    LAS unsigned char* wp = wl + (lane & 31) * PROW + (lane >> 5) * 16;
#pragma unroll
    for (int i4 = 0; i4 < 4; ++i4) {
        *(LAS f32x4*)(wp + i4 * 32) = (f32x4){v0[4 * i4] * mul, v0[4 * i4 + 1] * mul, v0[4 * i4 + 2] * mul, v0[4 * i4 + 3] * mul};
        *(LAS f32x4*)(wp + 128 + i4 * 32) = (f32x4){v1[4 * i4] * mul, v1[4 * i4 + 1] * mul, v1[4 * i4 + 2] * mul, v1[4 * i4 + 3] * mul};
    }
    int lo_ = lane; asm volatile("" : "+v"(lo_));
    const int rr = lo_ >> 4, piece = lo_ & 15;
    const unsigned yoff = (unsigned)(rr * DM + 4 * piece);
    f32x4 s = (f32x4){1.f, 1.f, 1.f, 1.f};
    if (SCALE) s = *(const f32x4*)(scale + 4 * piece);
#pragma unroll
    for (int it = 0; it < 8; ++it) { const int row = 4 * it + rr;
        const f32x4 x = *(const LAS f32x4*)(wl + row * PROW + piece * 16);
        const u32x2 gw = G.g[it];
        const float o0 = x[0] * s[0] * silu_f(bf_lo(gw.x)), o1 = x[1] * s[1] * silu_f(bf_hi(gw.x)), o2 = x[2] * s[2] * silu_f(bf_lo(gw.y)), o3 = x[3] * s[3] * silu_f(bf_hi(gw.y));
        u32x2 ow; ow.x = pkbf(o0, o1); ow.y = pkbf(o2, o3); *(u32x2*)(ybase + (yoff + (unsigned)(4 * it * DM))) = ow; }
}
template <int W> __device__ __forceinline__ bf16x8 pool_window(const LAS unsigned char* rp, float inv) {
    float sum[8], own[8];
#pragma unroll
    for (int e = 0; e < 8; ++e) { sum[e] = 0.f; own[e] = 0.f; }
#pragma unroll
    for (int i = 0; i < W; ++i) {
        const u32x4 w = *(const LAS u32x4*)(rp - i * PROW);
        const float f[8] = {bf_lo(w.x), bf_hi(w.x), bf_lo(w.y), bf_hi(w.y), bf_lo(w.z), bf_hi(w.z), bf_lo(w.w), bf_hi(w.w)};
#pragma unroll
        for (int e = 0; e < 8; ++e) { sum[e] += f[e]; if (i == 0) own[e] = f[e]; }
        if ((i & 3) == 3) __builtin_amdgcn_sched_barrier(0);
    }
    u32x4 o; o.x = pkbf(sum[0] * inv - own[0], sum[1] * inv - own[1]); o.y = pkbf(sum[2] * inv - own[2], sum[3] * inv - own[3]);
    o.z = pkbf(sum[4] * inv - own[4], sum[5] * inv - own[5]); o.w = pkbf(sum[6] * inv - own[6], sum[7] * inv - own[7]);
    return __builtin_bit_cast(bf16x8, o);
}
template <int W> __device__ __forceinline__ void pool_unit(const bf16* proj, const bf16* pwf, const float* pool_scale, bf16* Y, LAS unsigned char* wl, int b, int c, int g, int th, int lane, bf16x8 (&qpre)[8], int h) {
    const int r32 = lane & 31, hi = lane >> 5;
    const int sb = c * CHUNK + th * 32, s = sb + r32;
    const char* wt = (const char*)(pwf + (size_t)g * 128 * 128); const unsigned l16 = (unsigned)lane * 16u;
    bf16x8 wfx[8], wfy[8];
#pragma unroll
    for (int t = 0; t < 8; ++t) wfx[t] = *(const bf16x8*)(wt + t * 1024 + l16);
#pragma unroll
    for (int t = 0; t < 8; ++t) wfy[t] = *(const bf16x8*)(wt + (8 + t) * 1024 + l16);
#pragma unroll
    for (int i = 0; i < 12; ++i) { const int r0 = 4 * i + (lane >> 4), r = r0 < 46 ? r0 : 46, piece = lane & 15, u = sb - 15 + r, uc = u > 0 ? u : 0;
        u32x4 w = *(const u32x4*)(proj + ((size_t)b * SEQ + uc) * NPROJ + g * 128 + piece * 8);
        if (u < 0) w = (u32x4){0u, 0u, 0u, 0u};
        *(LAS u32x4*)(wl + r * PROW + piece * 16) = w; }
    const int cnt = (s + 1 < W) ? (s + 1) : W; const float inv = 1.f / (float)cnt;
    const LAS unsigned char* rp0 = wl + (r32 + 15) * PROW + hi * 16;
    f32x16 acc[4];
#pragma unroll
    for (int db = 0; db < 4; ++db)
#pragma unroll
        for (int i = 0; i < 16; ++i) acc[db][i] = 0.f;
    const size_t row0 = (size_t)b * SEQ + sb;
    Gates g0, g1;
#pragma unroll
    for (int kp = 0; kp < 4; ++kp) {
#pragma unroll
        for (int k2 = 0; k2 < 2; ++k2) { const int ks = 2 * kp + k2;
            const bf16x8 df = pool_window<W>(rp0 + ks * 32, inv);
#pragma unroll
            for (int db = 0; db < 4; ++db) acc[db] = __builtin_amdgcn_mfma_f32_32x32x16_bf16((kp & 1) ? wfy[k2 * 4 + db] : wfx[k2 * 4 + db], df, acc[db], 0, 0, 0);
            __builtin_amdgcn_sched_barrier(0); }
        if (kp == 0) {
#pragma unroll
            for (int t = 0; t < 8; ++t) wfx[t] = *(const bf16x8*)(wt + (16 + t) * 1024 + l16);
        }
        if (kp == 1) {
#pragma unroll
            for (int t = 0; t < 8; ++t) wfy[t] = *(const bf16x8*)(wt + (24 + t) * 1024 + l16);
        }
        if (kp == 2) { gate_load(g0, proj + row0 * NPROJ + (512 + g * 128), lane);
            int lq = lane; asm volatile("" : "+v"(lq));
            const bf16* qp = proj + ((size_t)b * SEQ + c * CHUNK + (lq & 31)) * NPROJ + (1024 + h * 64 + 8 * (lq >> 5));
#pragma unroll
            for (int t = 0; t < 8; ++t) qpre[t] = *(const bf16x8*)(qp + (unsigned)((t >> 2) * 32 * NPROJ + 16 * (t & 3))); }
        __builtin_amdgcn_sched_barrier(0);
    }
    gate_load(g1, proj + row0 * NPROJ + (512 + g * 128 + 64), lane);
    epi_tile<true>(wl, acc[0], acc[1], 1.f, g0, Y + row0 * DM + g * 128, pool_scale + g * 128, lane);
    epi_tile<true>(wl, acc[2], acc[3], 1.f, g1, Y + row0 * DM + (g * 128 + 64), pool_scale + (g * 128 + 64), lane);
}
__device__ __forceinline__ void attn_unit(const bf16* proj, const bf16* KF, const bf16* VF, bf16* Y, const LAS float* tab, LAS unsigned char* wl, int b, int c, int h, int lane, const bf16x8 (&qpre)[8]) {
    const int r32 = lane & 31, hi = lane >> 5;
    const int jstart = (c < 8) ? (8 - c) : 0;
    const char* kbase = (const char*)(KF + (size_t)(b * 8 + h) * 256 * 2048);
    const char* vbase = (const char*)(VF + (size_t)(b * 8 + h) * 256 * 2048);
    const unsigned l16 = (unsigned)lane * 16u;
#pragma unroll
    for (int t = 0; t < 8; ++t) *(LAS bf16x8*)(wl + t * 1024 + l16) = qpre[t];
    bf16x8 kf[8];
    { const int kblk = (c - 8 + jstart) * 2;
#pragma unroll
        for (int t = 0; t < 8; ++t) kf[t] = *(const bf16x8*)(kbase + (size_t)kblk * 4096 + t * 1024 + l16); }
    float m[2] = {-1e30f, -1e30f}, l[2] = {0.f, 0.f}; f32x16 o[2][2];
#pragma unroll
    for (int qh = 0; qh < 2; ++qh)
#pragma unroll
        for (int db = 0; db < 2; ++db)
#pragma unroll
            for (int i = 0; i < 16; ++i) o[qh][db][i] = 0.f;
    for (int j = jstart; j <= 8; ++j) {
        const int kblk = (c - 8 + j) * 2;
        __builtin_amdgcn_sched_barrier(0);
        bf16x8 vf[8];
#pragma unroll
        for (int t = 0; t < 8; ++t) vf[t] = *(const bf16x8*)(vbase + (size_t)kblk * 4096 + t * 1024 + l16);
        __builtin_amdgcn_sched_barrier(0);
        bf16x8 qfa[8];
#pragma unroll
        for (int t = 0; t < 8; ++t) qfa[t] = *(const LAS bf16x8*)(wl + t * 1024 + l16);
#pragma unroll
        for (int qh = 0; qh < 2; ++qh) {
            const int dq = 4 * hi - (qh * 32 + r32);
            f32x16 sc[2];
            { bf16x8 qf[4];
#pragma unroll
              for (int ds = 0; ds < 4; ++ds) qf[ds] = qfa[qh * 4 + ds];
#pragma unroll
              for (int kb = 0; kb < 2; ++kb) {
#pragma unroll
                for (int i = 0; i < 16; ++i) sc[kb][i] = 0.f;
#pragma unroll
                for (int ds = 0; ds < 4; ++ds) sc[kb] = __builtin_amdgcn_mfma_f32_32x32x16_bf16(kf[kb * 4 + ds], qf[ds], sc[kb], 0, 0, 0);
              }
              asm volatile("s_nop 15\n\ts_nop 7" : "+v"(sc[0]), "+v"(sc[1])); }
            if (qh == 1) {
                __builtin_amdgcn_sched_barrier(0);
                if (j < 8) {
#pragma unroll
                    for (int t = 0; t < 8; ++t) kf[t] = *(const bf16x8*)(kbase + (size_t)(kblk + 2) * 4096 + t * 1024 + l16);
                } else {
                    int lo_ = lane; asm volatile("" : "+v"(lo_));
                    const bf16* gb = proj + ((size_t)b * SEQ + c * CHUNK) * NPROJ + (2560 + h * 64) + (unsigned)((lo_ >> 4) * NPROJ + 4 * (lo_ & 15));
#pragma unroll
                    for (int t = 0; t < 8; ++t) {
                        const u32x2 ga = *(const u32x2*)(gb + (unsigned)((8 * t) * NPROJ)), gc = *(const u32x2*)(gb + (unsigned)((8 * t + 4) * NPROJ));
                        u32x4 w; w.x = ga.x; w.y = ga.y; w.z = gc.x; w.w = gc.y; kf[t] = __builtin_bit_cast(bf16x8, w); }
                }
                __builtin_amdgcn_sched_barrier(0);
            }
            const bool cb_tile = (j <= 6);
            if (!cb_tile) {
                const LAS float* tp = tab + ((j == 8) ? 64 : (129 + 63)) + dq;
#pragma unroll
                for (int kb = 0; kb < 2; ++kb)
#pragma unroll
                    for (int i = 0; i < 16; ++i) sc[kb][i] = sc[kb][i] * SCL + tp[32 * kb + (i & 3) + 8 * (i >> 2)];
            }
            float mt;
            { float ma = max3f(sc[0][0], sc[0][1], sc[0][2]), mb = max3f(sc[1][0], sc[1][1], sc[1][2]);
#pragma unroll
              for (int i = 3; i < 15; i += 2) { ma = max3f(ma, sc[0][i], sc[0][i + 1]); mb = max3f(mb, sc[1][i], sc[1][i + 1]); }
              mt = max3f(ma, mb, sc[0][15]); mt = max3f(mt, sc[1][15], sc[1][15]); }
            mt = xmax32(mt);
            const float b0 = tab[0];
            const float mts = cb_tile ? (mt * SCL + b0) : mt;
            if (__builtin_amdgcn_ballot_w64(mts > m[qh] + 8.0f) != 0ull) {
                const float mn = fmaxf(m[qh], mts); const float alpha = __builtin_amdgcn_exp2f(m[qh] - mn); m[qh] = mn; l[qh] *= alpha;
#pragma unroll
                for (int db = 0; db < 2; ++db)
#pragma unroll
                    for (int i = 0; i < 16; ++i) o[qh][db][i] *= alpha;
            }
            float ls = 0.f;
            if (cb_tile) { const float cb = b0 - m[qh];
#pragma unroll
                for (int kb = 0; kb < 2; ++kb)
#pragma unroll
                    for (int i = 0; i < 16; ++i) { const float p = __builtin_amdgcn_exp2f(sc[kb][i] * SCL + cb); sc[kb][i] = p; ls += p; }
            } else { const float mr = m[qh];
#pragma unroll
                for (int kb = 0; kb < 2; ++kb)
#pragma unroll
                    for (int i = 0; i < 16; ++i) { const float p = __builtin_amdgcn_exp2f(sc[kb][i] - mr); sc[kb][i] = p; ls += p; }
            }
            l[qh] += ls;
#pragma unroll
            for (int kb = 0; kb < 2; ++kb)
#pragma unroll
                for (int s2 = 0; s2 < 2; ++s2) {
                    u32x4 pw; pw.x = pkbf(sc[kb][8 * s2 + 0], sc[kb][8 * s2 + 1]); pw.y = pkbf(sc[kb][8 * s2 + 2], sc[kb][8 * s2 + 3]);
                    pw.z = pkbf(sc[kb][8 * s2 + 4], sc[kb][8 * s2 + 5]); pw.w = pkbf(sc[kb][8 * s2 + 6], sc[kb][8 * s2 + 7]);
                    const bf16x8 pf = __builtin_bit_cast(bf16x8, pw);
#pragma unroll
                    for (int db = 0; db < 2; ++db) o[qh][db] = __builtin_amdgcn_mfma_f32_32x32x16_bf16(vf[(kb * 2 + s2) * 2 + db], pf, o[qh][db], 0, 0, 0);
                }
        }
    }
    { const size_t row0 = (size_t)b * SEQ + c * CHUNK;
      Gates g0, g1;
#pragma unroll
      for (int t = 0; t < 4; ++t) { const u32x4 w0 = __builtin_bit_cast(u32x4, kf[t]), w1 = __builtin_bit_cast(u32x4, kf[4 + t]);
          g0.g[2 * t] = (u32x2){w0.x, w0.y}; g0.g[2 * t + 1] = (u32x2){w0.z, w0.w}; g1.g[2 * t] = (u32x2){w1.x, w1.y}; g1.g[2 * t + 1] = (u32x2){w1.z, w1.w}; }
      const float inv0 = 1.f / xsum32(l[0]), inv1 = 1.f / xsum32(l[1]);
      epi_tile<false>(wl, o[0][0], o[0][1], inv0, g0, Y + row0 * DM + (512 + h * 64), nullptr, lane);
      epi_tile<false>(wl, o[1][0], o[1][1], inv1, g1, Y + (row0 + 32) * DM + (512 + h * 64), nullptr, lane); }
}

__global__ void __launch_bounds__(NWAVES * 64, 2) fwd_mega(Args a) {
    extern __shared__ __attribute__((aligned(16))) unsigned char lds[];
    cg::grid_group grid = cg::this_grid();
    const int wave = __builtin_amdgcn_readfirstlane((int)threadIdx.x >> 6);
    const int G = gridDim.x, bx = blockIdx.x; const int vcu = (G % 8 == 0) ? (bx % 8) * (G / 8) + bx / 8 : bx;
    unsigned char* ws = a.ws;
    bf16* WinT = (bf16*)(ws + WS_WINT); bf16* WoutT = (bf16*)(ws + WS_WOUTT); bf16* PoolWT = (bf16*)(ws + WS_POOLWT);
    float* part = (float*)(ws + WS_PART); bf16* XN = (bf16*)(ws + WS_XN); bf16* PROJ = (bf16*)(ws + WS_PROJ); bf16* VF = (bf16*)(ws + WS_VT); bf16* KF = (bf16*)(ws + WS_KF); bf16* Y = (bf16*)(ws + WS_Y);
    const int gw = vcu * NWAVES + wave, NGW = G * NWAVES;
    volatile LAS unsigned* xst = (volatile LAS unsigned*)((LAS unsigned char*)lds + 131072);
    if (threadIdx.x < 2) xst[threadIdx.x] = 0u;
    __syncthreads();
    const XcdBarrier xbar = xcd_barrier_post((unsigned*)ws, xst);

    {
        const int lane = lane_id();
        LAS float* scr = (LAS float*)((LAS unsigned char*)lds + wave * 16384);
        constexpr int I_IN = (DM / 64) * (NPROJ / 32), I_OUT = (DM / 64) * (DM / 32), I_PW = (128 / 64) * (128 / 32);
        constexpr int NITEMS = I_IN + I_OUT + 4 * I_PW;
        for (int it = gw; it < NITEMS; it += NGW) {
            int r = it;
            if (r < I_IN) { p0_transpose_item<false>(a.w_in, DM, NPROJ, WinT, scr, r, lane); continue; } r -= I_IN;
            if (r < I_OUT) { p0_transpose_item<false>(a.w_out, DM, DM, WoutT, scr, r, lane); continue; } r -= I_OUT;
            const int g = r / I_PW; r -= g * I_PW;
            p0_transpose_item<true>(a.pool_w + (size_t)g * 128 * 128, 128, 128, PoolWT + (size_t)g * 128 * 128, scr, r, lane);
        }
        f32x4 gv[4];
#pragma unroll
        for (int j = 0; j < 4; ++j) gv[j] = ((const f32x4*)a.norm_gain)[lane + 64 * j];
        for (int m0 = gw * 8; m0 < M; m0 += NGW * 8) {
            f32x4 v[8][4];
#pragma unroll
            for (int r = 0; r < 8; ++r) { const f32x4* xr = (const f32x4*)(a.x + (size_t)(m0 + r) * DM) + lane;
#pragma unroll
                for (int j = 0; j < 4; ++j) v[r][j] = __builtin_nontemporal_load(xr + 64 * j); }
#pragma unroll
            for (int r = 0; r < 8; ++r) { float ss = 0.f;
#pragma unroll
                for (int j = 0; j < 4; ++j) ss += (v[r][j][0] * v[r][j][0] + v[r][j][1] * v[r][j][1]) + (v[r][j][2] * v[r][j][2] + v[r][j][3] * v[r][j][3]);
                const float rstd = 1.0f / sqrtf(wave_sum(ss) * (1.f / DM) + EPS);
                unsigned long long* o8 = (unsigned long long*)(XN + (size_t)(m0 + r) * DM) + lane;
#pragma unroll
                for (int j = 0; j < 4; ++j) { const f32x4 t = v[r][j] * rstd * gv[j]; o8[64 * j] = (unsigned long long)pkbf(t[0], t[1]) | ((unsigned long long)pkbf(t[2], t[3]) << 32); } }
        }
    }
    if (a.ws == nullptr) grid.sync();
    xcd_barrier(xbar);

    {
        pg8::Gemm g{XN, WinT, M, NPROJ, DM}; pg8::StaticOrder S; S.init(M, NPROJ, G, bx);
        pg8::EpiProj E{PROJ, KF, VF};
        pg8::gemm_phase<pg8::EpiProj, pg8::StaticOrder, PG8_ALIGN, PG8_SP2>((PG8_LAS unsigned char*)lds, g, S, E, wave);
    }
    xcd_barrier(xbar);

    {
        LAS float* tab = (LAS float*)((LAS unsigned char*)lds + NWAVES * WREG);
        LAS unsigned char* wl = (LAS unsigned char*)lds + wave * WREG;
        const int lane = lane_id(), tid = wave * 64 + lane;
        for (int i = tid; i < 8 * 256; i += NWAVES * 64) { const int hh = i >> 8, e = i & 255;
            const int src_i = (e < 129) ? e : ((e - 129 - 63) > 0 ? (e - 129 - 63) : 0); tab[i] = a.rel_bias[hh * 129 + src_i] * LOG2E; }
        __syncthreads();
        for (int unit = vcu; unit < BATCH * NCHUNK; unit += G) {
            const int b = unit / NCHUNK, c = unit % NCHUNK;
            const int g = ((wave >> 1) + (unit / G)) & 3, th = wave & 1;
            int ln = lane; asm volatile("" : "+v"(ln));
            bf16x8 qpre[8];
            switch (g) {
                case 0: pool_unit<2>(PROJ, PoolWT, a.pool_scale, Y, wl, b, c, 0, th, ln, qpre, wave); break;
                case 1: pool_unit<4>(PROJ, PoolWT, a.pool_scale, Y, wl, b, c, 1, th, ln, qpre, wave); break;
                case 2: pool_unit<8>(PROJ, PoolWT, a.pool_scale, Y, wl, b, c, 2, th, ln, qpre, wave); break;
                default: pool_unit<16>(PROJ, PoolWT, a.pool_scale, Y, wl, b, c, 3, th, ln, qpre, wave); break;
            }
            asm volatile("" : "+v"(ln));
            attn_unit(PROJ, KF, VF, Y, tab + wave * 256, wl, b, c, wave, ln, qpre);
        }
    }
    xcd_barrier(xbar);

    {
        pg8::Gemm g{Y, WoutT, M, DM, DM}; pg8::StaticOrder S; S.init(M, DM, G, bx);
        pg8::EpiOut E{a.x, a.out, (unsigned long long*)(ws + 131072), a.fgain};
        pg8::gemm_phase<pg8::EpiOut, pg8::StaticOrder, PG8_ALIGN, PG8_SP2>((PG8_LAS unsigned char*)lds, g, S, E, wave);
    }
}

extern "C" void kernel_launch(void* const* d_in, const int* in_sizes, int n_in, void* d_out, int out_size, void* d_ws, size_t ws_size, hipStream_t stream) {
    static int grid = 0;
    if (grid == 0) {
        if (n_in != 8 || in_sizes[0] != M * DM || out_size != M * DM || ws_size < WS_END) { fprintf(stderr, "kernel_launch: unexpected shapes (n_in %d, in0 %d, out %d, ws %zu); nothing launched\n", n_in, n_in > 0 ? in_sizes[0] : -1, out_size, ws_size); grid = -1; return; }
        int dev = 0, cus = 0, per_cu = 0;
        if (hipGetDevice(&dev) != hipSuccess || hipDeviceGetAttribute(&cus, hipDeviceAttributeMultiprocessorCount, dev) != hipSuccess) { fprintf(stderr, "kernel_launch: device query failed\n"); grid = -1; return; }
        if (hipFuncSetAttribute((const void*)fwd_mega, hipFuncAttributeMaxDynamicSharedMemorySize, LDS_BYTES) != hipSuccess) { fprintf(stderr, "kernel_launch: hipFuncSetAttribute failed\n"); grid = -1; return; }
        if (hipOccupancyMaxActiveBlocksPerMultiprocessor(&per_cu, (const void*)fwd_mega, NWAVES * 64, LDS_BYTES) != hipSuccess || per_cu < 1) { fprintf(stderr, "kernel_launch: occupancy query gave %d blocks per CU\n", per_cu); (void)hipGetLastError(); grid = -1; return; }
        grid = cus * per_cu;
    }
    if (grid < 0) return;
    if (hipMemsetAsync(d_ws, 0, 131072 + 524288, stream) != hipSuccess) { fprintf(stderr, "kernel_launch: hipMemsetAsync failed\n"); return; }
    Args a{};
    a.x = (const float*)d_in[0]; a.norm_gain = (const float*)d_in[1]; a.w_in = (const float*)d_in[2]; a.pool_w = (const float*)d_in[3]; a.pool_scale = (const float*)d_in[4];
    a.rel_bias = (const float*)d_in[5]; a.w_out = (const float*)d_in[6]; a.fgain = (const float*)d_in[7]; a.out = (float*)d_out; a.ws = (unsigned char*)d_ws;
    void* args[] = {&a};
    hipError_t e = hipLaunchCooperativeKernel((const void*)fwd_mega, dim3(grid), dim3(NWAVES * 64), args, LDS_BYTES, stream);
    if (e != hipSuccess) fprintf(stderr, "kernel_launch: cooperative launch failed: %s (grid %d)\n", hipGetErrorString(e), grid);
}
```
